# Optimizing an MI355X kernel written in HIP

```python
import math
import jax, jax.numpy as jnp
from jax import lax
import numpy as np

D_MODEL = 1024
BATCH = 32
SEQ = 2048
DEPTH = 1

D_MIX = D_MODEL
DIFF_WIDTH = D_MIX // 2
DIFF_HEADS = 4
DIFF_QK_DIM = 64
DIFF_V_DIM = DIFF_WIDTH // DIFF_HEADS
NSA_WIDTH = D_MIX - DIFF_WIDTH
NSA_HEADS = 8
NSA_HEAD_DIM = NSA_WIDTH // NSA_HEADS
NSA_KV_HEADS = 2
NSA_GROUP = NSA_HEADS // NSA_KV_HEADS
CMP_BLOCK = 32
CMP_STRIDE = 16
CMP_HIDDEN = 256
SEL_BLOCK = 64
SEL_TOPK = 8
N_LOCAL_BLOCKS = 2
FORCE_BONUS = 1000.0
WINDOW = 512
Q_BLOCK = 128
SEL_Q_BLOCK = 32
RMS_EPS = 1e-6
NEG_BIG = -1e30

COL_DIFF_Q = DIFF_HEADS * 2 * DIFF_QK_DIM
COL_DIFF_K = DIFF_HEADS * 2 * DIFF_QK_DIM
COL_DIFF_V = DIFF_WIDTH
COL_DIFF_Z = DIFF_WIDTH
COL_NSA_Q = NSA_WIDTH
COL_NSA_KV = 6 * NSA_KV_HEADS * NSA_HEAD_DIM
COL_NSA_Z = NSA_WIDTH
COL_NSA_GATE = 3 * NSA_HEADS
IN_COLS = COL_DIFF_Q + COL_DIFF_K + COL_DIFF_V + COL_DIFF_Z + COL_NSA_Q + COL_NSA_KV + COL_NSA_Z + COL_NSA_GATE
IN_SPLITS = [int(v) for v in np.cumsum([COL_DIFF_Q, COL_DIFF_K, COL_DIFF_V, COL_DIFF_Z, COL_NSA_Q, COL_NSA_KV, COL_NSA_Z])]

kernel_name = 'hymba_diffattn_nsa_block'


def rms_norm(x, g):
    xf = x.astype(jnp.float32)
    r = lax.rsqrt(jnp.mean(xf * xf, axis=-1, keepdims=True) + RMS_EPS)
    return (xf * r).astype(x.dtype) * g


def alibi_slopes(n):
    return jnp.asarray([2.0 ** (-8.0 * (h + 1) / n) for h in range(n)], dtype=jnp.float32)


def diff_attention(q, k, v, lam, slopes):
    B, H, _, T, _ = q.shape
    dv = v.shape[-1]
    scale = DIFF_QK_DIM ** -0.5
    kpos = jnp.arange(T)

    def block(start):
        qb = lax.dynamic_slice_in_dim(q, start, Q_BLOCK, axis=3)
        s = jnp.einsum('bhcqd,bhckd->bhcqk', qb, k).astype(jnp.float32) * scale
        qpos = start + jnp.arange(Q_BLOCK)
        dist = (qpos[:, None] - kpos[None, :]).astype(jnp.float32)
        s = s - slopes[None, :, None, None, None] * dist
        s = jnp.where(dist >= 0, s, -jnp.inf)
        p = jax.nn.softmax(s, axis=-1)
        p = p[:, :, 0] - lam * p[:, :, 1]
        return jnp.einsum('bhqk,bhkd->bhqd', p.astype(v.dtype), v)

    out = lax.map(block, jnp.arange(T // Q_BLOCK) * Q_BLOCK)
    return out.transpose(1, 2, 0, 3, 4).reshape(B, H, T, dv)


def compress(kv, pos, w1, b1, w2):
    B, KVH, T, d = kv.shape
    n_cmp = (T - CMP_BLOCK) // CMP_STRIDE + 1
    idx = jnp.arange(n_cmp)[:, None] * CMP_STRIDE + jnp.arange(CMP_BLOCK)[None, :]
    blocks = kv[:, :, idx] + pos
    flat = blocks.reshape(B, KVH, n_cmp, CMP_BLOCK * d)
    return jax.nn.silu(flat @ w1 + b1) @ w2


def compressed_attention(q, kc, vc):
    T = q.shape[3]
    n_cmp = kc.shape[2]
    scale = NSA_HEAD_DIM ** -0.5
    s = jnp.einsum('bhgtd,bhcd->bhgtc', q, kc).astype(jnp.float32) * scale
    cend = jnp.arange(n_cmp) * CMP_STRIDE + CMP_BLOCK - 1
    valid = cend[None, :] <= jnp.arange(T)[:, None]
    p = jax.nn.softmax(jnp.where(valid, s, NEG_BIG), axis=-1)
    p = jnp.where(valid, p, 0.0)
    o = jnp.einsum('bhgtc,bhcd->bhgtd', p.astype(vc.dtype), vc)
    return o, p


def select_blocks(p_cmp):
    T, n_cmp = p_cmp.shape[3], p_cmp.shape[4]
    n_sb = T // SEL_BLOCK
    cstart = jnp.arange(n_cmp) * CMP_STRIDE
    sstart = jnp.arange(n_sb) * SEL_BLOCK
    overlap = ((cstart[:, None] < sstart[None, :] + SEL_BLOCK)
               & (cstart[:, None] + CMP_BLOCK > sstart[None, :])).astype(jnp.float32)
    imp = jnp.einsum('bhgtc,cs->bhts', p_cmp, overlap)
    blk_t = jnp.arange(T)[:, None] // SEL_BLOCK
    j = jnp.arange(n_sb)[None, :]
    valid = j <= blk_t
    forced = valid & ((j == 0) | (j >= blk_t - (N_LOCAL_BLOCKS - 1)))
    score = jnp.where(valid, imp, -1.0) + jnp.where(forced, FORCE_BONUS, 0.0)
    _, idx = lax.top_k(score, min(SEL_TOPK, n_sb))
    return idx


def selected_attention(q, k, v, sel_idx, slopes):
    B, KVH, G, T, d = q.shape
    n = sel_idx.shape[-1]
    scale = NSA_HEAD_DIM ** -0.5
    kb = k.reshape(B, KVH, T // SEL_BLOCK, SEL_BLOCK, d)
    vb = v.reshape(B, KVH, T // SEL_BLOCK, SEL_BLOCK, d)
    bi = jnp.arange(B)[:, None, None, None]
    hi = jnp.arange(KVH)[None, :, None, None]
    offs = jnp.arange(SEL_BLOCK)
    n_keys = n * SEL_BLOCK

    def chunk(start):
        qc = lax.dynamic_slice_in_dim(q, start, SEL_Q_BLOCK, axis=3)
        ic = lax.dynamic_slice_in_dim(sel_idx, start, SEL_Q_BLOCK, axis=2)
        kg = kb[bi, hi, ic].reshape(B, KVH, SEL_Q_BLOCK, n_keys, d)
        vg = vb[bi, hi, ic].reshape(B, KVH, SEL_Q_BLOCK, n_keys, d)
        kpos = (ic[..., None] * SEL_BLOCK + offs).reshape(B, KVH, SEL_Q_BLOCK, n_keys)
        qpos = start + jnp.arange(SEL_Q_BLOCK)
        dist = (qpos[None, None, :, None] - kpos).astype(jnp.float32)[:, :, None]
        s = jnp.einsum('bhgqd,bhqkd->bhgqk', qc, kg).astype(jnp.float32) * scale
        s = s - slopes[None, :, :, None, None] * dist
        s = jnp.where(dist >= 0, s, -jnp.inf)
        p = jax.nn.softmax(s, axis=-1)
        return jnp.einsum('bhgqk,bhqkd->bhgqd', p.astype(vg.dtype), vg)

    out = lax.map(chunk, jnp.arange(T // SEL_Q_BLOCK) * SEL_Q_BLOCK)
    return out.transpose(1, 2, 3, 0, 4, 5).reshape(B, KVH, G, T, d)


def window_attention(q, k, v, slopes):
    B, KVH, G, T, d = q.shape
    scale = NSA_HEAD_DIM ** -0.5
    span = WINDOW + Q_BLOCK
    kp = jnp.pad(k, ((0, 0), (0, 0), (WINDOW, 0), (0, 0)))
    vp = jnp.pad(v, ((0, 0), (0, 0), (WINDOW, 0), (0, 0)))

    def block(start):
        qb = lax.dynamic_slice_in_dim(q, start, Q_BLOCK, axis=3)
        kbk = lax.dynamic_slice_in_dim(kp, start, span, axis=2)
        vbk = lax.dynamic_slice_in_dim(vp, start, span, axis=2)
        qpos = start + jnp.arange(Q_BLOCK)
        kpos = start - WINDOW + jnp.arange(span)
        dist = (qpos[:, None] - kpos[None, :]).astype(jnp.float32)
        valid = (dist >= 0) & (dist < WINDOW) & (kpos[None, :] >= 0)
        s = jnp.einsum('bhgqd,bhkd->bhgqk', qb, kbk).astype(jnp.float32) * scale
        s = s - slopes[None, :, :, None, None] * dist
        s = jnp.where(valid, s, -jnp.inf)
        p = jax.nn.softmax(s, axis=-1)
        return jnp.einsum('bhgqk,bhkd->bhgqd', p.astype(vbk.dtype), vbk)

    out = lax.map(block, jnp.arange(T // Q_BLOCK) * Q_BLOCK)
    return out.transpose(1, 2, 3, 0, 4, 5).reshape(B, KVH, G, T, d)


def setup_inputs(seed: int = 0) -> dict:
    key = jax.random.key(seed)
    ks = jax.random.split(key, 20)
    f32 = jnp.float32
    nrm = lambda k, shape, s: jax.random.normal(k, shape, f32) * s
    return {
        'x': nrm(ks[0], (BATCH, SEQ, D_MODEL), 1.0),
        'norm_g': 1.0 + nrm(ks[1], (DEPTH, D_MODEL), 0.02),
        'w_in': nrm(ks[2], (DEPTH, D_MODEL, IN_COLS), D_MODEL ** -0.5),
        'diff_q_norm_g': 1.0 + nrm(ks[3], (DEPTH, DIFF_QK_DIM), 0.02),
        'diff_k_norm_g': 1.0 + nrm(ks[4], (DEPTH, DIFF_QK_DIM), 0.02),
        'diff_lambda_q1': nrm(ks[5], (DEPTH, DIFF_QK_DIM), 0.1),
        'diff_lambda_k1': nrm(ks[6], (DEPTH, DIFF_QK_DIM), 0.1),
        'diff_lambda_q2': nrm(ks[7], (DEPTH, DIFF_QK_DIM), 0.1),
        'diff_lambda_k2': nrm(ks[8], (DEPTH, DIFF_QK_DIM), 0.1),
        'diff_subln_g': 1.0 + nrm(ks[9], (DEPTH, DIFF_V_DIM), 0.02),
        'nsa_q_norm_g': 1.0 + nrm(ks[10], (DEPTH, NSA_HEAD_DIM), 0.02),
        'nsa_k_norm_g': 1.0 + nrm(ks[11], (DEPTH, 3, NSA_HEAD_DIM), 0.02),
        'cmp_pos': nrm(ks[12], (DEPTH, 2, CMP_BLOCK, NSA_HEAD_DIM), 0.1),
        'cmp_w1': nrm(ks[13], (DEPTH, 2, CMP_BLOCK * NSA_HEAD_DIM, CMP_HIDDEN), (CMP_BLOCK * NSA_HEAD_DIM) ** -0.5),
        'cmp_b1': nrm(ks[14], (DEPTH, 2, CMP_HIDDEN), 0.01),
        'cmp_w2': nrm(ks[15], (DEPTH, 2, CMP_HIDDEN, NSA_HEAD_DIM), CMP_HIDDEN ** -0.5),
        'w_out': nrm(ks[16], (DEPTH, D_MIX, D_MODEL), D_MIX ** -0.5),
    }


def reference(x, norm_g, w_in, diff_q_norm_g, diff_k_norm_g, diff_lambda_q1, diff_lambda_k1,
              diff_lambda_q2, diff_lambda_k2, diff_subln_g, nsa_q_norm_g, nsa_k_norm_g,
              cmp_pos, cmp_w1, cmp_b1, cmp_w2, w_out):
    B, T, _ = x.shape
    f32 = jnp.float32
    diff_slopes = alibi_slopes(DIFF_HEADS)
    nsa_slopes = alibi_slopes(NSA_HEADS).reshape(NSA_KV_HEADS, NSA_GROUP)
    for layer in range(DEPTH):
        lam_init = 0.8 - 0.6 * math.exp(-0.3 * layer)
        h = rms_norm(x, norm_g[layer])
        proj = h @ w_in[layer]
        dq, dk, dv, dz, nq, nkv, nz, ng = jnp.split(proj, IN_SPLITS, axis=-1)

        dq = rms_norm(dq.reshape(B, T, DIFF_HEADS, 2, DIFF_QK_DIM).transpose(0, 2, 3, 1, 4), diff_q_norm_g[layer])
        dk = rms_norm(dk.reshape(B, T, DIFF_HEADS, 2, DIFF_QK_DIM).transpose(0, 2, 3, 1, 4), diff_k_norm_g[layer])
        dv = dv.reshape(B, T, DIFF_HEADS, DIFF_V_DIM).transpose(0, 2, 1, 3)
        lam = (jnp.exp(jnp.sum(diff_lambda_q1[layer].astype(f32) * diff_lambda_k1[layer].astype(f32)))
               - jnp.exp(jnp.sum(diff_lambda_q2[layer].astype(f32) * diff_lambda_k2[layer].astype(f32)))
               + lam_init)
        o_diff = diff_attention(dq, dk, dv, lam, diff_slopes)
        o_diff = rms_norm(o_diff, diff_subln_g[layer]) * (1.0 - lam_init)
        o_diff = o_diff.transpose(0, 2, 1, 3).reshape(B, T, DIFF_WIDTH) * jax.nn.silu(dz)

        nq = rms_norm(nq.reshape(B, T, NSA_KV_HEADS, NSA_GROUP, NSA_HEAD_DIM).transpose(0, 2, 3, 1, 4),
                      nsa_q_norm_g[layer])
        nkv = nkv.reshape(B, T, 6, NSA_KV_HEADS, NSA_HEAD_DIM).transpose(2, 0, 3, 1, 4)
        kc = compress(nkv[0], cmp_pos[layer, 0], cmp_w1[layer, 0], cmp_b1[layer, 0], cmp_w2[layer, 0])
        vc = compress(nkv[1], cmp_pos[layer, 1], cmp_w1[layer, 1], cmp_b1[layer, 1], cmp_w2[layer, 1])
        kc = rms_norm(kc, nsa_k_norm_g[layer, 0])
        k_slc = rms_norm(nkv[2], nsa_k_norm_g[layer, 1])
        k_win = rms_norm(nkv[4], nsa_k_norm_g[layer, 2])
        o_cmp, p_cmp = compressed_attention(nq, kc, vc)
        sel_idx = select_blocks(p_cmp)
        o_slc = selected_attention(nq, k_slc, nkv[3], sel_idx, nsa_slopes)
        o_win = window_attention(nq, k_win, nkv[5], nsa_slopes)
        g = jax.nn.sigmoid(ng.astype(f32)).astype(x.dtype)
        g = g.reshape(B, T, 3, NSA_KV_HEADS, NSA_GROUP).transpose(2, 0, 3, 4, 1)[..., None]
        o_nsa = g[0] * o_cmp + g[1] * o_slc + g[2] * o_win
        o_nsa = o_nsa.transpose(0, 3, 1, 2, 4).reshape(B, T, NSA_WIDTH) * jax.nn.silu(nz)

        x = x + jnp.concatenate([o_diff, o_nsa], axis=-1) @ w_out[layer]
    return x
```

```cpp
#include <hip/hip_runtime.h>
#include <hip/hip_cooperative_groups.h>
#include <cstdio>
#include <cstdint>
#include <cmath>
namespace pg8 {
#define PG8_LAS __attribute__((address_space(3)))
typedef unsigned short bf16_t;
typedef short bf16x8 __attribute__((ext_vector_type(8)));
typedef float f32x4 __attribute__((ext_vector_type(4)));
typedef unsigned u32x4 __attribute__((ext_vector_type(4)));
constexpr int BM = 256, BK = 64, HALF = 128, HTB = HALF * BK * 2  , STAGE_BYTES = 8 * HTB, NXCD = 8, WGM = 8;

__host__ __device__ __forceinline__ int lds_byte(int r, int c) { const int st = (r >> 4) * 2 + (c >> 5), rr = r & 15, cc = c & 31, ob = rr * 64 + cc * 2; return st * 1024 + (ob ^ (((ob >> 9) & 1) << 5)); }
__host__ __device__ __forceinline__ void stage_rc(int b, int& R, int& C) { const int st = b / 1024, sb = b % 1024, swz = sb ^ (((sb >> 9) & 1) << 5); R = (st >> 1) * 16 + swz / 64; C = (st & 1) * 32 + (swz % 64) / 2; }
__host__ __device__ __forceinline__ int perm32(int rho) { const int n = rho >> 4, i = rho & 15; return 8 * (i >> 2) + 4 * n + (i & 3); }

struct Unit { int pm, pn; };
struct Gemm { const bf16_t* A; const bf16_t* Bt; int M, N, K; };

struct StaticOrder {
    int nM, nN, nwg, G, c;
    __host__ __device__ void init(int M, int N, int G_, int c_) { nM = M / BM; nN = N / BM; nwg = nM * nN; G = G_; c = c_; }
    __host__ __device__ bool next(int i, Unit& u) const {
        const long L = (long)i * G + c; if (L >= nwg) return false;
        int wgid = (int)L; { const int q = nwg / NXCD, r = nwg % NXCD, xcd = wgid % NXCD, off = wgid / NXCD; wgid = (xcd < r ? xcd * (q + 1) : r * (q + 1) + (xcd - r) * q) + off; }
        const int nig = WGM * nN, gid = wgid / nig, fm = gid * WGM, gsz = (nM - fm) < WGM ? (nM - fm) : WGM;
        u.pm = fm + ((wgid % nig) % gsz); u.pn = (wgid % nig) / gsz; return true;
    }
    __device__ __forceinline__ void a_ready(const Unit&) const {}
    __device__ __forceinline__ void done(const Unit&) const {}
};

template <class Epi, class Sched, bool ALIGN_EPI = false, bool SP2 = false>
__device__ __forceinline__ void gemm_phase(PG8_LAS unsigned char* lds, const Gemm g, const Sched& S, const Epi& E, const int wid) {
    unsigned z_; asm volatile("v_mov_b32 %0, 0" : "=v"(z_));
    const int tid = wid * 64 + (int)__builtin_amdgcn_mbcnt_hi(~0u, __builtin_amdgcn_mbcnt_lo(~0u, z_)), lane = tid & 63, wr = wid >> 2, wc = wid & 3, fr = lane & 15, fq = lane >> 4;
    const int K = g.K, nt = K / BK;
    unsigned voffA[2], voffB[2];
#pragma unroll
    for (int i = 0; i < 2; ++i) { int R, C; stage_rc(tid * 16 + i * 8192, R, C); const int Rb = Epi::PERM ? ((R & ~31) + perm32(R & 31)) : R;
        voffA[i] = (unsigned)(R * K + C) * 2u; voffB[i] = (unsigned)(Rb * K + C) * 2u; }
    const size_t kstep = (size_t)(BK * 2);
    const size_t hstep = (size_t)HALF * K * 2;
    const size_t tstep = 2 * hstep;
    const unsigned ldsw = (unsigned)wid * 1024u;
    const int aoff = lds_byte(wr * 64 + fr, fq * 8), boff = lds_byte(wc * 32 + fr, fq * 8);
#define PG8_SA(b, h) (((b) * 2 + (h)) * HTB)
#define PG8_SB(b, h) ((4 + (b) * 2 + (h)) * HTB)
#define PG8_STAGE(bufoff, gbase, voff) do { _Pragma("unroll") for (int _i = 0; _i < 2; ++_i) \
        __builtin_amdgcn_global_load_lds((const unsigned*)((const char*)(gbase) + (voff)[_i]), (PG8_LAS unsigned*)(lds + (bufoff) + ldsw + _i * 8192), 16, 0, 0); } while (0)
#define PG8_LDA(dst, b, h) do { _Pragma("unroll") for (int m = 0; m < 4; ++m) _Pragma("unroll") for (int k = 0; k < 2; ++k) dst[m][k] = *(const PG8_LAS bf16x8*)(lds + PG8_SA(b, h) + aoff + m * 2048 + k * 1024); } while (0)
#define PG8_LDB(dst, b, h) do { _Pragma("unroll") for (int n = 0; n < 2; ++n) _Pragma("unroll") for (int k = 0; k < 2; ++k) dst[n][k] = *(const PG8_LAS bf16x8*)(lds + PG8_SB(b, h) + boff + n * 2048 + k * 1024); } while (0)
#define PG8_MMA(ai, bj, At, Bt) do { __builtin_amdgcn_s_setprio(1); _Pragma("unroll") for (int m = 0; m < 4; ++m) _Pragma("unroll") for (int n = 0; n < 2; ++n) _Pragma("unroll") for (int k = 0; k < 2; ++k) \
        acc[ai][bj][m][n] = __builtin_amdgcn_mfma_f32_16x16x32_bf16(Bt[n][k], At[m][k], acc[ai][bj][m][n], 0, 0, 0); __builtin_amdgcn_s_setprio(0); } while (0)
#define PG8_WAIT_V(n) asm volatile("s_waitcnt vmcnt(" #n ")" ::: "memory")
#define PG8_WAIT_L(n) asm volatile("s_waitcnt lgkmcnt(" #n ")" ::: "memory")
#define PG8_BAR __builtin_amdgcn_s_barrier()
#define PG8_SCHED __builtin_amdgcn_sched_barrier(0)
    Unit cur, nxt; int ui = 0;
    if (!S.next(0, cur)) return;
    f32x4 acc[2][2][4][2];
#pragma unroll
    for (int a = 0; a < 2; ++a)
#pragma unroll
        for (int b = 0; b < 2; ++b)
#pragma unroll
            for (int m = 0; m < 4; ++m)
#pragma unroll
                for (int n = 0; n < 2; ++n) acc[a][b][m][n] = (f32x4){0.f, 0.f, 0.f, 0.f};
    bf16x8 At[4][2], B0[2][2], B1[2][2];
    const char* cA = (const char*)g.A + (size_t)cur.pm * tstep; const char* cB = (const char*)g.Bt + (size_t)cur.pn * tstep;
    S.a_ready(cur);
    if constexpr (SP2) {
        PG8_STAGE(PG8_SB(0, 0), cB, voffB); PG8_STAGE(PG8_SB(0, 1), cB + hstep, voffB); PG8_STAGE(PG8_SA(0, 0), cA, voffA); PG8_STAGE(PG8_SA(0, 1), cA + hstep, voffA);
        if (wr == 1) PG8_BAR;
        PG8_WAIT_V(2); PG8_BAR;
        PG8_STAGE(PG8_SB(1, 0), cB + kstep, voffB); PG8_STAGE(PG8_SA(1, 0), cA + kstep, voffA); PG8_STAGE(PG8_SB(1, 1), cB + hstep + kstep, voffB);
        PG8_WAIT_V(6); PG8_BAR;
    } else {
        PG8_STAGE(PG8_SB(0, 0), cB, voffB); PG8_STAGE(PG8_SA(0, 0), cA, voffA); PG8_STAGE(PG8_SB(0, 1), cB + hstep, voffB); PG8_STAGE(PG8_SA(0, 1), cA + hstep, voffA);
        if (wr == 1) PG8_BAR;
        PG8_WAIT_V(4); PG8_BAR;
        PG8_STAGE(PG8_SB(1, 0), cB + kstep, voffB); PG8_STAGE(PG8_SA(1, 0), cA + kstep, voffA); PG8_STAGE(PG8_SB(1, 1), cB + hstep + kstep, voffB);
        PG8_WAIT_V(6); PG8_BAR;
    }
    for (;;) {
        const bool has_next = S.next(ui + 1, nxt);
        const char* nA = has_next ? (const char*)g.A + (size_t)nxt.pm * tstep : cA; const char* nB = has_next ? (const char*)g.Bt + (size_t)nxt.pn * tstep : cB;
        for (int t = 0; t < nt; t += 2) {
            const bool last = (t == nt - 2);
            const char* a1 = cA + (size_t)(t + 1) * kstep;
            const char* a2 = last ? nA : cA + (size_t)(t + 2) * kstep; const char* b2 = last ? nB : cB + (size_t)(t + 2) * kstep;
            const char* a3 = a2 + kstep; const char* b3 = b2 + kstep;
            if (last && has_next) S.a_ready(nxt);
            if constexpr (SP2) {
            PG8_LDB(B0, 0, 0); PG8_LDB(B1, 0, 1); PG8_SCHED; PG8_LDA(At, 0, 0); PG8_STAGE(PG8_SA(1, 1), a1 + hstep, voffA);
            PG8_WAIT_V(8); PG8_WAIT_L(0); PG8_BAR; PG8_MMA(0, 0, At, B0); PG8_MMA(0, 1, At, B1); PG8_BAR; PG8_SCHED;
            PG8_LDA(At, 0, 1); PG8_STAGE(PG8_SB(0, 0), b2, voffB); PG8_STAGE(PG8_SB(0, 1), b2 + hstep, voffB); PG8_STAGE(PG8_SA(0, 0), a2, voffA);
            PG8_WAIT_V(8); PG8_WAIT_L(0); PG8_BAR; PG8_MMA(1, 0, At, B0); PG8_MMA(1, 1, At, B1); PG8_BAR; PG8_SCHED;
            PG8_LDB(B0, 1, 0); PG8_LDB(B1, 1, 1); PG8_SCHED; PG8_LDA(At, 1, 0); PG8_STAGE(PG8_SA(0, 1), a2 + hstep, voffA);
            PG8_WAIT_V(8); PG8_WAIT_L(0); PG8_BAR; PG8_MMA(0, 0, At, B0); PG8_MMA(0, 1, At, B1); PG8_BAR; PG8_SCHED;
            PG8_LDA(At, 1, 1); PG8_STAGE(PG8_SB(1, 0), b3, voffB); PG8_STAGE(PG8_SB(1, 1), b3 + hstep, voffB); PG8_STAGE(PG8_SA(1, 0), a3, voffA);
            PG8_WAIT_V(8); PG8_WAIT_L(0); PG8_BAR; PG8_MMA(1, 0, At, B0); PG8_MMA(1, 1, At, B1); PG8_BAR; PG8_SCHED;
            } else {
            PG8_LDB(B0, 0, 0); PG8_SCHED; PG8_LDA(At, 0, 0); PG8_STAGE(PG8_SA(1, 1), a1 + hstep, voffA);
            PG8_WAIT_L(8); PG8_BAR; PG8_WAIT_L(0); PG8_MMA(0, 0, At, B0); PG8_BAR; PG8_SCHED;
            PG8_LDB(B1, 0, 1); PG8_STAGE(PG8_SB(0, 0), b2, voffB);
            PG8_BAR; PG8_WAIT_L(0); PG8_MMA(0, 1, At, B1); PG8_BAR;
            PG8_LDA(At, 0, 1); PG8_STAGE(PG8_SA(0, 0), a2, voffA);
            PG8_BAR; PG8_WAIT_L(0); PG8_MMA(1, 0, At, B0); PG8_BAR; PG8_SCHED;
            PG8_STAGE(PG8_SB(0, 1), b2 + hstep, voffB);
            PG8_WAIT_V(6); PG8_BAR; PG8_MMA(1, 1, At, B1); PG8_BAR;
            PG8_LDB(B0, 1, 0); PG8_SCHED; PG8_LDA(At, 1, 0); PG8_STAGE(PG8_SA(0, 1), a2 + hstep, voffA);
            PG8_WAIT_L(8); PG8_BAR; PG8_WAIT_L(0); PG8_MMA(0, 0, At, B0); PG8_BAR; PG8_SCHED;
            PG8_LDB(B1, 1, 1); PG8_STAGE(PG8_SB(1, 0), b3, voffB);
            PG8_BAR; PG8_WAIT_L(0); PG8_MMA(0, 1, At, B1); PG8_BAR;
            PG8_LDA(At, 1, 1); PG8_STAGE(PG8_SA(1, 0), a3, voffA);
            PG8_BAR; PG8_WAIT_L(0); PG8_MMA(1, 0, At, B0); PG8_BAR; PG8_SCHED;
            PG8_STAGE(PG8_SB(1, 1), b3 + hstep, voffB);
            PG8_WAIT_V(6); PG8_BAR; PG8_MMA(1, 1, At, B1); PG8_BAR;
            }
        }
        if constexpr (ALIGN_EPI) { if (wr == 0) PG8_BAR; }
        if constexpr (!Epi::AFTER_DRAIN) { E(acc, cur, wr, wc, fr, fq); S.done(cur); }
        if (!has_next) break;
#pragma unroll
        for (int a = 0; a < 2; ++a)
#pragma unroll
            for (int b = 0; b < 2; ++b)
#pragma unroll
                for (int m = 0; m < 4; ++m)
#pragma unroll
                    for (int n = 0; n < 2; ++n) acc[a][b][m][n] = (f32x4){0.f, 0.f, 0.f, 0.f};
        cur = nxt; cA = nA; cB = nB; ++ui;
        if constexpr (ALIGN_EPI) { if (wr == 1) PG8_BAR; }
    }
    PG8_WAIT_V(0);
    if constexpr (!ALIGN_EPI) { if (wr == 0) PG8_BAR; }
    PG8_BAR;
    if constexpr (Epi::AFTER_DRAIN) { E.fused(acc, cur, wr, wc, fr, fq, lds, wid, lane); S.done(cur); }
#undef PG8_SA
#undef PG8_SB
#undef PG8_STAGE
#undef PG8_LDA
#undef PG8_LDB
#undef PG8_MMA
#undef PG8_WAIT_V
#undef PG8_WAIT_L
#undef PG8_BAR
#undef PG8_SCHED
}
}

#ifndef HY_N_LAUNCHES
#define HY_N_LAUNCHES 5
#endif

namespace hy {
namespace cg = cooperative_groups;
#define LAS __attribute__((address_space(3)))
typedef unsigned short bf16_t;
typedef short bf16x8 __attribute__((ext_vector_type(8)));
typedef short s16x4 __attribute__((ext_vector_type(4)));
typedef float f32x4 __attribute__((ext_vector_type(4)));
typedef float f32x16 __attribute__((ext_vector_type(16)));
typedef unsigned u32x4 __attribute__((ext_vector_type(4)));
typedef unsigned u32x2 __attribute__((ext_vector_type(2)));
typedef LAS unsigned char* ldsp;

constexpr int BATCH = 32, T = 2048, D = 1024, M = BATCH * T;
constexpr int NIN = 3864, NPAD = 4096, LDP = 3904;
constexpr int C_DQ = 0, C_DK = 512, C_DV = 1024, C_DZ = 1536, C_NQ = 2048, C_NKV = 2560, C_NZ = 3328, C_NG = 3840;
constexpr float EPS = 1e-6f;
constexpr float LOG2E = 1.4426950408889634f;
constexpr float QSCALE = 0.125f * LOG2E;
constexpr float MCOEF = QSCALE * 64.0f;
constexpr float LAM_INIT = 0.2f;

constexpr size_t MiB = 1u << 20;
constexpr size_t WS_CTL = 0, CTL_BYTES = 1 * MiB;
constexpr size_t WS_WIN = 2 * MiB;
constexpr size_t WS_WOUT = 12 * MiB;
constexpr size_t WS_W1T = 14 * MiB;
constexpr size_t WS_W2T = 16 * MiB;
constexpr size_t WS_B1P = 16 * MiB + 256 * 1024;
constexpr size_t WS_KC = 17 * MiB;
constexpr size_t WS_VC = 18 * MiB;
constexpr size_t WS_XN = 32 * MiB;
constexpr size_t WS_AOUT = 160 * MiB;
constexpr size_t WS_PROJ = 288 * MiB;
constexpr size_t WS_END = 776 * MiB;
constexpr int CW_QCTR = 64;

constexpr int LDS_BYTES = 147456;
constexpr int KCS = 1040, KSLOT = 8 * KCS, DHS = 4160;
constexpr int L_GB = 66560, L_TB = L_GB + 33792, L_WSF = L_TB + 33792, L_LB = L_WSF + 2048, L_MISC = L_LB + 1024;
static_assert(L_MISC + 256 <= LDS_BYTES, "LDS map");

struct Args { const float* in[17]; float* out; unsigned char* ws; int ph_lo, ph_hi; };

#define LDS_FENCE() do { asm volatile("s_waitcnt lgkmcnt(0)" ::: "memory"); __builtin_amdgcn_wave_barrier(); } while (0)

__device__ __forceinline__ unsigned cvtpk(float lo, float hi) {
    typedef float f2_t __attribute__((ext_vector_type(2))); typedef __bf16 b2_t __attribute__((ext_vector_type(2)));
    f2_t v = {lo, hi}; b2_t b = __builtin_convertvector(v, b2_t); return __builtin_bit_cast(unsigned, b);
}
__device__ __forceinline__ int hy_tid(int wave) { unsigned z; asm volatile("v_mov_b32 %0, 0" : "=v"(z)); return wave * 64 + (int)__builtin_amdgcn_mbcnt_hi(~0u, __builtin_amdgcn_mbcnt_lo(~0u, z)); }
__device__ __forceinline__ float bf2f(unsigned short u) { return __builtin_bit_cast(float, (unsigned)u << 16); }
__device__ __forceinline__ float wave_sum(float v) {
#pragma unroll
    for (int o = 1; o < 64; o <<= 1) v += __shfl_xor(v, o);
    return v;
}
__device__ __forceinline__ float wave_max(float v) {
#pragma unroll
    for (int o = 1; o < 64; o <<= 1) v = fmaxf(v, __shfl_xor(v, o));
    return v;
}
__device__ __forceinline__ float siluf(float v) { return v / (1.0f + __expf(-v)); }
__device__ __forceinline__ float sigmf(float v) { return 1.0f / (1.0f + __expf(-v)); }

__device__ __forceinline__ void transpose_item(const float* W, int ldw, int ncols, int n0, int k0, bf16_t* WT, int K, int p0, LAS float* scr, int lane) {
#pragma unroll 8
    for (int i = 0; i < 32; ++i) {
        const int kk = 2 * i + (lane >> 5), nn = lane & 31, n = n0 + nn;
#ifdef HY_T_NOLOAD
        scr[kk * 33 + nn] = (float)n;
#else
        scr[kk * 33 + nn] = (n < ncols) ? W[(size_t)(k0 + kk) * ldw + n] : 0.f;
#endif
    }
    LDS_FENCE();
    const int c = lane & 7;
#pragma unroll
    for (int j = 0; j < 4; ++j) {
        const int n = (lane >> 3) + 8 * j; const LAS float* s = scr + (8 * c) * 33 + n;
        u32x4 o; o.x = cvtpk(s[0 * 33], s[1 * 33]); o.y = cvtpk(s[2 * 33], s[3 * 33]); o.z = cvtpk(s[4 * 33], s[5 * 33]); o.w = cvtpk(s[6 * 33], s[7 * 33]);
#ifdef HY_T_NOSTORE
        if (o.x == 0x12345678u) *(u32x4*)(WT) = o;
#else
        *(u32x4*)(WT + (size_t)(p0 + n) * K + k0 + 8 * c) = o;
#endif
    }
    LDS_FENCE();
}
__device__ __forceinline__ void rms_row(const float* xrow, const float* g, bf16_t* orow, int lane) {
    const f32x4* xr = (const f32x4*)xrow + lane; const f32x4* gr = (const f32x4*)g + lane;
    f32x4 v[4]; float s = 0.f;
#pragma unroll
    for (int j = 0; j < 4; ++j) { v[j] = xr[64 * j]; s += (v[j].x * v[j].x + v[j].y * v[j].y) + (v[j].z * v[j].z + v[j].w * v[j].w); }
    const float r = 1.0f / sqrtf(wave_sum(s) * (1.f / D) + EPS);
    u32x2* o8 = (u32x2*)orow + lane;
#pragma unroll
    for (int j = 0; j < 4; ++j) { const f32x4 gj = gr[64 * j]; const f32x4 y = (v[j] * r) * gj; u32x2 w; w.x = cvtpk(y.x, y.y); w.y = cvtpk(y.z, y.w); o8[64 * j] = w; }
}
__device__ __forceinline__ void p0_prologue(const Args& A, ldsp lds, int vcu, int G, int wave, int lane) {
    LAS float* scr = (LAS float*)(lds + wave * 16384);
    unsigned char* ws = A.ws;
    const int gw = vcu * 8 + wave, NGW = G * 8;
    constexpr int I_WIN = (NPAD / 32) * (D / 64), I_WOUT = (D / 32) * (D / 64), I_W1 = (256 / 32) * (2048 / 64), I_W2 = (64 / 32) * (256 / 64), I_B1 = 2 * 4 * 8;
    constexpr int NITEMS = I_WIN + I_WOUT + 2 * I_W1 + 2 * I_W2 + I_B1;
#ifndef HY_P0_SKIP_T
#ifndef HY_IT_LO
#define HY_IT_LO 0
#define HY_IT_HI NITEMS
#endif
    for (int it = gw; it < NITEMS; it += NGW) {
        int r = it;
        if (it < (HY_IT_LO) || it >= (HY_IT_HI)) continue;
#ifdef HY_WAVE_LT
        if (wave >= (HY_WAVE_LT)) continue;
#endif
        if (r < I_WIN) { const int nb = r / (D / 64), kb = r % (D / 64), p0 = 32 * nb;
            const int n0 = 256 * (p0 >> 8) + 64 * ((p0 >> 5) & 3) + 32 * ((p0 >> 7) & 1);
            transpose_item(A.in[2], NIN, NIN, n0, 64 * kb, (bf16_t*)(ws + WS_WIN), D, p0, scr, lane); continue; }
        r -= I_WIN;
        if (r < I_WOUT) { const int nb = r / (D / 64), kb = r % (D / 64); transpose_item(A.in[16], D, D, 32 * nb, 64 * kb, (bf16_t*)(ws + WS_WOUT), D, 32 * nb, scr, lane); continue; }
        r -= I_WOUT;
        if (r < 2 * I_W1) { const int wh = r / I_W1, q = r % I_W1, nb = q / 32, kb = q % 32;
            transpose_item(A.in[13] + (size_t)wh * 2048 * 256, 256, 256, 32 * nb, 64 * kb, (bf16_t*)(ws + WS_W1T) + (size_t)wh * 256 * 2048, 2048, 32 * nb, scr, lane); continue; }
        r -= 2 * I_W1;
        if (r < 2 * I_W2) { const int wh = r / I_W2, q = r % I_W2, nb = q / 4, kb = q % 4;
            transpose_item(A.in[15] + (size_t)wh * 256 * 64, 64, 64, 32 * nb, 64 * kb, (bf16_t*)(ws + WS_W2T) + (size_t)wh * 64 * 256, 256, 32 * nb, scr, lane); continue; }
        r -= 2 * I_W2;
        {
            const int wh = r >> 5, ng = (r >> 3) & 3, ksl = r & 7;
            const float* pos = A.in[12] + (size_t)wh * 2048 + ksl * 256; const float* w1 = A.in[13] + (size_t)wh * 2048 * 256 + (size_t)(ksl * 256) * 256 + ng * 64 + lane;
            float acc = 0.f;
#pragma unroll 8
            for (int k = 0; k < 256; ++k) acc = fmaf(pos[k], w1[(size_t)k * 256], acc);
            ((float*)(ws + WS_B1P))[(wh * 8 + ksl) * 256 + ng * 64 + lane] = acc;
        }
    }
#endif
#ifndef HY_P0_SKIP_R
    for (int m = gw; m < M; m += NGW) rms_row(A.in[0] + (size_t)m * D, A.in[1], (bf16_t*)(ws + WS_XN) + (size_t)m * D, lane);
#endif
}

struct EpiIn {
    static constexpr bool PERM = true, AFTER_DRAIN = false;
    bf16_t* P; const float* gq_d; const float* gk_d; const float* gq_n; const float* gk_n3;
    __device__ __forceinline__ void operator()(const f32x4 (&acc)[2][2][4][2], const pg8::Unit& u, int wr, int wc, int fr, int fq) const {
        const int G = u.pn * 4 + wc;
        if (G > 60) return;
        int kind = 0; const float* g = nullptr; float post = 1.f;
        if (G < 8) { kind = 1; g = gq_d; post = QSCALE; }
        else if (G < 16) { kind = 1; g = gk_d; }
        else if (G < 24) { kind = 0; }
        else if (G < 32) { kind = 2; }
        else if (G < 40) { kind = 1; g = gq_n; post = QSCALE; }
        else if (G < 52) { const int wh = (G - 40) >> 1; if (wh == 2) { kind = 1; g = gk_n3 + 64; } else if (wh == 4) { kind = 1; g = gk_n3 + 128; } }
        else if (G < 60) { kind = 2; }
        else { kind = 3; }
        f32x4 gv[2][2];
#pragma unroll
        for (int bj = 0; bj < 2; ++bj)
#pragma unroll
            for (int n = 0; n < 2; ++n) gv[bj][n] = (kind == 1) ? (*(const f32x4*)(g + 32 * bj + 8 * fq + 4 * n)) * post : (f32x4){1.f, 1.f, 1.f, 1.f};
        bf16_t* base = P + (size_t)(u.pm * 256 + wr * 64 + fr) * LDP + G * 64 + 8 * fq;
#pragma unroll
        for (int ai = 0; ai < 2; ++ai)
#pragma unroll
            for (int m = 0; m < 4; ++m) {
                f32x4 v[2][2];
#pragma unroll
                for (int bj = 0; bj < 2; ++bj)
#pragma unroll
                    for (int n = 0; n < 2; ++n) v[bj][n] = acc[ai][bj][m][n];
                if (kind == 1) {
                    float ss = 0.f;
#pragma unroll
                    for (int bj = 0; bj < 2; ++bj)
#pragma unroll
                        for (int n = 0; n < 2; ++n) { const f32x4 x = v[bj][n]; ss += (x[0] * x[0] + x[1] * x[1]) + (x[2] * x[2] + x[3] * x[3]); }
                    ss += __shfl_xor(ss, 16); ss += __shfl_xor(ss, 32);
                    const float r = 1.0f / sqrtf(ss * (1.f / 64.f) + EPS);
#pragma unroll
                    for (int bj = 0; bj < 2; ++bj)
#pragma unroll
                        for (int n = 0; n < 2; ++n) v[bj][n] = (v[bj][n] * r) * gv[bj][n];
                } else if (kind == 2) {
#pragma unroll
                    for (int bj = 0; bj < 2; ++bj)
#pragma unroll
                        for (int n = 0; n < 2; ++n)
#pragma unroll
                            for (int e = 0; e < 4; ++e) v[bj][n][e] = siluf(v[bj][n][e]);
                } else if (kind == 3) {
#pragma unroll
                    for (int bj = 0; bj < 2; ++bj)
#pragma unroll
                        for (int n = 0; n < 2; ++n)
#pragma unroll
                            for (int e = 0; e < 4; ++e) v[bj][n][e] = sigmf(v[bj][n][e]);
                }
                bf16_t* rowp = base + (size_t)(ai * 128 + m * 16) * LDP;
#pragma unroll
                for (int bj = 0; bj < 2; ++bj) {
                    u32x4 w; w.x = cvtpk(v[bj][0][0], v[bj][0][1]); w.y = cvtpk(v[bj][0][2], v[bj][0][3]); w.z = cvtpk(v[bj][1][0], v[bj][1][1]); w.w = cvtpk(v[bj][1][2], v[bj][1][3]);
                    *(u32x4*)(rowp + 32 * bj) = w;
                }
            }
    }
};
struct EpiOut {
    static constexpr bool PERM = false, AFTER_DRAIN = false;
    const float* x; float* out;
    __device__ __forceinline__ void operator()(const f32x4 (&acc)[2][2][4][2], const pg8::Unit& u, int wr, int wc, int fr, int fq) const {
        const int col0 = u.pn * 256 + wc * 32 + 4 * fq;
#pragma unroll
        for (int ai = 0; ai < 2; ++ai)
#pragma unroll
            for (int m = 0; m < 4; ++m) {
                const size_t off = (size_t)(u.pm * 256 + ai * 128 + wr * 64 + m * 16 + fr) * D + col0;
#pragma unroll
                for (int bj = 0; bj < 2; ++bj)
#pragma unroll
                    for (int n = 0; n < 2; ++n) { const f32x4 xv = *(const f32x4*)(x + off + bj * 128 + n * 16); *(f32x4*)(out + off + bj * 128 + n * 16) = xv + acc[ai][bj][m][n]; }
            }
    }
};

__device__ __forceinline__ void compress_phase(const Args& A, ldsp lds, int wave, int lane) {
    unsigned char* ws = A.ws;
    const bf16_t* PROJ = (const bf16_t*)(ws + WS_PROJ);
    LAS bf16_t* hbuf = (LAS bf16_t*)(lds) + wave * (16 * 264);
    const int fr = lane & 15, kq = lane >> 4;
    for (int uidx = blockIdx.x; uidx < 128; uidx += gridDim.x) {
        const int wh = uidx & 1, kvh = (uidx >> 1) & 1, b = uidx >> 2;
        const bf16_t* src = PROJ + (size_t)(b * T) * LDP + C_NKV + wh * 128 + kvh * 64;
        const bf16_t* w1t = (const bf16_t*)(ws + WS_W1T) + (size_t)wh * 256 * 2048;
        const bf16_t* w2t = (const bf16_t*)(ws + WS_W2T) + (size_t)wh * 64 * 256;
        const float* b1 = A.in[14] + wh * 256; const float* b1p = (const float*)(ws + WS_B1P) + wh * 8 * 256;
        const int i = wave * 16 + fr;
        f32x4 acc[16];
#pragma unroll
        for (int nt = 0; nt < 16; ++nt) acc[nt] = (f32x4){0.f, 0.f, 0.f, 0.f};
#pragma unroll 2
        for (int ks = 0; ks < 64; ++ks) {
            const int k0 = 32 * ks + 8 * kq; int tok = 16 * i + (k0 >> 6); tok = tok < T ? tok : T - 1;
            const bf16x8 a = *(const bf16x8*)(src + (size_t)tok * LDP + (k0 & 63));
#pragma unroll
            for (int nt = 0; nt < 16; ++nt) {
                const bf16x8 bb = *(const bf16x8*)(w1t + (size_t)(nt * 16 + fr) * 2048 + k0);
                acc[nt] = __builtin_amdgcn_mfma_f32_16x16x32_bf16(a, bb, acc[nt], 0, 0, 0);
            }
        }
#pragma unroll
        for (int nt = 0; nt < 16; ++nt) {
            const int col = 16 * nt + fr; float bias = b1[col];
#pragma unroll
            for (int s = 0; s < 8; ++s) bias += b1p[s * 256 + col];
#pragma unroll
            for (int rg = 0; rg < 4; ++rg) { const float hv = siluf(acc[nt][rg] + bias); hbuf[(4 * kq + rg) * 264 + col] = (bf16_t)(cvtpk(hv, hv) & 0xffffu); }
        }
        LDS_FENCE();
        f32x4 acc2[4];
#pragma unroll
        for (int nt = 0; nt < 4; ++nt) acc2[nt] = (f32x4){0.f, 0.f, 0.f, 0.f};
#pragma unroll
        for (int ks = 0; ks < 8; ++ks) {
            const bf16x8 a = *(const LAS bf16x8*)(hbuf + fr * 264 + 32 * ks + 8 * kq);
#pragma unroll
            for (int nt = 0; nt < 4; ++nt) {
                const bf16x8 bb = *(const bf16x8*)(w2t + (size_t)(nt * 16 + fr) * 256 + 32 * ks + 8 * kq);
                acc2[nt] = __builtin_amdgcn_mfma_f32_16x16x32_bf16(a, bb, acc2[nt], 0, 0, 0);
            }
        }
        LDS_FENCE();
        bf16_t* dst = (bf16_t*)(ws + (wh == 0 ? WS_KC : WS_VC)) + (size_t)((b * 2 + kvh) * 128) * 64;
        const float* gk = A.in[11];
#pragma unroll
        for (int rg = 0; rg < 4; ++rg) {
            const int io = wave * 16 + 4 * kq + rg;
            float v[4];
#pragma unroll
            for (int nt = 0; nt < 4; ++nt) v[nt] = acc2[nt][rg];
            if (wh == 0) {
                float ss = (v[0] * v[0] + v[1] * v[1]) + (v[2] * v[2] + v[3] * v[3]);
                ss += __shfl_xor(ss, 1); ss += __shfl_xor(ss, 2); ss += __shfl_xor(ss, 4); ss += __shfl_xor(ss, 8);
                const float r = 1.0f / sqrtf(ss * (1.f / 64.f) + EPS);
#pragma unroll
                for (int nt = 0; nt < 4; ++nt) v[nt] = (v[nt] * r) * gk[16 * nt + fr];
            }
#pragma unroll
            for (int nt = 0; nt < 4; ++nt) { const float ov = (io < 127) ? v[nt] : 0.f; dst[(size_t)io * 64 + 16 * nt + fr] = (bf16_t)(cvtpk(ov, ov) & 0xffffu); }
        }
    }
}

__device__ __forceinline__ int crow(int r, int hi) { return (r & 3) + 8 * (r >> 2) + 4 * hi; }
typedef short v4i16_t __attribute__((ext_vector_type(4)));
__device__ __forceinline__ s16x4 vtr(const LAS unsigned char* p) { return __builtin_bit_cast(s16x4, __builtin_amdgcn_ds_read_tr16_b64_v4i16((LAS v4i16_t*)p)); }

__device__ __forceinline__ void qk_tile(f32x16& p0, f32x16& p1, const LAS unsigned char* kslot, const bf16x8 (&qr)[4], float c0, float c1, int r32, int hi) {
#pragma unroll
    for (int r = 0; r < 16; ++r) { p0[r] = c0; p1[r] = c1; }
    const LAS unsigned char* kb = kslot + hi * KCS + r32 * 16;
#pragma unroll
    for (int d0 = 0; d0 < 4; ++d0) {
        const bf16x8 b0 = *(const LAS bf16x8*)(kb + d0 * 2 * KCS);
        const bf16x8 b1 = *(const LAS bf16x8*)(kb + d0 * 2 * KCS + 512);
        p0 = __builtin_amdgcn_mfma_f32_32x32x16_bf16(b0, qr[d0], p0, 0, 0, 0);
        p1 = __builtin_amdgcn_mfma_f32_32x32x16_bf16(b1, qr[d0], p1, 0, 0, 0);
    }
}
template <bool ALIBI>
__device__ __forceinline__ void sm_tile(f32x16& p0, f32x16& p1, float slope2, float& l, bool need_mask, int kbase, int kmin, int kmax) {
#pragma unroll
    for (int r = 0; r < 16; ++r) {
        const float cr = (float)((r & 3) + 8 * (r >> 2));
        if (ALIBI) { p0[r] = __builtin_amdgcn_exp2f(fmaf(slope2, cr, p0[r])); p1[r] = __builtin_amdgcn_exp2f(fmaf(slope2, cr, p1[r])); }
        else { p0[r] = __builtin_amdgcn_exp2f(p0[r]); p1[r] = __builtin_amdgcn_exp2f(p1[r]); }
    }
    if (need_mask) {
#pragma unroll
        for (int r = 0; r < 16; ++r) {
            const int kv = kbase + (r & 3) + 8 * (r >> 2);
            if (kv < kmin || kv > kmax) p0[r] = 0.f;
            if (kv + 32 < kmin || kv + 32 > kmax) p1[r] = 0.f;
        }
    }
    float s = 0.f;
#pragma unroll
    for (int r = 0; r < 16; ++r) s += p0[r] + p1[r];
    l += s;
}
template <int NDV>
__device__ __forceinline__ void pv_tile(f32x16 (&o)[NDV], const f32x16& p0, const f32x16& p1, const LAS unsigned char* vp) {
    bf16x8 pa[4];
    { u32x4 w;
      w.x = cvtpk(p0[0], p0[1]); w.y = cvtpk(p0[2], p0[3]); w.z = cvtpk(p0[4], p0[5]); w.w = cvtpk(p0[6], p0[7]); pa[0] = __builtin_bit_cast(bf16x8, w);
      w.x = cvtpk(p0[8], p0[9]); w.y = cvtpk(p0[10], p0[11]); w.z = cvtpk(p0[12], p0[13]); w.w = cvtpk(p0[14], p0[15]); pa[1] = __builtin_bit_cast(bf16x8, w);
      w.x = cvtpk(p1[0], p1[1]); w.y = cvtpk(p1[2], p1[3]); w.z = cvtpk(p1[4], p1[5]); w.w = cvtpk(p1[6], p1[7]); pa[2] = __builtin_bit_cast(bf16x8, w);
      w.x = cvtpk(p1[8], p1[9]); w.y = cvtpk(p1[10], p1[11]); w.z = cvtpk(p1[12], p1[13]); w.w = cvtpk(p1[14], p1[15]); pa[3] = __builtin_bit_cast(bf16x8, w); }
#pragma unroll
    for (int d0 = 0; d0 < NDV; ++d0)
#pragma unroll
        for (int ks = 0; ks < 4; ++ks) {
            const s16x4 lo = vtr(vp + d0 * DHS + ks * 1024), hh = vtr(vp + d0 * DHS + ks * 1024 + 512);
            const bf16x8 vb = (bf16x8){lo[0], lo[1], lo[2], lo[3], hh[0], hh[1], hh[2], hh[3]};
            o[d0] = __builtin_amdgcn_mfma_f32_32x32x16_bf16(pa[ks], vb, o[d0], 0, 0, 0);
        }
}

struct AttnCtx {
    const bf16_t* PROJ; const bf16_t* KC; const bf16_t* VC; bf16_t* AOUT;
    const float* gsub;
    float lam;
    float M2d, M2c, M2s, M2w;
};

__device__ __forceinline__ void diff_unit(const AttnCtx& C0, int b, int h, int qb, ldsp lds, const int wid) {
    AttnCtx C = C0; { volatile LAS float* sc = (volatile LAS float*)(lds + L_MISC); C.lam = sc[4]; C.M2d = sc[5]; }
    int tid = hy_tid(wid); asm volatile("" : "+v"(tid));
    const int lane = tid & 63, r32 = lane & 31, hi = lane >> 5;
    const int cm = wid >> 2, wq = wid & 3;
    const int q0 = qb * 128, qlo = q0 + wq * 32, qpos = qlo + r32;
    const bf16_t* Pb = C.PROJ + (size_t)b * T * LDP;
    bf16x8 qr[4];
    { const bf16_t* qp = Pb + (size_t)qpos * LDP + C_DQ + h * 128 + cm * 64 + hi * 8;
#pragma unroll
      for (int d0 = 0; d0 < 4; ++d0) qr[d0] = *(const bf16x8*)(qp + d0 * 16); }
    const float slope2 = __builtin_ldexpf(1.0f, -2 * (h + 1)) * LOG2E;
    f32x16 o[4];
#pragma unroll
    for (int d0 = 0; d0 < 4; ++d0)
#pragma unroll
        for (int r = 0; r < 16; ++r) o[d0][r] = 0.f;
    float l = 0.f;
    const int NT = 2 * (qb + 1);
    constexpr int SLOT = 2 * KSLOT + 4 * DHS;
    const bf16_t* ksrc = Pb + (size_t)(tid >> 3) * LDP + C_DK + h * 128 + (tid & 7) * 8;
    const bf16_t* vsrc = Pb + (size_t)(tid >> 4) * LDP + C_DV + h * 128 + (tid & 15) * 8;
    const int kdst = (tid & 7) * KCS + (tid >> 3) * 16;
    const int vdst = 2 * KSLOT + ((tid & 15) >> 2) * DHS + (tid >> 4) * 64 + (tid & 3) * 16;
    const int vb = ((lane >> 4) & 1) * 32 + (lane & 3) * 8 + (4 * hi + ((lane & 15) >> 2)) * 64;
    u32x4 rk1, rk2, rv0, rv1;
#define DLOAD(t) do { const size_t to_ = (size_t)(t) * 64 * LDP; rk1 = *(const u32x4*)(ksrc + to_); rk2 = *(const u32x4*)(ksrc + to_ + 64); \
        rv0 = *(const u32x4*)(vsrc + to_); rv1 = *(const u32x4*)(vsrc + to_ + (size_t)32 * LDP); } while (0)
#define DSTORE(so) do { *(LAS u32x4*)(lds + (so) + kdst) = rk1; *(LAS u32x4*)(lds + (so) + KSLOT + kdst) = rk2; \
        *(LAS u32x4*)(lds + (so) + vdst) = rv0; *(LAS u32x4*)(lds + (so) + vdst + 32 * 64) = rv1; } while (0)
    DLOAD(0); DSTORE(0);
    __syncthreads();
    for (int t = 0; t < NT; ++t) {
        const int cur = (t & 1) * SLOT, nxt = SLOT - cur;
        if (t + 1 < NT) DLOAD(t + 1);
        if (64 * t <= qlo + 31) {
            const float c0 = fmaf(slope2, (float)(64 * t + 4 * hi - qpos), -C.M2d), c1 = c0 + 32.f * slope2;
            f32x16 p0, p1;
            qk_tile(p0, p1, lds + cur + cm * KSLOT, qr, c0, c1, r32, hi);
            sm_tile<true>(p0, p1, slope2, l, 64 * t + 63 > qlo, 64 * t + 4 * hi, 0, qpos);
            pv_tile<4>(o, p0, p1, lds + cur + 2 * KSLOT + vb);
        }
        if (t + 1 < NT) DSTORE(nxt);
        __syncthreads();
    }
#undef DLOAD
#undef DSTORE
    l += __shfl_xor(l, 32);
    LAS float* wsf = (LAS float*)(lds + L_WSF) + wid * 64;
    if (hi == 0) wsf[r32] = 1.0f / l;
    LDS_FENCE();
    float rl[16];
#pragma unroll
    for (int r = 0; r < 16; ++r) rl[r] = wsf[crow(r, hi)];
#pragma unroll
    for (int d0 = 0; d0 < 4; ++d0)
#pragma unroll
        for (int r = 0; r < 16; ++r) o[d0][r] *= rl[r];
    LAS float* xb = (LAS float*)lds + wq * 64 + lane;
    if (cm == 1) {
#pragma unroll
        for (int d0 = 0; d0 < 4; ++d0)
#pragma unroll
            for (int r = 0; r < 16; ++r) xb[(d0 * 16 + r) * 256] = o[d0][r];
    }
    __syncthreads();
    if (cm == 0) {
        float ss[16];
#pragma unroll
        for (int r = 0; r < 16; ++r) ss[r] = 0.f;
#pragma unroll
        for (int d0 = 0; d0 < 4; ++d0)
#pragma unroll
            for (int r = 0; r < 16; ++r) { const float v = o[d0][r] - C.lam * xb[(d0 * 16 + r) * 256]; o[d0][r] = v; ss[r] += v * v; }
#pragma unroll
        for (int r = 0; r < 16; ++r) {
            float s = ss[r];
            s += __shfl_xor(s, 1); s += __shfl_xor(s, 2); s += __shfl_xor(s, 4); s += __shfl_xor(s, 8); s += __shfl_xor(s, 16);
            ss[r] = (1.0f - LAM_INIT) / sqrtf(s * (1.f / 128.f) + EPS);
        }
#pragma unroll
        for (int d0 = 0; d0 < 4; ++d0) {
            const float gs = C.gsub[32 * d0 + r32];
#pragma unroll
            for (int r = 0; r < 16; ++r) {
                const int tok = qlo + crow(r, hi);
                const float z = bf2f(Pb[(size_t)tok * LDP + C_DZ + h * 128 + 32 * d0 + r32]);
                const float v = (o[d0][r] * ss[r]) * gs * z;
                C.AOUT[((size_t)b * T + tok) * D + h * 128 + 32 * d0 + r32] = (bf16_t)(cvtpk(v, v) & 0xffffu);
            }
        }
    }
    __syncthreads();
}

template <int TT>
__device__ __forceinline__ void cmp_groups(const f32x16& p0, const f32x16& p1, LAS float* GB, LAS float* TB, int hi) {
#pragma unroll
    for (int i = 0; i < 4; ++i) {
        const int m0 = 16 * TT + 2 * i + hi, m1 = m0 + 8;
        GB[m0] = (p0[4 * i] + p0[4 * i + 1]) + (p0[4 * i + 2] + p0[4 * i + 3]); TB[m0 + 1] = p0[4 * i + 3];
        GB[m1] = (p1[4 * i] + p1[4 * i + 1]) + (p1[4 * i + 2] + p1[4 * i + 3]); if (m1 + 1 < 32) TB[m1 + 1] = p1[4 * i + 3];
    }
}
template <int MODE>
__device__ __forceinline__ void nsa_stage(ldsp lds, const bf16_t* kthr, const bf16_t* vthr, int j0, int j1, const bf16x8 (&qr)[4],
                                          float slope2, float M2, int qpos, unsigned selmask, int tb, f32x16 (&o)[2], float& l, int tid, int lane, int r32, int hi) {
    constexpr int SLOT = 2 * KSLOT;
    const int kdst = (tid & 7) * KCS + (tid >> 3) * 16;
    const int vdst = KSLOT + ((tid & 7) >> 2) * DHS + (tid >> 3) * 64 + (tid & 3) * 16;
    const int vb = ((lane >> 4) & 1) * 32 + (lane & 3) * 8 + (4 * hi + ((lane & 15) >> 2)) * 64;
    u32x4 rk, rv;
    rk = *(const u32x4*)(kthr + (size_t)j0 * 64 * LDP); rv = *(const u32x4*)(vthr + (size_t)j0 * 64 * LDP);
    *(LAS u32x4*)(lds + kdst) = rk; *(LAS u32x4*)(lds + vdst) = rv;
    __syncthreads();
    for (int j = j0; j <= j1; ++j) {
        const int cur = ((j - j0) & 1) * SLOT, nxt = SLOT - cur;
        if (j < j1) { rk = *(const u32x4*)(kthr + (size_t)(j + 1) * 64 * LDP); rv = *(const u32x4*)(vthr + (size_t)(j + 1) * 64 * LDP); }
        {
            const float base = fmaf(slope2, (float)(64 * j + 4 * hi - qpos), -M2);
            float c0 = base, c1 = base + 32.f * slope2; bool need_mask; int kmin = 0;
            if (MODE == 1) { if (((selmask >> j) & 1u) == 0u) { c0 = -INFINITY; c1 = -INFINITY; } need_mask = (j == tb); }
            else { need_mask = (j == tb) || (j == tb - 8); kmin = qpos - 511; }
            f32x16 p0, p1;
            qk_tile(p0, p1, lds + cur, qr, c0, c1, r32, hi);
            sm_tile<true>(p0, p1, slope2, l, need_mask, 64 * j + 4 * hi, kmin, qpos);
            pv_tile<2>(o, p0, p1, lds + cur + KSLOT + vb);
        }
        if (j < j1) { *(LAS u32x4*)(lds + nxt + kdst) = rk; *(LAS u32x4*)(lds + nxt + vdst) = rv; }
        __syncthreads();
    }
}
__device__ __forceinline__ void nsa_accum(f32x16 (&tot)[2], const f32x16 (&o)[2], float f, LAS float* wsf, int r32, int hi) {
    LDS_FENCE();
    if (hi == 0) wsf[r32] = f;
    LDS_FENCE();
#pragma unroll
    for (int r = 0; r < 16; ++r) { const float fr = wsf[crow(r, hi)]; tot[0][r] += o[0][r] * fr; tot[1][r] += o[1][r] * fr; }
}
__device__ __forceinline__ void nsa_unit(const AttnCtx& C0, int b, int kvh, int tb, ldsp lds, const int wid) {
    AttnCtx C = C0; { volatile LAS float* sc = (volatile LAS float*)(lds + L_MISC); C.M2c = sc[6]; C.M2s = sc[7]; C.M2w = sc[8]; }
    int tid = hy_tid(wid); asm volatile("" : "+v"(tid));
    const int lane = tid & 63, r32 = lane & 31, hi = lane >> 5;
    const int g = wid >> 1, half = wid & 1, head = kvh * 4 + g;
    const int tokl = 32 * half + r32, qpos = tb * 64 + tokl;
    const bf16_t* Pb = C.PROJ + (size_t)b * T * LDP;
    bf16x8 qr[4];
    { const bf16_t* qp = Pb + (size_t)qpos * LDP + C_NQ + head * 64 + hi * 8;
#pragma unroll
      for (int d0 = 0; d0 < 4; ++d0) qr[d0] = *(const bf16x8*)(qp + d0 * 16); }
    const bf16_t* gatep = Pb + (size_t)qpos * LDP + C_NG + head;
    const float slope2 = __builtin_ldexpf(1.0f, -(head + 1)) * LOG2E;
    LAS float* wsf = (LAS float*)(lds + L_WSF) + wid * 64;
    f32x16 tot[2];
#pragma unroll
    for (int r = 0; r < 16; ++r) { tot[0][r] = 0.f; tot[1][r] = 0.f; }
    unsigned selmask;
    {
        f32x16 o[2];
#pragma unroll
        for (int r = 0; r < 16; ++r) { o[0][r] = 0.f; o[1][r] = 0.f; }
        float l = 0.f;
        const int cmax = (qpos >= 31) ? ((qpos - 31) >> 4) : -1;
        const bf16_t* kc = C.KC + (size_t)((b * 2 + kvh) * 128) * 64; const bf16_t* vc = C.VC + (size_t)((b * 2 + kvh) * 128) * 64;
        const int kdst = (tid & 7) * KCS + (tid >> 3) * 16;
        const int vdst = KSLOT + ((tid & 7) >> 2) * DHS + (tid >> 3) * 64 + (tid & 3) * 16;
        const int vb = ((lane >> 4) & 1) * 32 + (lane & 3) * 8 + (4 * hi + ((lane & 15) >> 2)) * 64;
        constexpr int SLOT = 2 * KSLOT;
#pragma unroll
        for (int tt = 0; tt < 2; ++tt) {
            *(LAS u32x4*)(lds + tt * SLOT + kdst) = *(const u32x4*)(kc + (size_t)(tt * 64 + (tid >> 3)) * 64 + (tid & 7) * 8);
            *(LAS u32x4*)(lds + tt * SLOT + vdst) = *(const u32x4*)(vc + (size_t)(tt * 64 + (tid >> 3)) * 64 + (tid & 7) * 8);
        }
        __syncthreads();
        LAS float* GB = (LAS float*)(lds + L_GB) + (g * 64 + tokl) * 33; LAS float* TB = (LAS float*)(lds + L_TB) + (g * 64 + tokl) * 33;
        { f32x16 p0, p1; qk_tile(p0, p1, lds, qr, -C.M2c, -C.M2c, r32, hi); sm_tile<false>(p0, p1, 0.f, l, true, 4 * hi, 0, cmax); cmp_groups<0>(p0, p1, GB, TB, hi); pv_tile<2>(o, p0, p1, lds + KSLOT + vb); }
        { f32x16 p0, p1; qk_tile(p0, p1, lds + SLOT, qr, -C.M2c, -C.M2c, r32, hi); sm_tile<false>(p0, p1, 0.f, l, true, 64 + 4 * hi, 0, cmax); cmp_groups<1>(p0, p1, GB, TB, hi); pv_tile<2>(o, p0, p1, lds + SLOT + KSLOT + vb); }
        l += __shfl_xor(l, 32);
        const float invl = (l > 0.f) ? 1.0f / l : 0.f;
        if (hi == 0) ((LAS float*)(lds + L_LB))[g * 64 + tokl] = invl;
        nsa_accum(tot, o, bf2f(gatep[0]) * invl, wsf, r32, hi);
        __syncthreads();
        if (tb <= 7) selmask = (2u << tb) - 1u;
        else {
            float imp[32];
            const LAS float* G0 = (const LAS float*)(lds + L_GB) + tokl * 33; const LAS float* T0 = (const LAS float*)(lds + L_TB) + tokl * 33;
            float il[4];
#pragma unroll
            for (int gg = 0; gg < 4; ++gg) il[gg] = ((const LAS float*)(lds + L_LB))[gg * 64 + tokl];
#pragma unroll
            for (int s = 0; s < 32; ++s) {
                float a = 0.f;
#pragma unroll
                for (int gg = 0; gg < 4; ++gg) { float v = G0[gg * 64 * 33 + s]; if (s > 0) v += T0[gg * 64 * 33 + s]; a = fmaf(v, il[gg], a); }
                imp[s] = a;
            }
            unsigned sel = 0u;
#pragma unroll 1
            for (int it = 0; it < 5; ++it) {
                float bv = -1.0f; int best = 0;
#pragma unroll
                for (int s = 1; s < 30; ++s) { const bool ok = (s <= tb - 2) && (((sel >> s) & 1u) == 0u) && (imp[s] > bv); if (ok) { bv = imp[s]; best = s; } }
                sel |= 1u << best;
            }
            selmask = (sel & ~1u) | 1u | (1u << (tb - 1)) | (1u << tb);
        }
    }
    const bf16_t* kvthr = Pb + (size_t)(tid >> 3) * LDP + C_NKV + kvh * 64 + (tid & 7) * 8;
    {
        f32x16 o[2];
#pragma unroll
        for (int r = 0; r < 16; ++r) { o[0][r] = 0.f; o[1][r] = 0.f; }
        float l = 0.f;
        nsa_stage<1>(lds, kvthr + 2 * 128, kvthr + 3 * 128, 0, tb, qr, slope2, C.M2s, qpos, selmask, tb, o, l, tid, lane, r32, hi);
        l += __shfl_xor(l, 32);
        nsa_accum(tot, o, bf2f(gatep[8]) / l, wsf, r32, hi);
    }
    {
        f32x16 o[2];
#pragma unroll
        for (int r = 0; r < 16; ++r) { o[0][r] = 0.f; o[1][r] = 0.f; }
        float l = 0.f;
        nsa_stage<2>(lds, kvthr + 4 * 128, kvthr + 5 * 128, tb >= 8 ? tb - 8 : 0, tb, qr, slope2, C.M2w, qpos, 0u, tb, o, l, tid, lane, r32, hi);
        l += __shfl_xor(l, 32);
        nsa_accum(tot, o, bf2f(gatep[16]) / l, wsf, r32, hi);
    }
#pragma unroll
    for (int d0 = 0; d0 < 2; ++d0)
#pragma unroll
        for (int r = 0; r < 16; ++r) {
            const int tok = tb * 64 + 32 * half + crow(r, hi);
            const float z = bf2f(Pb[(size_t)tok * LDP + C_NZ + head * 64 + 32 * d0 + r32]);
            const float v = tot[d0][r] * z;
            C.AOUT[((size_t)b * T + tok) * D + 512 + head * 64 + 32 * d0 + r32] = (bf16_t)(cvtpk(v, v) & 0xffffu);
        }
}

__device__ __forceinline__ void attn_phase(const Args& A, ldsp lds, const int wave, int lane) {
    const bool t0 = (wave == 0 && lane == 0);
    unsigned char* ws = A.ws;
    AttnCtx C;
    C.PROJ = (const bf16_t*)(ws + WS_PROJ); C.KC = (const bf16_t*)(ws + WS_KC); C.VC = (const bf16_t*)(ws + WS_VC); C.AOUT = (bf16_t*)(ws + WS_AOUT);
    C.gsub = A.in[9];
    {
        const float sa = wave_sum(A.in[5][lane] * A.in[6][lane]), sb = wave_sum(A.in[7][lane] * A.in[8][lane]);
        C.lam = expf(sa) - expf(sb) + LAM_INIT;
        const float mqd = wave_max(fabsf(A.in[3][lane])), mkd = wave_max(fabsf(A.in[4][lane])), mqn = wave_max(fabsf(A.in[10][lane]));
        const float mk0 = wave_max(fabsf(A.in[11][lane])), mk1 = wave_max(fabsf(A.in[11][64 + lane])), mk2 = wave_max(fabsf(A.in[11][128 + lane]));
        C.M2d = MCOEF * mqd * mkd; C.M2c = MCOEF * mqn * mk0; C.M2s = MCOEF * mqn * mk1; C.M2w = MCOEF * mqn * mk2;
        if (t0) { LAS float* sc = (LAS float*)(lds + L_MISC); sc[4] = C.lam; sc[5] = C.M2d; sc[6] = C.M2c; sc[7] = C.M2s; sc[8] = C.M2w; }
        C.lam = 0.f; C.M2d = 0.f; C.M2c = 0.f; C.M2s = 0.f; C.M2w = 0.f;
    }
    unsigned* qctr = (unsigned*)(ws + WS_CTL) + CW_QCTR;
    volatile LAS unsigned* bc = (volatile LAS unsigned*)(lds + L_MISC);
    for (;;) {
        if (t0) bc[0] = atomicAdd(qctr, 1u);
        __syncthreads();
        const unsigned idx = bc[0];
        __syncthreads();
        if (idx >= 4096u) break;
        const int j = 15 - (int)(idx >> 8), r = (int)(idx & 255u);
#ifndef HY_NO_DIFF
        if (r < 128) diff_unit(C, r >> 2, r & 3, j, lds, wave);
#endif
#ifndef HY_NO_NSA
        if (r >= 128) { const int q = (r - 128) & 63, tb = (r < 192) ? 2 * j + 1 : 2 * j; nsa_unit(C, q >> 1, q & 1, tb, lds, wave); }
#endif
    }
}

__global__ void __launch_bounds__(512, 2) hymba_fwd(Args args) {
    extern __shared__ __attribute__((aligned(16))) unsigned char lds_raw[];
    ldsp lds = (ldsp)lds_raw;
    const int wave = __builtin_amdgcn_readfirstlane((int)threadIdx.x >> 6);
    const int G = gridDim.x; const int bx = blockIdx.x; const int vcu = (G % 8 == 0) ? (bx % 8) * (G / 8) + bx / 8 : bx;
    unsigned char* ws = args.ws;
    const int lo = args.ph_lo, hi = args.ph_hi;
#ifndef HY_PHASE_MASK
#define HY_PHASE_MASK 31
#endif
#define IN(k) ((((HY_PHASE_MASK) >> (k)) & 1) && lo <= (k) && (k) < hi)
#if HY_N_LAUNCHES == 1
#define SEAM(k) do { if (IN(k) && IN((k) + 1)) { __threadfence(); cg::this_grid().sync(); } } while (0)
#else
#define SEAM(k) do { } while (0)
#endif
    if (IN(0)) { p0_prologue(args, lds, vcu, G, wave, hy_tid(wave) & 63); }
    SEAM(0);
    if (IN(1)) {
        pg8::Gemm g{(const bf16_t*)(ws + WS_XN), (const bf16_t*)(ws + WS_WIN), M, NPAD, D}; pg8::StaticOrder S; S.init(M, NPAD, G, bx);
        EpiIn E{(bf16_t*)(ws + WS_PROJ), args.in[3], args.in[4], args.in[10], args.in[11]};
        pg8::gemm_phase<EpiIn, pg8::StaticOrder, true, true>((PG8_LAS unsigned char*)lds, g, S, E, wave);
    }
    SEAM(1);
    if (IN(2)) { compress_phase(args, lds, wave, hy_tid(wave) & 63); }
    SEAM(2);
    if (IN(3)) { attn_phase(args, lds, wave, hy_tid(wave) & 63); }
    SEAM(3);
    if (IN(4)) {
        pg8::Gemm g{(const bf16_t*)(ws + WS_AOUT), (const bf16_t*)(ws + WS_WOUT), M, D, D}; pg8::StaticOrder S; S.init(M, D, G, bx);
        EpiOut E{args.in[0], args.out};
        pg8::gemm_phase<EpiOut, pg8::StaticOrder, true, true>((PG8_LAS unsigned char*)lds, g, S, E, wave);
    }
#undef IN
#undef SEAM
}
}

extern "C" void kernel_launch(void* const* d_in, const int* in_sizes, int n_in, void* d_out, int out_size, void* d_ws, size_t ws_size, hipStream_t stream) {
    using namespace hy;
    static int grid = 0;
    if (grid == 0) {
        if (n_in != 17 || in_sizes[0] != M * D || out_size != M * D || ws_size < WS_END) {
            fprintf(stderr, "kernel_launch: unexpected shapes (n_in %d, in0 %d, out %d, ws %zu)\n", n_in, n_in > 0 ? in_sizes[0] : -1, out_size, ws_size); grid = -1; return; }
        { const int want[17] = {M * D, D, D * NIN, 64, 64, 64, 64, 64, 64, 128, 64, 192, 2 * 32 * 64, 2 * 2048 * 256, 2 * 256, 2 * 256 * 64, D * D};
          for (int i = 0; i < 17; ++i) if (in_sizes[i] != want[i]) { fprintf(stderr, "kernel_launch: input %d has %d elements, expected %d\n", i, in_sizes[i], want[i]); grid = -1; return; } }
        int dev = 0, cus = 0, per_cu = 0;
        if (hipGetDevice(&dev) != hipSuccess || hipDeviceGetAttribute(&cus, hipDeviceAttributeMultiprocessorCount, dev) != hipSuccess) { grid = -1; return; }
        if (hipFuncSetAttribute((const void*)hymba_fwd, hipFuncAttributeMaxDynamicSharedMemorySize, LDS_BYTES) != hipSuccess) { fprintf(stderr, "kernel_launch: hipFuncSetAttribute failed\n"); grid = -1; return; }
        if (hipOccupancyMaxActiveBlocksPerMultiprocessor(&per_cu, (const void*)hymba_fwd, 512, LDS_BYTES) != hipSuccess || per_cu < 1) { fprintf(stderr, "kernel_launch: occupancy query says %d blocks per CU\n", per_cu); grid = -1; return; }
        (void)hipGetLastError();
        grid = cus * 1;
    }
    if (grid < 0) return;
    (void)hipMemsetAsync((char*)d_ws + WS_CTL, 0, CTL_BYTES, stream);
    Args a{};
    for (int i = 0; i < 17; ++i) a.in[i] = (const float*)d_in[i];
    a.out = (float*)d_out; a.ws = (unsigned char*)d_ws;
#if HY_N_LAUNCHES == 1
    a.ph_lo = 0; a.ph_hi = 5;
    void* kargs[] = {&a};
    hipError_t e = hipLaunchCooperativeKernel((const void*)hymba_fwd, dim3(grid), dim3(512), kargs, LDS_BYTES, stream);
    if (e != hipSuccess) fprintf(stderr, "kernel_launch: cooperative launch failed: %s (grid %d)\n", hipGetErrorString(e), grid);
#else
    for (int p = 0; p < 5; ++p) { a.ph_lo = p; a.ph_hi = p + 1; hipLaunchKernelGGL(hymba_fwd, dim3(grid), dim3(512), LDS_BYTES, stream, a); }
#endif
}
```

```cpp
#include <hip/hip_runtime.h>
#include <cstdio>
#include <cstdint>
#include <cmath>
#define HY_N_LAUNCHES 1
namespace pg8 {
#define PG8_LAS __attribute__((address_space(3)))
typedef unsigned short bf16_t;
typedef short bf16x8 __attribute__((ext_vector_type(8)));
typedef float f32x4 __attribute__((ext_vector_type(4)));
typedef unsigned u32x4 __attribute__((ext_vector_type(4)));
constexpr int BM = 256, BK = 64, HALF = 128, HTB = HALF * BK * 2  , STAGE_BYTES = 8 * HTB, NXCD = 8, WGM = 8;

__host__ __device__ __forceinline__ int lds_byte(int r, int c) { const int st = (r >> 4) * 2 + (c >> 5), rr = r & 15, cc = c & 31, ob = rr * 64 + cc * 2; return st * 1024 + (ob ^ (((ob >> 9) & 1) << 5)); }
__host__ __device__ __forceinline__ void stage_rc(int b, int& R, int& C) { const int st = b / 1024, sb = b % 1024, swz = sb ^ (((sb >> 9) & 1) << 5); R = (st >> 1) * 16 + swz / 64; C = (st & 1) * 32 + (swz % 64) / 2; }
__host__ __device__ __forceinline__ int perm32(int rho) { const int n = rho >> 4, i = rho & 15; return 8 * (i >> 2) + 4 * n + (i & 3); }

struct Unit { int pm, pn; };
struct Gemm { const bf16_t* A; const bf16_t* Bt; int M, N, K; };

struct StaticOrder {
    int nM, nN, nwg, G, c;
    __host__ __device__ void init(int M, int N, int G_, int c_) { nM = M / BM; nN = N / BM; nwg = nM * nN; G = G_; c = c_; }
    __host__ __device__ bool next(int i, Unit& u) const {
        const long L = (long)i * G + c; if (L >= nwg) return false;
        int wgid = (int)L; { const int q = nwg / NXCD, r = nwg % NXCD, xcd = wgid % NXCD, off = wgid / NXCD; wgid = (xcd < r ? xcd * (q + 1) : r * (q + 1) + (xcd - r) * q) + off; }
        const int nig = WGM * nN, gid = wgid / nig, fm = gid * WGM, gsz = (nM - fm) < WGM ? (nM - fm) : WGM;
        u.pm = fm + ((wgid % nig) % gsz); u.pn = (wgid % nig) / gsz; return true;
    }
    __device__ __forceinline__ void a_ready(const Unit&) const {}
    __device__ __forceinline__ void done(const Unit&) const {}
};

template <class Epi, class Sched, bool ALIGN_EPI = false, bool SP2 = false>
__device__ __forceinline__ void gemm_phase(PG8_LAS unsigned char* lds, const Gemm g, const Sched& S, const Epi& E, const int wid) {
    unsigned z_; asm volatile("v_mov_b32 %0, 0" : "=v"(z_));
    const int tid = wid * 64 + (int)__builtin_amdgcn_mbcnt_hi(~0u, __builtin_amdgcn_mbcnt_lo(~0u, z_)), lane = tid & 63, wr = wid >> 2, wc = wid & 3, fr = lane & 15, fq = lane >> 4;
    const int K = g.K, nt = K / BK;
    unsigned voffA[2], voffB[2];
#pragma unroll
    for (int i = 0; i < 2; ++i) { int R, C; stage_rc(tid * 16 + i * 8192, R, C); const int Rb = Epi::PERM ? ((R & ~31) + perm32(R & 31)) : R;
        voffA[i] = (unsigned)(R * K + C) * 2u; voffB[i] = (unsigned)(Rb * K + C) * 2u; }
    const size_t kstep = (size_t)(BK * 2);
    const size_t hstep = (size_t)HALF * K * 2;
    const size_t tstep = 2 * hstep;
    const unsigned ldsw = (unsigned)wid * 1024u;
    const int aoff = lds_byte(wr * 64 + fr, fq * 8), boff = lds_byte(wc * 32 + fr, fq * 8);
#define PG8_SA(b, h) (((b) * 2 + (h)) * HTB)
#define PG8_SB(b, h) ((4 + (b) * 2 + (h)) * HTB)
#define PG8_STAGE(bufoff, gbase, voff) do { _Pragma("unroll") for (int _i = 0; _i < 2; ++_i) \
        __builtin_amdgcn_global_load_lds((const unsigned*)((const char*)(gbase) + (voff)[_i]), (PG8_LAS unsigned*)(lds + (bufoff) + ldsw + _i * 8192), 16, 0, 0); } while (0)
#define PG8_LDA(dst, b, h) do { _Pragma("unroll") for (int m = 0; m < 4; ++m) _Pragma("unroll") for (int k = 0; k < 2; ++k) dst[m][k] = *(const PG8_LAS bf16x8*)(lds + PG8_SA(b, h) + aoff + m * 2048 + k * 1024); } while (0)
#define PG8_LDB(dst, b, h) do { _Pragma("unroll") for (int n = 0; n < 2; ++n) _Pragma("unroll") for (int k = 0; k < 2; ++k) dst[n][k] = *(const PG8_LAS bf16x8*)(lds + PG8_SB(b, h) + boff + n * 2048 + k * 1024); } while (0)
#define PG8_MMA(ai, bj, At, Bt) do { __builtin_amdgcn_s_setprio(1); _Pragma("unroll") for (int m = 0; m < 4; ++m) _Pragma("unroll") for (int n = 0; n < 2; ++n) _Pragma("unroll") for (int k = 0; k < 2; ++k) \
        acc[ai][bj][m][n] = __builtin_amdgcn_mfma_f32_16x16x32_bf16(Bt[n][k], At[m][k], acc[ai][bj][m][n], 0, 0, 0); __builtin_amdgcn_s_setprio(0); } while (0)
#define PG8_WAIT_V(n) asm volatile("s_waitcnt vmcnt(" #n ")" ::: "memory")
#define PG8_WAIT_L(n) asm volatile("s_waitcnt lgkmcnt(" #n ")" ::: "memory")
#define PG8_BAR __builtin_amdgcn_s_barrier()
#define PG8_SCHED __builtin_amdgcn_sched_barrier(0)
    Unit cur, nxt; int ui = 0;
    if (!S.next(0, cur)) return;
    f32x4 acc[2][2][4][2];
#pragma unroll
    for (int a = 0; a < 2; ++a)
#pragma unroll
        for (int b = 0; b < 2; ++b)
#pragma unroll
            for (int m = 0; m < 4; ++m)
#pragma unroll
                for (int n = 0; n < 2; ++n) acc[a][b][m][n] = (f32x4){0.f, 0.f, 0.f, 0.f};
    bf16x8 At[4][2], B0[2][2], B1[2][2];
    const char* cA = (const char*)g.A + (size_t)cur.pm * tstep; const char* cB = (const char*)g.Bt + (size_t)cur.pn * tstep;
    S.a_ready(cur);
    if constexpr (SP2) {
        PG8_STAGE(PG8_SB(0, 0), cB, voffB); PG8_STAGE(PG8_SB(0, 1), cB + hstep, voffB); PG8_STAGE(PG8_SA(0, 0), cA, voffA); PG8_STAGE(PG8_SA(0, 1), cA + hstep, voffA);
        if (wr == 1) PG8_BAR;
        PG8_WAIT_V(2); PG8_BAR;
        PG8_STAGE(PG8_SB(1, 0), cB + kstep, voffB); PG8_STAGE(PG8_SA(1, 0), cA + kstep, voffA); PG8_STAGE(PG8_SB(1, 1), cB + hstep + kstep, voffB);
        PG8_WAIT_V(6); PG8_BAR;
    } else {
        PG8_STAGE(PG8_SB(0, 0), cB, voffB); PG8_STAGE(PG8_SA(0, 0), cA, voffA); PG8_STAGE(PG8_SB(0, 1), cB + hstep, voffB); PG8_STAGE(PG8_SA(0, 1), cA + hstep, voffA);
        if (wr == 1) PG8_BAR;
        PG8_WAIT_V(4); PG8_BAR;
        PG8_STAGE(PG8_SB(1, 0), cB + kstep, voffB); PG8_STAGE(PG8_SA(1, 0), cA + kstep, voffA); PG8_STAGE(PG8_SB(1, 1), cB + hstep + kstep, voffB);
        PG8_WAIT_V(6); PG8_BAR;
    }
    for (;;) {
        const bool has_next = S.next(ui + 1, nxt);
        const char* nA = has_next ? (const char*)g.A + (size_t)nxt.pm * tstep : cA; const char* nB = has_next ? (const char*)g.Bt + (size_t)nxt.pn * tstep : cB;
        for (int t = 0; t < nt; t += 2) {
            const bool last = (t == nt - 2);
            const char* a1 = cA + (size_t)(t + 1) * kstep;
            const char* a2 = last ? nA : cA + (size_t)(t + 2) * kstep; const char* b2 = last ? nB : cB + (size_t)(t + 2) * kstep;
            const char* a3 = a2 + kstep; const char* b3 = b2 + kstep;
            if (last && has_next) S.a_ready(nxt);
            if constexpr (SP2) {
            PG8_LDB(B0, 0, 0); PG8_LDB(B1, 0, 1); PG8_SCHED; PG8_LDA(At, 0, 0); PG8_STAGE(PG8_SA(1, 1), a1 + hstep, voffA);
            PG8_WAIT_V(8); PG8_WAIT_L(0); PG8_BAR; PG8_MMA(0, 0, At, B0); PG8_MMA(0, 1, At, B1); PG8_BAR; PG8_SCHED;
            PG8_LDA(At, 0, 1); PG8_STAGE(PG8_SB(0, 0), b2, voffB); PG8_STAGE(PG8_SB(0, 1), b2 + hstep, voffB); PG8_STAGE(PG8_SA(0, 0), a2, voffA);
            PG8_WAIT_V(8); PG8_WAIT_L(0); PG8_BAR; PG8_MMA(1, 0, At, B0); PG8_MMA(1, 1, At, B1); PG8_BAR; PG8_SCHED;
            PG8_LDB(B0, 1, 0); PG8_LDB(B1, 1, 1); PG8_SCHED; PG8_LDA(At, 1, 0); PG8_STAGE(PG8_SA(0, 1), a2 + hstep, voffA);
            PG8_WAIT_V(8); PG8_WAIT_L(0); PG8_BAR; PG8_MMA(0, 0, At, B0); PG8_MMA(0, 1, At, B1); PG8_BAR; PG8_SCHED;
            PG8_LDA(At, 1, 1); PG8_STAGE(PG8_SB(1, 0), b3, voffB); PG8_STAGE(PG8_SB(1, 1), b3 + hstep, voffB); PG8_STAGE(PG8_SA(1, 0), a3, voffA);
            PG8_WAIT_V(8); PG8_WAIT_L(0); PG8_BAR; PG8_MMA(1, 0, At, B0); PG8_MMA(1, 1, At, B1); PG8_BAR; PG8_SCHED;
            } else {
            PG8_LDB(B0, 0, 0); PG8_SCHED; PG8_LDA(At, 0, 0); PG8_STAGE(PG8_SA(1, 1), a1 + hstep, voffA);
            PG8_WAIT_L(8); PG8_BAR; PG8_WAIT_L(0); PG8_MMA(0, 0, At, B0); PG8_BAR; PG8_SCHED;
            PG8_LDB(B1, 0, 1); PG8_STAGE(PG8_SB(0, 0), b2, voffB);
            PG8_BAR; PG8_WAIT_L(0); PG8_MMA(0, 1, At, B1); PG8_BAR;
            PG8_LDA(At, 0, 1); PG8_STAGE(PG8_SA(0, 0), a2, voffA);
            PG8_BAR; PG8_WAIT_L(0); PG8_MMA(1, 0, At, B0); PG8_BAR; PG8_SCHED;
            PG8_STAGE(PG8_SB(0, 1), b2 + hstep, voffB);
            PG8_WAIT_V(6); PG8_BAR; PG8_MMA(1, 1, At, B1); PG8_BAR;
            PG8_LDB(B0, 1, 0); PG8_SCHED; PG8_LDA(At, 1, 0); PG8_STAGE(PG8_SA(0, 1), a2 + hstep, voffA);
            PG8_WAIT_L(8); PG8_BAR; PG8_WAIT_L(0); PG8_MMA(0, 0, At, B0); PG8_BAR; PG8_SCHED;
            PG8_LDB(B1, 1, 1); PG8_STAGE(PG8_SB(1, 0), b3, voffB);
            PG8_BAR; PG8_WAIT_L(0); PG8_MMA(0, 1, At, B1); PG8_BAR;
            PG8_LDA(At, 1, 1); PG8_STAGE(PG8_SA(1, 0), a3, voffA);
            PG8_BAR; PG8_WAIT_L(0); PG8_MMA(1, 0, At, B0); PG8_BAR; PG8_SCHED;
            PG8_STAGE(PG8_SB(1, 1), b3 + hstep, voffB);
            PG8_WAIT_V(6); PG8_BAR; PG8_MMA(1, 1, At, B1); PG8_BAR;
            }
        }
        if constexpr (ALIGN_EPI) { if (wr == 0) PG8_BAR; }
        if constexpr (!Epi::AFTER_DRAIN) { E(acc, cur, wr, wc, fr, fq); S.done(cur); }
        if (!has_next) break;
#pragma unroll
        for (int a = 0; a < 2; ++a)
#pragma unroll
            for (int b = 0; b < 2; ++b)
#pragma unroll
                for (int m = 0; m < 4; ++m)
#pragma unroll
                    for (int n = 0; n < 2; ++n) acc[a][b][m][n] = (f32x4){0.f, 0.f, 0.f, 0.f};
        cur = nxt; cA = nA; cB = nB; ++ui;
        if constexpr (ALIGN_EPI) { if (wr == 1) PG8_BAR; }
    }
    PG8_WAIT_V(0);
    if constexpr (!ALIGN_EPI) { if (wr == 0) PG8_BAR; }
    PG8_BAR;
    if constexpr (Epi::AFTER_DRAIN) { E.fused(acc, cur, wr, wc, fr, fq, lds, wid, lane); S.done(cur); }
#undef PG8_SA
#undef PG8_SB
#undef PG8_STAGE
#undef PG8_LDA
#undef PG8_LDB
#undef PG8_MMA
#undef PG8_WAIT_V
#undef PG8_WAIT_L
#undef PG8_BAR
#undef PG8_SCHED
}
}

#ifndef HY_N_LAUNCHES
#define HY_N_LAUNCHES 5
#endif

namespace hy {
#define LAS __attribute__((address_space(3)))
typedef unsigned short bf16_t;
typedef short bf16x8 __attribute__((ext_vector_type(8)));
typedef short s16x4 __attribute__((ext_vector_type(4)));
typedef float f32x4 __attribute__((ext_vector_type(4)));
typedef float f32x16 __attribute__((ext_vector_type(16)));
typedef unsigned u32x4 __attribute__((ext_vector_type(4)));
typedef unsigned u32x2 __attribute__((ext_vector_type(2)));
typedef LAS unsigned char* ldsp;

constexpr int BATCH = 32, T = 2048, D = 1024, M = BATCH * T;
constexpr int NIN = 3864, NPAD = 4096, LDP = 3904;
constexpr int C_DQ = 0, C_DK = 512, C_DV = 1024, C_DZ = 1536, C_NQ = 2048, C_NKV = 2560, C_NZ = 3328, C_NG = 3840;
constexpr float EPS = 1e-6f;
constexpr float LOG2E = 1.4426950408889634f;
constexpr float QSCALE = 0.125f * LOG2E;
constexpr float MCOEF = QSCALE * 64.0f;
constexpr float LAM_INIT = 0.2f;

constexpr size_t MiB = 1u << 20;
constexpr size_t WS_CTL = 0, CTL_BYTES = 1 * MiB;
constexpr size_t WS_WIN = 2 * MiB;
constexpr size_t WS_WOUT = 12 * MiB;
constexpr size_t WS_W1T = 14 * MiB;
constexpr size_t WS_W2T = 16 * MiB;
constexpr size_t WS_B1P = 16 * MiB + 256 * 1024;
constexpr size_t WS_KC = 17 * MiB;
constexpr size_t WS_VC = 18 * MiB;
constexpr size_t WS_XN = 32 * MiB;
constexpr size_t WS_AOUT = 160 * MiB;
constexpr size_t WS_PROJ = 288 * MiB;
constexpr size_t WS_END = 776 * MiB;
constexpr int CW_QCTR = 64;

constexpr int LDS_BYTES = 147456;
constexpr int KCS = 1040, KSLOT = 8 * KCS, DHS = 4160;
constexpr int L_GB = 66560, L_TB = L_GB + 33792, L_WSF = L_TB + 33792, L_LB = L_WSF + 2048, L_MISC = L_LB + 1024;
static_assert(L_MISC + 256 <= LDS_BYTES, "LDS map");

struct Args { const float* in[17]; float* out; unsigned char* ws; int ph_lo, ph_hi; };

#define LDS_FENCE() do { asm volatile("s_waitcnt lgkmcnt(0)" ::: "memory"); __builtin_amdgcn_wave_barrier(); } while (0)

__device__ __forceinline__ unsigned cvtpk(float lo, float hi) {
    typedef float f2_t __attribute__((ext_vector_type(2))); typedef __bf16 b2_t __attribute__((ext_vector_type(2)));
    f2_t v = {lo, hi}; b2_t b = __builtin_convertvector(v, b2_t); return __builtin_bit_cast(unsigned, b);
}
__device__ __forceinline__ int hy_tid(int wave) { unsigned z; asm volatile("v_mov_b32 %0, 0" : "=v"(z)); return wave * 64 + (int)__builtin_amdgcn_mbcnt_hi(~0u, __builtin_amdgcn_mbcnt_lo(~0u, z)); }
__device__ __forceinline__ float bf2f(unsigned short u) { return __builtin_bit_cast(float, (unsigned)u << 16); }
__device__ __forceinline__ float wave_sum(float v) {
#pragma unroll
    for (int o = 1; o < 64; o <<= 1) v += __shfl_xor(v, o);
    return v;
}
__device__ __forceinline__ float wave_max(float v) {
#pragma unroll
    for (int o = 1; o < 64; o <<= 1) v = fmaxf(v, __shfl_xor(v, o));
    return v;
}
__device__ __forceinline__ float siluf(float v) { return v / (1.0f + __expf(-v)); }
__device__ __forceinline__ float sigmf(float v) { return 1.0f / (1.0f + __expf(-v)); }

__device__ __forceinline__ void transpose_item(const float* W, int ldw, int ncols, int n0, int k0, bf16_t* WT, int K, int p0, LAS float* scr, int lane) {
#pragma unroll 8
    for (int i = 0; i < 32; ++i) {
        const int kk = 2 * i + (lane >> 5), nn = lane & 31, n = n0 + nn;
#ifdef HY_T_NOLOAD
        scr[kk * 33 + nn] = (float)n;
#else
        scr[kk * 33 + nn] = (n < ncols) ? W[(size_t)(k0 + kk) * ldw + n] : 0.f;
#endif
    }
    LDS_FENCE();
    const int c = lane & 7;
#pragma unroll
    for (int j = 0; j < 4; ++j) {
        const int n = (lane >> 3) + 8 * j; const LAS float* s = scr + (8 * c) * 33 + n;
        u32x4 o; o.x = cvtpk(s[0 * 33], s[1 * 33]); o.y = cvtpk(s[2 * 33], s[3 * 33]); o.z = cvtpk(s[4 * 33], s[5 * 33]); o.w = cvtpk(s[6 * 33], s[7 * 33]);
#ifdef HY_T_NOSTORE
        if (o.x == 0x12345678u) *(u32x4*)(WT) = o;
#else
        *(u32x4*)(WT + (size_t)(p0 + n) * K + k0 + 8 * c) = o;
#endif
    }
    LDS_FENCE();
}
__device__ __forceinline__ void rms_row(const float* xrow, const float* g, bf16_t* orow, int lane) {
    const f32x4* xr = (const f32x4*)xrow + lane; const f32x4* gr = (const f32x4*)g + lane;
    f32x4 v[4]; float s = 0.f;
#pragma unroll
    for (int j = 0; j < 4; ++j) { v[j] = xr[64 * j]; s += (v[j].x * v[j].x + v[j].y * v[j].y) + (v[j].z * v[j].z + v[j].w * v[j].w); }
    const float r = 1.0f / sqrtf(wave_sum(s) * (1.f / D) + EPS);
    u32x2* o8 = (u32x2*)orow + lane;
#pragma unroll
    for (int j = 0; j < 4; ++j) { const f32x4 gj = gr[64 * j]; const f32x4 y = (v[j] * r) * gj; u32x2 w; w.x = cvtpk(y.x, y.y); w.y = cvtpk(y.z, y.w); o8[64 * j] = w; }
}
__device__ __forceinline__ void p0_prologue(const Args& A, ldsp lds, int vcu, int G, int wave, int lane) {
    LAS float* scr = (LAS float*)(lds + wave * 16384);
    unsigned char* ws = A.ws;
    const int gw = vcu * 8 + wave, NGW = G * 8;
    constexpr int I_WIN = (NPAD / 32) * (D / 64), I_WOUT = (D / 32) * (D / 64), I_W1 = (256 / 32) * (2048 / 64), I_W2 = (64 / 32) * (256 / 64), I_B1 = 2 * 4 * 8;
    constexpr int NITEMS = I_WIN + I_WOUT + 2 * I_W1 + 2 * I_W2 + I_B1;
#ifndef HY_P0_SKIP_T
#ifndef HY_IT_LO
#define HY_IT_LO 0
#define HY_IT_HI NITEMS
#endif
    for (int it = gw; it < NITEMS; it += NGW) {
        int r = it;
        if (it < (HY_IT_LO) || it >= (HY_IT_HI)) continue;
#ifdef HY_WAVE_LT
        if (wave >= (HY_WAVE_LT)) continue;
#endif
        if (r < I_WIN) { const int nb = r / (D / 64), kb = r % (D / 64), p0 = 32 * nb;
            const int n0 = 256 * (p0 >> 8) + 64 * ((p0 >> 5) & 3) + 32 * ((p0 >> 7) & 1);
            transpose_item(A.in[2], NIN, NIN, n0, 64 * kb, (bf16_t*)(ws + WS_WIN), D, p0, scr, lane); continue; }
        r -= I_WIN;
        if (r < I_WOUT) { const int nb = r / (D / 64), kb = r % (D / 64); transpose_item(A.in[16], D, D, 32 * nb, 64 * kb, (bf16_t*)(ws + WS_WOUT), D, 32 * nb, scr, lane); continue; }
        r -= I_WOUT;
        if (r < 2 * I_W1) { const int wh = r / I_W1, q = r % I_W1, nb = q / 32, kb = q % 32;
            transpose_item(A.in[13] + (size_t)wh * 2048 * 256, 256, 256, 32 * nb, 64 * kb, (bf16_t*)(ws + WS_W1T) + (size_t)wh * 256 * 2048, 2048, 32 * nb, scr, lane); continue; }
        r -= 2 * I_W1;
        if (r < 2 * I_W2) { const int wh = r / I_W2, q = r % I_W2, nb = q / 4, kb = q % 4;
            transpose_item(A.in[15] + (size_t)wh * 256 * 64, 64, 64, 32 * nb, 64 * kb, (bf16_t*)(ws + WS_W2T) + (size_t)wh * 64 * 256, 256, 32 * nb, scr, lane); continue; }
        r -= 2 * I_W2;
        {
            const int wh = r >> 5, ng = (r >> 3) & 3, ksl = r & 7;
            const float* pos = A.in[12] + (size_t)wh * 2048 + ksl * 256; const float* w1 = A.in[13] + (size_t)wh * 2048 * 256 + (size_t)(ksl * 256) * 256 + ng * 64 + lane;
            float acc = 0.f;
#pragma unroll 8
            for (int k = 0; k < 256; ++k) acc = fmaf(pos[k], w1[(size_t)k * 256], acc);
            ((float*)(ws + WS_B1P))[(wh * 8 + ksl) * 256 + ng * 64 + lane] = acc;
        }
    }
#endif
#ifndef HY_P0_SKIP_R
    for (int m = gw; m < M; m += NGW) rms_row(A.in[0] + (size_t)m * D, A.in[1], (bf16_t*)(ws + WS_XN) + (size_t)m * D, lane);
#endif
}

struct EpiIn {
    static constexpr bool PERM = true, AFTER_DRAIN = false;
    bf16_t* P; const float* gq_d; const float* gk_d; const float* gq_n; const float* gk_n3;
    __device__ __forceinline__ void operator()(const f32x4 (&acc)[2][2][4][2], const pg8::Unit& u, int wr, int wc, int fr, int fq) const {
        const int G = u.pn * 4 + wc;
        if (G > 60) return;
        int kind = 0; const float* g = nullptr; float post = 1.f;
        if (G < 8) { kind = 1; g = gq_d; post = QSCALE; }
        else if (G < 16) { kind = 1; g = gk_d; }
        else if (G < 24) { kind = 0; }
        else if (G < 32) { kind = 2; }
        else if (G < 40) { kind = 1; g = gq_n; post = QSCALE; }
        else if (G < 52) { const int wh = (G - 40) >> 1; if (wh == 2) { kind = 1; g = gk_n3 + 64; } else if (wh == 4) { kind = 1; g = gk_n3 + 128; } }
        else if (G < 60) { kind = 2; }
        else { kind = 3; }
        f32x4 gv[2][2];
#pragma unroll
        for (int bj = 0; bj < 2; ++bj)
#pragma unroll
            for (int n = 0; n < 2; ++n) gv[bj][n] = (kind == 1) ? (*(const f32x4*)(g + 32 * bj + 8 * fq + 4 * n)) * post : (f32x4){1.f, 1.f, 1.f, 1.f};
        bf16_t* base = P + (size_t)(u.pm * 256 + wr * 64 + fr) * LDP + G * 64 + 8 * fq;
#pragma unroll
        for (int ai = 0; ai < 2; ++ai)
#pragma unroll
            for (int m = 0; m < 4; ++m) {
                f32x4 v[2][2];
#pragma unroll
                for (int bj = 0; bj < 2; ++bj)
#pragma unroll
                    for (int n = 0; n < 2; ++n) v[bj][n] = acc[ai][bj][m][n];
                if (kind == 1) {
                    float ss = 0.f;
#pragma unroll
                    for (int bj = 0; bj < 2; ++bj)
#pragma unroll
                        for (int n = 0; n < 2; ++n) { const f32x4 x = v[bj][n]; ss += (x[0] * x[0] + x[1] * x[1]) + (x[2] * x[2] + x[3] * x[3]); }
                    ss += __shfl_xor(ss, 16); ss += __shfl_xor(ss, 32);
                    const float r = 1.0f / sqrtf(ss * (1.f / 64.f) + EPS);
#pragma unroll
                    for (int bj = 0; bj < 2; ++bj)
#pragma unroll
                        for (int n = 0; n < 2; ++n) v[bj][n] = (v[bj][n] * r) * gv[bj][n];
                } else if (kind == 2) {
#pragma unroll
                    for (int bj = 0; bj < 2; ++bj)
#pragma unroll
                        for (int n = 0; n < 2; ++n)
#pragma unroll
                            for (int e = 0; e < 4; ++e) v[bj][n][e] = siluf(v[bj][n][e]);
                } else if (kind == 3) {
#pragma unroll
                    for (int bj = 0; bj < 2; ++bj)
#pragma unroll
                        for (int n = 0; n < 2; ++n)
#pragma unroll
                            for (int e = 0; e < 4; ++e) v[bj][n][e] = sigmf(v[bj][n][e]);
                }
                bf16_t* rowp = base + (size_t)(ai * 128 + m * 16) * LDP;
#pragma unroll
                for (int bj = 0; bj < 2; ++bj) {
                    u32x4 w; w.x = cvtpk(v[bj][0][0], v[bj][0][1]); w.y = cvtpk(v[bj][0][2], v[bj][0][3]); w.z = cvtpk(v[bj][1][0], v[bj][1][1]); w.w = cvtpk(v[bj][1][2], v[bj][1][3]);
                    *(u32x4*)(rowp + 32 * bj) = w;
                }
            }
    }
};
struct EpiOut {
    static constexpr bool PERM = false, AFTER_DRAIN = false;
    const float* x; float* out;
    __device__ __forceinline__ void operator()(const f32x4 (&acc)[2][2][4][2], const pg8::Unit& u, int wr, int wc, int fr, int fq) const {
        const int col0 = u.pn * 256 + wc * 32 + 4 * fq;
#pragma unroll
        for (int ai = 0; ai < 2; ++ai)
#pragma unroll
            for (int m = 0; m < 4; ++m) {
                const size_t off = (size_t)(u.pm * 256 + ai * 128 + wr * 64 + m * 16 + fr) * D + col0;
#pragma unroll
                for (int bj = 0; bj < 2; ++bj)
#pragma unroll
                    for (int n = 0; n < 2; ++n) { const f32x4 xv = *(const f32x4*)(x + off + bj * 128 + n * 16); *(f32x4*)(out + off + bj * 128 + n * 16) = xv + acc[ai][bj][m][n]; }
            }
    }
};

__device__ __forceinline__ void compress_phase(const Args& A, ldsp lds, int wave, int lane) {
    unsigned char* ws = A.ws;
    const bf16_t* PROJ = (const bf16_t*)(ws + WS_PROJ);
    LAS bf16_t* hbuf = (LAS bf16_t*)(lds) + wave * (16 * 264);
    const int fr = lane & 15, kq = lane >> 4;
    for (int uidx = blockIdx.x; uidx < 128; uidx += gridDim.x) {
        const int wh = uidx & 1, kvh = (uidx >> 1) & 1, b = uidx >> 2;
        const bf16_t* src = PROJ + (size_t)(b * T) * LDP + C_NKV + wh * 128 + kvh * 64;
        const bf16_t* w1t = (const bf16_t*)(ws + WS_W1T) + (size_t)wh * 256 * 2048;
        const bf16_t* w2t = (const bf16_t*)(ws + WS_W2T) + (size_t)wh * 64 * 256;
        const float* b1 = A.in[14] + wh * 256; const float* b1p = (const float*)(ws + WS_B1P) + wh * 8 * 256;
        const int i = wave * 16 + fr;
        f32x4 acc[16];
#pragma unroll
        for (int nt = 0; nt < 16; ++nt) acc[nt] = (f32x4){0.f, 0.f, 0.f, 0.f};
#pragma unroll 2
        for (int ks = 0; ks < 64; ++ks) {
            const int k0 = 32 * ks + 8 * kq; int tok = 16 * i + (k0 >> 6); tok = tok < T ? tok : T - 1;
            const bf16x8 a = *(const bf16x8*)(src + (size_t)tok * LDP + (k0 & 63));
#pragma unroll
            for (int nt = 0; nt < 16; ++nt) {
                const bf16x8 bb = *(const bf16x8*)(w1t + (size_t)(nt * 16 + fr) * 2048 + k0);
                acc[nt] = __builtin_amdgcn_mfma_f32_16x16x32_bf16(a, bb, acc[nt], 0, 0, 0);
            }
        }
#pragma unroll
        for (int nt = 0; nt < 16; ++nt) {
            const int col = 16 * nt + fr; float bias = b1[col];
#pragma unroll
            for (int s = 0; s < 8; ++s) bias += b1p[s * 256 + col];
#pragma unroll
            for (int rg = 0; rg < 4; ++rg) { const float hv = siluf(acc[nt][rg] + bias); hbuf[(4 * kq + rg) * 264 + col] = (bf16_t)(cvtpk(hv, hv) & 0xffffu); }
        }
        LDS_FENCE();
        f32x4 acc2[4];
#pragma unroll
        for (int nt = 0; nt < 4; ++nt) acc2[nt] = (f32x4){0.f, 0.f, 0.f, 0.f};
#pragma unroll
        for (int ks = 0; ks < 8; ++ks) {
            const bf16x8 a = *(const LAS bf16x8*)(hbuf + fr * 264 + 32 * ks + 8 * kq);
#pragma unroll
            for (int nt = 0; nt < 4; ++nt) {
                const bf16x8 bb = *(const bf16x8*)(w2t + (size_t)(nt * 16 + fr) * 256 + 32 * ks + 8 * kq);
                acc2[nt] = __builtin_amdgcn_mfma_f32_16x16x32_bf16(a, bb, acc2[nt], 0, 0, 0);
            }
        }
        LDS_FENCE();
        bf16_t* dst = (bf16_t*)(ws + (wh == 0 ? WS_KC : WS_VC)) + (size_t)((b * 2 + kvh) * 128) * 64;
        const float* gk = A.in[11];
#pragma unroll
        for (int rg = 0; rg < 4; ++rg) {
            const int io = wave * 16 + 4 * kq + rg;
            float v[4];
#pragma unroll
            for (int nt = 0; nt < 4; ++nt) v[nt] = acc2[nt][rg];
            if (wh == 0) {
                float ss = (v[0] * v[0] + v[1] * v[1]) + (v[2] * v[2] + v[3] * v[3]);
                ss += __shfl_xor(ss, 1); ss += __shfl_xor(ss, 2); ss += __shfl_xor(ss, 4); ss += __shfl_xor(ss, 8);
                const float r = 1.0f / sqrtf(ss * (1.f / 64.f) + EPS);
#pragma unroll
                for (int nt = 0; nt < 4; ++nt) v[nt] = (v[nt] * r) * gk[16 * nt + fr];
            }
#pragma unroll
            for (int nt = 0; nt < 4; ++nt) { const float ov = (io < 127) ? v[nt] : 0.f; dst[(size_t)io * 64 + 16 * nt + fr] = (bf16_t)(cvtpk(ov, ov) & 0xffffu); }
        }
    }
}

__device__ __forceinline__ int crow(int r, int hi) { return (r & 3) + 8 * (r >> 2) + 4 * hi; }
typedef short v4i16_t __attribute__((ext_vector_type(4)));
__device__ __forceinline__ s16x4 vtr(const LAS unsigned char* p) { return __builtin_bit_cast(s16x4, __builtin_amdgcn_ds_read_tr16_b64_v4i16((LAS v4i16_t*)p)); }

__device__ __forceinline__ void qk_tile(f32x16& p0, f32x16& p1, const LAS unsigned char* kslot, const bf16x8 (&qr)[4], float c0, float c1, int r32, int hi) {
#pragma unroll
    for (int r = 0; r < 16; ++r) { p0[r] = c0; p1[r] = c1; }
    const LAS unsigned char* kb = kslot + hi * KCS + r32 * 16;
#pragma unroll
    for (int d0 = 0; d0 < 4; ++d0) {
        const bf16x8 b0 = *(const LAS bf16x8*)(kb + d0 * 2 * KCS);
        const bf16x8 b1 = *(const LAS bf16x8*)(kb + d0 * 2 * KCS + 512);
        p0 = __builtin_amdgcn_mfma_f32_32x32x16_bf16(b0, qr[d0], p0, 0, 0, 0);
        p1 = __builtin_amdgcn_mfma_f32_32x32x16_bf16(b1, qr[d0], p1, 0, 0, 0);
    }
}
template <bool ALIBI>
__device__ __forceinline__ void sm_tile(f32x16& p0, f32x16& p1, float slope2, float& l, bool need_mask, int kbase, int kmin, int kmax) {
#pragma unroll
    for (int r = 0; r < 16; ++r) {
        const float cr = (float)((r & 3) + 8 * (r >> 2));
        if (ALIBI) { p0[r] = __builtin_amdgcn_exp2f(fmaf(slope2, cr, p0[r])); p1[r] = __builtin_amdgcn_exp2f(fmaf(slope2, cr, p1[r])); }
        else { p0[r] = __builtin_amdgcn_exp2f(p0[r]); p1[r] = __builtin_amdgcn_exp2f(p1[r]); }
    }
    if (need_mask) {
#pragma unroll
        for (int r = 0; r < 16; ++r) {
            const int kv = kbase + (r & 3) + 8 * (r >> 2);
            if (kv < kmin || kv > kmax) p0[r] = 0.f;
            if (kv + 32 < kmin || kv + 32 > kmax) p1[r] = 0.f;
        }
    }
    float s = 0.f;
#pragma unroll
    for (int r = 0; r < 16; ++r) s += p0[r] + p1[r];
    l += s;
}
template <int NDV>
__device__ __forceinline__ void pv_tile(f32x16 (&o)[NDV], const f32x16& p0, const f32x16& p1, const LAS unsigned char* vp) {
    bf16x8 pa[4];
    { u32x4 w;
      w.x = cvtpk(p0[0], p0[1]); w.y = cvtpk(p0[2], p0[3]); w.z = cvtpk(p0[4], p0[5]); w.w = cvtpk(p0[6], p0[7]); pa[0] = __builtin_bit_cast(bf16x8, w);
      w.x = cvtpk(p0[8], p0[9]); w.y = cvtpk(p0[10], p0[11]); w.z = cvtpk(p0[12], p0[13]); w.w = cvtpk(p0[14], p0[15]); pa[1] = __builtin_bit_cast(bf16x8, w);
      w.x = cvtpk(p1[0], p1[1]); w.y = cvtpk(p1[2], p1[3]); w.z = cvtpk(p1[4], p1[5]); w.w = cvtpk(p1[6], p1[7]); pa[2] = __builtin_bit_cast(bf16x8, w);
      w.x = cvtpk(p1[8], p1[9]); w.y = cvtpk(p1[10], p1[11]); w.z = cvtpk(p1[12], p1[13]); w.w = cvtpk(p1[14], p1[15]); pa[3] = __builtin_bit_cast(bf16x8, w); }
#pragma unroll
    for (int d0 = 0; d0 < NDV; ++d0)
#pragma unroll
        for (int ks = 0; ks < 4; ++ks) {
            const s16x4 lo = vtr(vp + d0 * DHS + ks * 1024), hh = vtr(vp + d0 * DHS + ks * 1024 + 512);
            const bf16x8 vb = (bf16x8){lo[0], lo[1], lo[2], lo[3], hh[0], hh[1], hh[2], hh[3]};
            o[d0] = __builtin_amdgcn_mfma_f32_32x32x16_bf16(pa[ks], vb, o[d0], 0, 0, 0);
        }
}

struct AttnCtx {
    const bf16_t* PROJ; const bf16_t* KC; const bf16_t* VC; bf16_t* AOUT;
    const float* gsub;
    float lam;
    float M2d, M2c, M2s, M2w;
};

__device__ __forceinline__ void diff_unit(const AttnCtx& C0, int b, int h, int qb, ldsp lds, const int wid) {
    AttnCtx C = C0; { volatile LAS float* sc = (volatile LAS float*)(lds + L_MISC); C.lam = sc[4]; C.M2d = sc[5]; }
    int tid = hy_tid(wid); asm volatile("" : "+v"(tid));
    const int lane = tid & 63, r32 = lane & 31, hi = lane >> 5;
    const int cm = wid >> 2, wq = wid & 3;
    const int q0 = qb * 128, qlo = q0 + wq * 32, qpos = qlo + r32;
    const bf16_t* Pb = C.PROJ + (size_t)b * T * LDP;
    bf16x8 qr[4];
    { const bf16_t* qp = Pb + (size_t)qpos * LDP + C_DQ + h * 128 + cm * 64 + hi * 8;
#pragma unroll
      for (int d0 = 0; d0 < 4; ++d0) qr[d0] = *(const bf16x8*)(qp + d0 * 16); }
    const float slope2 = __builtin_ldexpf(1.0f, -2 * (h + 1)) * LOG2E;
    f32x16 o[4];
#pragma unroll
    for (int d0 = 0; d0 < 4; ++d0)
#pragma unroll
        for (int r = 0; r < 16; ++r) o[d0][r] = 0.f;
    float l = 0.f;
    const int NT = 2 * (qb + 1);
    constexpr int SLOT = 2 * KSLOT + 4 * DHS;
    const bf16_t* ksrc = Pb + (size_t)(tid >> 3) * LDP + C_DK + h * 128 + (tid & 7) * 8;
    const bf16_t* vsrc = Pb + (size_t)(tid >> 4) * LDP + C_DV + h * 128 + (tid & 15) * 8;
    const int kdst = (tid & 7) * KCS + (tid >> 3) * 16;
    const int vdst = 2 * KSLOT + ((tid & 15) >> 2) * DHS + (tid >> 4) * 64 + (tid & 3) * 16;
    const int vb = ((lane >> 4) & 1) * 32 + (lane & 3) * 8 + (4 * hi + ((lane & 15) >> 2)) * 64;
    u32x4 rk1, rk2, rv0, rv1;
#define DLOAD(t) do { const size_t to_ = (size_t)(t) * 64 * LDP; rk1 = *(const u32x4*)(ksrc + to_); rk2 = *(const u32x4*)(ksrc + to_ + 64); \
        rv0 = *(const u32x4*)(vsrc + to_); rv1 = *(const u32x4*)(vsrc + to_ + (size_t)32 * LDP); } while (0)
#define DSTORE(so) do { *(LAS u32x4*)(lds + (so) + kdst) = rk1; *(LAS u32x4*)(lds + (so) + KSLOT + kdst) = rk2; \
        *(LAS u32x4*)(lds + (so) + vdst) = rv0; *(LAS u32x4*)(lds + (so) + vdst + 32 * 64) = rv1; } while (0)
    DLOAD(0); DSTORE(0);
    __syncthreads();
    for (int t = 0; t < NT; ++t) {
        const int cur = (t & 1) * SLOT, nxt = SLOT - cur;
        if (t + 1 < NT) DLOAD(t + 1);
        if (64 * t <= qlo + 31) {
            const float c0 = fmaf(slope2, (float)(64 * t + 4 * hi - qpos), -C.M2d), c1 = c0 + 32.f * slope2;
            f32x16 p0, p1;
            qk_tile(p0, p1, lds + cur + cm * KSLOT, qr, c0, c1, r32, hi);
            sm_tile<true>(p0, p1, slope2, l, 64 * t + 63 > qlo, 64 * t + 4 * hi, 0, qpos);
            pv_tile<4>(o, p0, p1, lds + cur + 2 * KSLOT + vb);
        }
        if (t + 1 < NT) DSTORE(nxt);
        __syncthreads();
    }
#undef DLOAD
#undef DSTORE
    l += __shfl_xor(l, 32);
    LAS float* wsf = (LAS float*)(lds + L_WSF) + wid * 64;
    if (hi == 0) wsf[r32] = 1.0f / l;
    LDS_FENCE();
    float rl[16];
#pragma unroll
    for (int r = 0; r < 16; ++r) rl[r] = wsf[crow(r, hi)];
#pragma unroll
    for (int d0 = 0; d0 < 4; ++d0)
#pragma unroll
        for (int r = 0; r < 16; ++r) o[d0][r] *= rl[r];
    LAS float* xb = (LAS float*)lds + wq * 64 + lane;
    if (cm == 1) {
#pragma unroll
        for (int d0 = 0; d0 < 4; ++d0)
#pragma unroll
            for (int r = 0; r < 16; ++r) xb[(d0 * 16 + r) * 256] = o[d0][r];
    }
    __syncthreads();
    if (cm == 0) {
        float ss[16];
#pragma unroll
        for (int r = 0; r < 16; ++r) ss[r] = 0.f;
#pragma unroll
        for (int d0 = 0; d0 < 4; ++d0)
#pragma unroll
            for (int r = 0; r < 16; ++r) { const float v = o[d0][r] - C.lam * xb[(d0 * 16 + r) * 256]; o[d0][r] = v; ss[r] += v * v; }
#pragma unroll
        for (int r = 0; r < 16; ++r) {
            float s = ss[r];
            s += __shfl_xor(s, 1); s += __shfl_xor(s, 2); s += __shfl_xor(s, 4); s += __shfl_xor(s, 8); s += __shfl_xor(s, 16);
            ss[r] = (1.0f - LAM_INIT) / sqrtf(s * (1.f / 128.f) + EPS);
        }
#pragma unroll
        for (int d0 = 0; d0 < 4; ++d0) {
            const float gs = C.gsub[32 * d0 + r32];
#pragma unroll
            for (int r = 0; r < 16; ++r) {
                const int tok = qlo + crow(r, hi);
                const float z = bf2f(Pb[(size_t)tok * LDP + C_DZ + h * 128 + 32 * d0 + r32]);
                const float v = (o[d0][r] * ss[r]) * gs * z;
                C.AOUT[((size_t)b * T + tok) * D + h * 128 + 32 * d0 + r32] = (bf16_t)(cvtpk(v, v) & 0xffffu);
            }
        }
    }
    __syncthreads();
}

template <int TT>
__device__ __forceinline__ void cmp_groups(const f32x16& p0, const f32x16& p1, LAS float* GB, LAS float* TB, int hi) {
#pragma unroll
    for (int i = 0; i < 4; ++i) {
        const int m0 = 16 * TT + 2 * i + hi, m1 = m0 + 8;
        GB[m0] = (p0[4 * i] + p0[4 * i + 1]) + (p0[4 * i + 2] + p0[4 * i + 3]); TB[m0 + 1] = p0[4 * i + 3];
        GB[m1] = (p1[4 * i] + p1[4 * i + 1]) + (p1[4 * i + 2] + p1[4 * i + 3]); if (m1 + 1 < 32) TB[m1 + 1] = p1[4 * i + 3];
    }
}
template <int MODE>
__device__ __forceinline__ void nsa_stage(ldsp lds, const bf16_t* kthr, const bf16_t* vthr, int j0, int j1, const bf16x8 (&qr)[4],
                                          float slope2, float M2, int qpos, unsigned selmask, int tb, f32x16 (&o)[2], float& l, int tid, int lane, int r32, int hi) {
    constexpr int SLOT = 2 * KSLOT;
    const int kdst = (tid & 7) * KCS + (tid >> 3) * 16;
    const int vdst = KSLOT + ((tid & 7) >> 2) * DHS + (tid >> 3) * 64 + (tid & 3) * 16;
    const int vb = ((lane >> 4) & 1) * 32 + (lane & 3) * 8 + (4 * hi + ((lane & 15) >> 2)) * 64;
    u32x4 rk, rv;
    rk = *(const u32x4*)(kthr + (size_t)j0 * 64 * LDP); rv = *(const u32x4*)(vthr + (size_t)j0 * 64 * LDP);
    *(LAS u32x4*)(lds + kdst) = rk; *(LAS u32x4*)(lds + vdst) = rv;
    __syncthreads();
    for (int j = j0; j <= j1; ++j) {
        const int cur = ((j - j0) & 1) * SLOT, nxt = SLOT - cur;
        if (j < j1) { rk = *(const u32x4*)(kthr + (size_t)(j + 1) * 64 * LDP); rv = *(const u32x4*)(vthr + (size_t)(j + 1) * 64 * LDP); }
        {
            const float base = fmaf(slope2, (float)(64 * j + 4 * hi - qpos), -M2);
            float c0 = base, c1 = base + 32.f * slope2; bool need_mask; int kmin = 0;
            if (MODE == 1) { if (((selmask >> j) & 1u) == 0u) { c0 = -INFINITY; c1 = -INFINITY; } need_mask = (j == tb); }
            else { need_mask = (j == tb) || (j == tb - 8); kmin = qpos - 511; }
            f32x16 p0, p1;
            qk_tile(p0, p1, lds + cur, qr, c0, c1, r32, hi);
            sm_tile<true>(p0, p1, slope2, l, need_mask, 64 * j + 4 * hi, kmin, qpos);
            pv_tile<2>(o, p0, p1, lds + cur + KSLOT + vb);
        }
        if (j < j1) { *(LAS u32x4*)(lds + nxt + kdst) = rk; *(LAS u32x4*)(lds + nxt + vdst) = rv; }
        __syncthreads();
    }
}
__device__ __forceinline__ void nsa_accum(f32x16 (&tot)[2], const f32x16 (&o)[2], float f, LAS float* wsf, int r32, int hi) {
    LDS_FENCE();
    if (hi == 0) wsf[r32] = f;
    LDS_FENCE();
#pragma unroll
    for (int r = 0; r < 16; ++r) { const float fr = wsf[crow(r, hi)]; tot[0][r] += o[0][r] * fr; tot[1][r] += o[1][r] * fr; }
}
__device__ __forceinline__ void nsa_unit(const AttnCtx& C0, int b, int kvh, int tb, ldsp lds, const int wid) {
    AttnCtx C = C0; { volatile LAS float* sc = (volatile LAS float*)(lds + L_MISC); C.M2c = sc[6]; C.M2s = sc[7]; C.M2w = sc[8]; }
    int tid = hy_tid(wid); asm volatile("" : "+v"(tid));
    const int lane = tid & 63, r32 = lane & 31, hi = lane >> 5;
    const int g = wid >> 1, half = wid & 1, head = kvh * 4 + g;
    const int tokl = 32 * half + r32, qpos = tb * 64 + tokl;
    const bf16_t* Pb = C.PROJ + (size_t)b * T * LDP;
    bf16x8 qr[4];
    { const bf16_t* qp = Pb + (size_t)qpos * LDP + C_NQ + head * 64 + hi * 8;
#pragma unroll
      for (int d0 = 0; d0 < 4; ++d0) qr[d0] = *(const bf16x8*)(qp + d0 * 16); }
    const bf16_t* gatep = Pb + (size_t)qpos * LDP + C_NG + head;
    const float slope2 = __builtin_ldexpf(1.0f, -(head + 1)) * LOG2E;
    LAS float* wsf = (LAS float*)(lds + L_WSF) + wid * 64;
    f32x16 tot[2];
#pragma unroll
    for (int r = 0; r < 16; ++r) { tot[0][r] = 0.f; tot[1][r] = 0.f; }
    unsigned selmask;
    {
        f32x16 o[2];
#pragma unroll
        for (int r = 0; r < 16; ++r) { o[0][r] = 0.f; o[1][r] = 0.f; }
        float l = 0.f;
        const int cmax = (qpos >= 31) ? ((qpos - 31) >> 4) : -1;
        const bf16_t* kc = C.KC + (size_t)((b * 2 + kvh) * 128) * 64; const bf16_t* vc = C.VC + (size_t)((b * 2 + kvh) * 128) * 64;
        const int kdst = (tid & 7) * KCS + (tid >> 3) * 16;
        const int vdst = KSLOT + ((tid & 7) >> 2) * DHS + (tid >> 3) * 64 + (tid & 3) * 16;
        const int vb = ((lane >> 4) & 1) * 32 + (lane & 3) * 8 + (4 * hi + ((lane & 15) >> 2)) * 64;
        constexpr int SLOT = 2 * KSLOT;
#pragma unroll
        for (int tt = 0; tt < 2; ++tt) {
            *(LAS u32x4*)(lds + tt * SLOT + kdst) = *(const u32x4*)(kc + (size_t)(tt * 64 + (tid >> 3)) * 64 + (tid & 7) * 8);
            *(LAS u32x4*)(lds + tt * SLOT + vdst) = *(const u32x4*)(vc + (size_t)(tt * 64 + (tid >> 3)) * 64 + (tid & 7) * 8);
        }
        __syncthreads();
        LAS float* GB = (LAS float*)(lds + L_GB) + (g * 64 + tokl) * 33; LAS float* TB = (LAS float*)(lds + L_TB) + (g * 64 + tokl) * 33;
        { f32x16 p0, p1; qk_tile(p0, p1, lds, qr, -C.M2c, -C.M2c, r32, hi); sm_tile<false>(p0, p1, 0.f, l, true, 4 * hi, 0, cmax); cmp_groups<0>(p0, p1, GB, TB, hi); pv_tile<2>(o, p0, p1, lds + KSLOT + vb); }
        { f32x16 p0, p1; qk_tile(p0, p1, lds + SLOT, qr, -C.M2c, -C.M2c, r32, hi); sm_tile<false>(p0, p1, 0.f, l, true, 64 + 4 * hi, 0, cmax); cmp_groups<1>(p0, p1, GB, TB, hi); pv_tile<2>(o, p0, p1, lds + SLOT + KSLOT + vb); }
        l += __shfl_xor(l, 32);
        const float invl = (l > 0.f) ? 1.0f / l : 0.f;
        if (hi == 0) ((LAS float*)(lds + L_LB))[g * 64 + tokl] = invl;
        nsa_accum(tot, o, bf2f(gatep[0]) * invl, wsf, r32, hi);
        __syncthreads();
        if (tb <= 7) selmask = (2u << tb) - 1u;
        else {
            float imp[32];
            const LAS float* G0 = (const LAS float*)(lds + L_GB) + tokl * 33; const LAS float* T0 = (const LAS float*)(lds + L_TB) + tokl * 33;
            float il[4];
#pragma unroll
            for (int gg = 0; gg < 4; ++gg) il[gg] = ((const LAS float*)(lds + L_LB))[gg * 64 + tokl];
#pragma unroll
            for (int s = 0; s < 32; ++s) {
                float a = 0.f;
#pragma unroll
                for (int gg = 0; gg < 4; ++gg) { float v = G0[gg * 64 * 33 + s]; if (s > 0) v += T0[gg * 64 * 33 + s]; a = fmaf(v, il[gg], a); }
                imp[s] = a;
            }
            unsigned sel = 0u;
#pragma unroll 1
            for (int it = 0; it < 5; ++it) {
                float bv = -1.0f; int best = 0;
#pragma unroll
                for (int s = 1; s < 30; ++s) { const bool ok = (s <= tb - 2) && (((sel >> s) & 1u) == 0u) && (imp[s] > bv); if (ok) { bv = imp[s]; best = s; } }
                sel |= 1u << best;
            }
            selmask = (sel & ~1u) | 1u | (1u << (tb - 1)) | (1u << tb);
        }
    }
    const bf16_t* kvthr = Pb + (size_t)(tid >> 3) * LDP + C_NKV + kvh * 64 + (tid & 7) * 8;
    {
        f32x16 o[2];
#pragma unroll
        for (int r = 0; r < 16; ++r) { o[0][r] = 0.f; o[1][r] = 0.f; }
        float l = 0.f;
        nsa_stage<1>(lds, kvthr + 2 * 128, kvthr + 3 * 128, 0, tb, qr, slope2, C.M2s, qpos, selmask, tb, o, l, tid, lane, r32, hi);
        l += __shfl_xor(l, 32);
        nsa_accum(tot, o, bf2f(gatep[8]) / l, wsf, r32, hi);
    }
    {
        f32x16 o[2];
#pragma unroll
        for (int r = 0; r < 16; ++r) { o[0][r] = 0.f; o[1][r] = 0.f; }
        float l = 0.f;
        nsa_stage<2>(lds, kvthr + 4 * 128, kvthr + 5 * 128, tb >= 8 ? tb - 8 : 0, tb, qr, slope2, C.M2w, qpos, 0u, tb, o, l, tid, lane, r32, hi);
        l += __shfl_xor(l, 32);
        nsa_accum(tot, o, bf2f(gatep[16]) / l, wsf, r32, hi);
    }
#pragma unroll
    for (int d0 = 0; d0 < 2; ++d0)
#pragma unroll
        for (int r = 0; r < 16; ++r) {
            const int tok = tb * 64 + 32 * half + crow(r, hi);
            const float z = bf2f(Pb[(size_t)tok * LDP + C_NZ + head * 64 + 32 * d0 + r32]);
            const float v = tot[d0][r] * z;
            C.AOUT[((size_t)b * T + tok) * D + 512 + head * 64 + 32 * d0 + r32] = (bf16_t)(cvtpk(v, v) & 0xffffu);
        }
}

__device__ __forceinline__ void attn_phase(const Args& A, ldsp lds, const int wave, int lane) {
    const bool t0 = (wave == 0 && lane == 0);
    unsigned char* ws = A.ws;
    AttnCtx C;
    C.PROJ = (const bf16_t*)(ws + WS_PROJ); C.KC = (const bf16_t*)(ws + WS_KC); C.VC = (const bf16_t*)(ws + WS_VC); C.AOUT = (bf16_t*)(ws + WS_AOUT);
    C.gsub = A.in[9];
    {
        const float sa = wave_sum(A.in[5][lane] * A.in[6][lane]), sb = wave_sum(A.in[7][lane] * A.in[8][lane]);
        C.lam = expf(sa) - expf(sb) + LAM_INIT;
        const float mqd = wave_max(fabsf(A.in[3][lane])), mkd = wave_max(fabsf(A.in[4][lane])), mqn = wave_max(fabsf(A.in[10][lane]));
        const float mk0 = wave_max(fabsf(A.in[11][lane])), mk1 = wave_max(fabsf(A.in[11][64 + lane])), mk2 = wave_max(fabsf(A.in[11][128 + lane]));
        C.M2d = MCOEF * mqd * mkd; C.M2c = MCOEF * mqn * mk0; C.M2s = MCOEF * mqn * mk1; C.M2w = MCOEF * mqn * mk2;
        if (t0) { LAS float* sc = (LAS float*)(lds + L_MISC); sc[4] = C.lam; sc[5] = C.M2d; sc[6] = C.M2c; sc[7] = C.M2s; sc[8] = C.M2w; }
        C.lam = 0.f; C.M2d = 0.f; C.M2c = 0.f; C.M2s = 0.f; C.M2w = 0.f;
    }
    unsigned* qctr = (unsigned*)(ws + WS_CTL) + CW_QCTR;
    volatile LAS unsigned* bc = (volatile LAS unsigned*)(lds + L_MISC);
    for (;;) {
        if (t0) bc[0] = atomicAdd(qctr, 1u);
        __syncthreads();
        const unsigned idx = bc[0];
        __syncthreads();
        if (idx >= 4096u) break;
        const int j = 15 - (int)(idx >> 8), r = (int)(idx & 255u);
#ifndef HY_NO_DIFF
        if (r < 128) diff_unit(C, r >> 2, r & 3, j, lds, wave);
#endif
#ifndef HY_NO_NSA
        if (r >= 128) { const int q = (r - 128) & 63, tb = (r < 192) ? 2 * j + 1 : 2 * j; nsa_unit(C, q >> 1, q & 1, tb, lds, wave); }
#endif
    }
}

#define XB_TMO      128
#define XB_XCNT(j)  (256  + 64 * (j))
#define XB_XSUB(j)  (1280 + 64 * (j))
#define XB_XGEN(j)  (2304 + 64 * (j))
#define XB_TOP      3328
#define XB_TOPGEN   3392
#define XCD_BAR_WORDS 3456
#define XB_SPIN_CAP (1u << 22)
__device__ __forceinline__ unsigned xb_ld(unsigned* p)              { return __hip_atomic_load(p, __ATOMIC_RELAXED, __HIP_MEMORY_SCOPE_AGENT); }
__device__ __forceinline__ unsigned xb_add(unsigned* p, unsigned v) { return __hip_atomic_fetch_add(p, v, __ATOMIC_RELAXED, __HIP_MEMORY_SCOPE_AGENT); }
__device__ __forceinline__ unsigned xb_xcc_id() { return (unsigned)__builtin_amdgcn_s_getreg((3 << 11) | 20) & 0xFu; }
#define XB_SPIN(cond, bar) do { unsigned _sp = 0; while (cond) { __builtin_amdgcn_s_sleep(1); \
    if ((++_sp & 255u) == 0u) { if (xb_ld(&(bar)[XB_TMO])) break; if (_sp > XB_SPIN_CAP) { atomicAdd(&(bar)[XB_TMO], 1u); break; } } } } while (0)
struct XcdBarrier { unsigned* bar; unsigned x; volatile LAS unsigned* st; };
__device__ __forceinline__ XcdBarrier xcd_barrier_post(unsigned* bar, volatile LAS unsigned* st, bool t0) {
    XcdBarrier b; b.bar = bar; b.x = xb_xcc_id(); b.st = st;
    if (t0) (void)xb_add(&bar[XB_XCNT(b.x)], 1u);
    return b;
}
__device__ __forceinline__ void xcd_barrier_complete(unsigned* bar, unsigned x, unsigned& nloc, unsigned& nx) {
    const unsigned G = gridDim.x * gridDim.y * gridDim.z;
    unsigned sum, cnt, mine, sp = 0u;
    for (;;) {
        sum = 0u; cnt = 0u; mine = 0u;
#pragma unroll
        for (unsigned j = 0; j < 16; ++j) { const unsigned c = xb_ld(&bar[XB_XCNT(j)]); sum += c; cnt += (c > 0u) ? 1u : 0u; mine = (j == x) ? c : mine; }
        if (sum == G) break;
        __builtin_amdgcn_s_sleep(1);
        if ((++sp & 255u) == 0u) { if (xb_ld(&bar[XB_TMO])) break; if (sp > XB_SPIN_CAP) { atomicAdd(&bar[XB_TMO], 1u); break; } }
    }
    nloc = mine > 0u ? mine : 1u; nx = cnt > 0u ? cnt : 1u;
}
__device__ __forceinline__ void xcd_barrier(const XcdBarrier& b, bool t0) {
    asm volatile("s_waitcnt vmcnt(0)" ::: "memory");
    __syncthreads();
    if (t0) {
        unsigned* bar = b.bar;
        __builtin_amdgcn_s_waitcnt(0);
        unsigned nloc = b.st[0], nx = b.st[1];
        if (nloc == 0u) { xcd_barrier_complete(bar, b.x, nloc, nx); b.st[0] = nloc; b.st[1] = nx; }
        const unsigned old = xb_add(&bar[XB_XSUB(b.x)], 1u);
        const unsigned gen = old / nloc;
        if (old + 1u == (gen + 1u) * nloc) {
            __builtin_amdgcn_fence(__ATOMIC_RELEASE, "agent");
            asm volatile("s_waitcnt vmcnt(0)" ::: "memory");
            const unsigned og = xb_add(&bar[XB_TOP], 1u);
            const unsigned tg = og / nx;
            if (og + 1u == (tg + 1u) * nx) xb_add(&bar[XB_TOPGEN], 1u);
            else XB_SPIN(xb_ld(&bar[XB_TOPGEN]) == tg, bar);
            __builtin_amdgcn_fence(__ATOMIC_ACQUIRE, "agent");
            xb_add(&bar[XB_XGEN(b.x)], 1u);
            asm volatile("s_waitcnt vmcnt(0)" ::: "memory");
        } else {
            XB_SPIN(xb_ld(&bar[XB_XGEN(b.x)]) == gen, bar);
            __builtin_amdgcn_fence(__ATOMIC_ACQUIRE, "agent");
            asm volatile("s_waitcnt vmcnt(0)" ::: "memory");
        }
    }
    __syncthreads();
}
constexpr int CW_BAR = 4096;

__global__ void __launch_bounds__(512, 2) hymba_fwd(Args args) {
    extern __shared__ __attribute__((aligned(16))) unsigned char lds_raw[];
    ldsp lds = (ldsp)lds_raw;
    const int wave = __builtin_amdgcn_readfirstlane((int)threadIdx.x >> 6);
    const int G = gridDim.x; const int bx = blockIdx.x; const int vcu = (G % 8 == 0) ? (bx % 8) * (G / 8) + bx / 8 : bx;
    unsigned char* ws = args.ws;
    const int lo = args.ph_lo, hi = args.ph_hi;
#ifndef HY_PHASE_MASK
#define HY_PHASE_MASK 31
#endif
#define IN(k) ((((HY_PHASE_MASK) >> (k)) & 1) && lo <= (k) && (k) < hi)
#if HY_N_LAUNCHES == 1
    const bool t0 = (wave == 0) && ((hy_tid(wave) & 63) == 0);
    { volatile LAS unsigned* st = (volatile LAS unsigned*)(lds + L_MISC + 64); if (t0) { st[0] = 0u; st[1] = 0u; } __syncthreads(); }
    const XcdBarrier bar = xcd_barrier_post((unsigned*)(ws + WS_CTL) + CW_BAR, (volatile LAS unsigned*)(lds + L_MISC + 64), t0);
#define SEAM(k) do { if (IN(k) && IN((k) + 1)) { xcd_barrier(bar, (wave == 0) && ((hy_tid(wave) & 63) == 0)); } } while (0)
#else
#define SEAM(k) do { } while (0)
#endif
    if (IN(0)) { p0_prologue(args, lds, vcu, G, wave, hy_tid(wave) & 63); }
    SEAM(0);
    if (IN(1)) {
        pg8::Gemm g{(const bf16_t*)(ws + WS_XN), (const bf16_t*)(ws + WS_WIN), M, NPAD, D}; pg8::StaticOrder S; S.init(M, NPAD, G, bx);
        EpiIn E{(bf16_t*)(ws + WS_PROJ), args.in[3], args.in[4], args.in[10], args.in[11]};
        pg8::gemm_phase<EpiIn, pg8::StaticOrder, true, true>((PG8_LAS unsigned char*)lds, g, S, E, wave);
    }
    SEAM(1);
    if (IN(2)) { compress_phase(args, lds, wave, hy_tid(wave) & 63); }
    SEAM(2);
    if (IN(3)) { attn_phase(args, lds, wave, hy_tid(wave) & 63); }
    SEAM(3);
    if (IN(4)) {
        pg8::Gemm g{(const bf16_t*)(ws + WS_AOUT), (const bf16_t*)(ws + WS_WOUT), M, D, D}; pg8::StaticOrder S; S.init(M, D, G, bx);
        EpiOut E{args.in[0], args.out};
        pg8::gemm_phase<EpiOut, pg8::StaticOrder, true, true>((PG8_LAS unsigned char*)lds, g, S, E, wave);
    }
#undef IN
#undef SEAM
}
}

extern "C" void kernel_launch(void* const* d_in, const int* in_sizes, int n_in, void* d_out, int out_size, void* d_ws, size_t ws_size, hipStream_t stream) {
    using namespace hy;
    static int grid = 0;
    if (grid == 0) {
        if (n_in != 17 || in_sizes[0] != M * D || out_size != M * D || ws_size < WS_END) {
            fprintf(stderr, "kernel_launch: unexpected shapes (n_in %d, in0 %d, out %d, ws %zu)\n", n_in, n_in > 0 ? in_sizes[0] : -1, out_size, ws_size); grid = -1; return; }
        { const int want[17] = {M * D, D, D * NIN, 64, 64, 64, 64, 64, 64, 128, 64, 192, 2 * 32 * 64, 2 * 2048 * 256, 2 * 256, 2 * 256 * 64, D * D};
          for (int i = 0; i < 17; ++i) if (in_sizes[i] != want[i]) { fprintf(stderr, "kernel_launch: input %d has %d elements, expected %d\n", i, in_sizes[i], want[i]); grid = -1; return; } }
        int dev = 0, cus = 0, per_cu = 0;
        if (hipGetDevice(&dev) != hipSuccess || hipDeviceGetAttribute(&cus, hipDeviceAttributeMultiprocessorCount, dev) != hipSuccess) { grid = -1; return; }
        if (hipFuncSetAttribute((const void*)hymba_fwd, hipFuncAttributeMaxDynamicSharedMemorySize, LDS_BYTES) != hipSuccess) { fprintf(stderr, "kernel_launch: hipFuncSetAttribute failed\n"); grid = -1; return; }
        if (hipOccupancyMaxActiveBlocksPerMultiprocessor(&per_cu, (const void*)hymba_fwd, 512, LDS_BYTES) != hipSuccess || per_cu < 1) { fprintf(stderr, "kernel_launch: occupancy query says %d blocks per CU\n", per_cu); grid = -1; return; }
        (void)hipGetLastError();
        grid = cus * 1;
    }
    if (grid < 0) return;
    (void)hipMemsetAsync((char*)d_ws + WS_CTL, 0, CTL_BYTES, stream);
    Args a{};
    for (int i = 0; i < 17; ++i) a.in[i] = (const float*)d_in[i];
    a.out = (float*)d_out; a.ws = (unsigned char*)d_ws;
#if HY_N_LAUNCHES == 1
    a.ph_lo = 0; a.ph_hi = 5;
    void* kargs[] = {&a};
    hipError_t e = hipLaunchCooperativeKernel((const void*)hymba_fwd, dim3(grid), dim3(512), kargs, LDS_BYTES, stream);
    if (e != hipSuccess) fprintf(stderr, "kernel_launch: cooperative launch failed: %s (grid %d)\n", hipGetErrorString(e), grid);
#else
    for (int p = 0; p < 5; ++p) { a.ph_lo = p; a.ph_hi = p + 1; hipLaunchKernelGGL(hymba_fwd, dim3(grid), dim3(512), LDS_BYTES, stream, a); }
#endif
}
```

```cpp
#include <hip/hip_runtime.h>
#include <cstdio>
#include <cstdint>
#include <cmath>
#define HY_N_LAUNCHES 1
namespace pg8 {
#define PG8_LAS __attribute__((address_space(3)))
typedef unsigned short bf16_t;
typedef short bf16x8 __attribute__((ext_vector_type(8)));
typedef float f32x4 __attribute__((ext_vector_type(4)));
typedef unsigned u32x4 __attribute__((ext_vector_type(4)));
constexpr int BM = 256, BK = 64, HALF = 128, HTB = HALF * BK * 2  , STAGE_BYTES = 8 * HTB, NXCD = 8, WGM = 8;

__host__ __device__ __forceinline__ int lds_byte(int r, int c) { const int st = (r >> 4) * 2 + (c >> 5), rr = r & 15, cc = c & 31, ob = rr * 64 + cc * 2; return st * 1024 + (ob ^ (((ob >> 9) & 1) << 5)); }
__host__ __device__ __forceinline__ void stage_rc(int b, int& R, int& C) { const int st = b / 1024, sb = b % 1024, swz = sb ^ (((sb >> 9) & 1) << 5); R = (st >> 1) * 16 + swz / 64; C = (st & 1) * 32 + (swz % 64) / 2; }
__host__ __device__ __forceinline__ int perm32(int rho) { const int n = rho >> 4, i = rho & 15; return 8 * (i >> 2) + 4 * n + (i & 3); }

struct Unit { int pm, pn; };
struct Gemm { const bf16_t* A; const bf16_t* Bt; int M, N, K; };

struct StaticOrder {
    int nM, nN, nwg, G, c;
    __host__ __device__ void init(int M, int N, int G_, int c_) { nM = M / BM; nN = N / BM; nwg = nM * nN; G = G_; c = c_; }
    __host__ __device__ bool next(int i, Unit& u) const {
        const long L = (long)i * G + c; if (L >= nwg) return false;
        int wgid = (int)L; { const int q = nwg / NXCD, r = nwg % NXCD, xcd = wgid % NXCD, off = wgid / NXCD; wgid = (xcd < r ? xcd * (q + 1) : r * (q + 1) + (xcd - r) * q) + off; }
        const int nig = WGM * nN, gid = wgid / nig, fm = gid * WGM, gsz = (nM - fm) < WGM ? (nM - fm) : WGM;
        u.pm = fm + ((wgid % nig) % gsz); u.pn = (wgid % nig) / gsz; return true;
    }
    __device__ __forceinline__ void a_ready(const Unit&) const {}
    __device__ __forceinline__ void done(const Unit&) const {}
};

template <class Epi, class Sched, bool ALIGN_EPI = false, bool SP2 = false>
__device__ __forceinline__ void gemm_phase(PG8_LAS unsigned char* lds, const Gemm g, const Sched& S, const Epi& E, const int wid) {
    unsigned z_; asm volatile("v_mov_b32 %0, 0" : "=v"(z_));
    const int tid = wid * 64 + (int)__builtin_amdgcn_mbcnt_hi(~0u, __builtin_amdgcn_mbcnt_lo(~0u, z_)), lane = tid & 63, wr = wid >> 2, wc = wid & 3, fr = lane & 15, fq = lane >> 4;
    const int K = g.K, nt = K / BK;
    unsigned voffA[2], voffB[2];
#pragma unroll
    for (int i = 0; i < 2; ++i) { int R, C; stage_rc(tid * 16 + i * 8192, R, C); const int Rb = Epi::PERM ? ((R & ~31) + perm32(R & 31)) : R;
        voffA[i] = (unsigned)(R * K + C) * 2u; voffB[i] = (unsigned)(Rb * K + C) * 2u; }
    const size_t kstep = (size_t)(BK * 2);
    const size_t hstep = (size_t)HALF * K * 2;
    const size_t tstep = 2 * hstep;
    const unsigned ldsw = (unsigned)wid * 1024u;
    const int aoff = lds_byte(wr * 64 + fr, fq * 8), boff = lds_byte(wc * 32 + fr, fq * 8);
#define PG8_SA(b, h) (((b) * 2 + (h)) * HTB)
#define PG8_SB(b, h) ((4 + (b) * 2 + (h)) * HTB)
#define PG8_STAGE(bufoff, gbase, voff) do { _Pragma("unroll") for (int _i = 0; _i < 2; ++_i) \
        __builtin_amdgcn_global_load_lds((const unsigned*)((const char*)(gbase) + (voff)[_i]), (PG8_LAS unsigned*)(lds + (bufoff) + ldsw + _i * 8192), 16, 0, 0); } while (0)
#define PG8_LDA(dst, b, h) do { _Pragma("unroll") for (int m = 0; m < 4; ++m) _Pragma("unroll") for (int k = 0; k < 2; ++k) dst[m][k] = *(const PG8_LAS bf16x8*)(lds + PG8_SA(b, h) + aoff + m * 2048 + k * 1024); } while (0)
#define PG8_LDB(dst, b, h) do { _Pragma("unroll") for (int n = 0; n < 2; ++n) _Pragma("unroll") for (int k = 0; k < 2; ++k) dst[n][k] = *(const PG8_LAS bf16x8*)(lds + PG8_SB(b, h) + boff + n * 2048 + k * 1024); } while (0)
#define PG8_MMA(ai, bj, At, Bt) do { __builtin_amdgcn_s_setprio(1); _Pragma("unroll") for (int m = 0; m < 4; ++m) _Pragma("unroll") for (int n = 0; n < 2; ++n) _Pragma("unroll") for (int k = 0; k < 2; ++k) \
        acc[ai][bj][m][n] = __builtin_amdgcn_mfma_f32_16x16x32_bf16(Bt[n][k], At[m][k], acc[ai][bj][m][n], 0, 0, 0); __builtin_amdgcn_s_setprio(0); } while (0)
#define PG8_WAIT_V(n) asm volatile("s_waitcnt vmcnt(" #n ")" ::: "memory")
#define PG8_WAIT_L(n) asm volatile("s_waitcnt lgkmcnt(" #n ")" ::: "memory")
#define PG8_BAR __builtin_amdgcn_s_barrier()
#define PG8_SCHED __builtin_amdgcn_sched_barrier(0)
    Unit cur, nxt; int ui = 0;
    if (!S.next(0, cur)) return;
    f32x4 acc[2][2][4][2];
#pragma unroll
    for (int a = 0; a < 2; ++a)
#pragma unroll
        for (int b = 0; b < 2; ++b)
#pragma unroll
            for (int m = 0; m < 4; ++m)
#pragma unroll
                for (int n = 0; n < 2; ++n) acc[a][b][m][n] = (f32x4){0.f, 0.f, 0.f, 0.f};
    bf16x8 At[4][2], B0[2][2], B1[2][2];
    const char* cA = (const char*)g.A + (size_t)cur.pm * tstep; const char* cB = (const char*)g.Bt + (size_t)cur.pn * tstep;
    S.a_ready(cur);
    if constexpr (SP2) {
        PG8_STAGE(PG8_SB(0, 0), cB, voffB); PG8_STAGE(PG8_SB(0, 1), cB + hstep, voffB); PG8_STAGE(PG8_SA(0, 0), cA, voffA); PG8_STAGE(PG8_SA(0, 1), cA + hstep, voffA);
        if (wr == 1) PG8_BAR;
        PG8_WAIT_V(2); PG8_BAR;
        PG8_STAGE(PG8_SB(1, 0), cB + kstep, voffB); PG8_STAGE(PG8_SA(1, 0), cA + kstep, voffA); PG8_STAGE(PG8_SB(1, 1), cB + hstep + kstep, voffB);
        PG8_WAIT_V(6); PG8_BAR;
    } else {
        PG8_STAGE(PG8_SB(0, 0), cB, voffB); PG8_STAGE(PG8_SA(0, 0), cA, voffA); PG8_STAGE(PG8_SB(0, 1), cB + hstep, voffB); PG8_STAGE(PG8_SA(0, 1), cA + hstep, voffA);
        if (wr == 1) PG8_BAR;
        PG8_WAIT_V(4); PG8_BAR;
        PG8_STAGE(PG8_SB(1, 0), cB + kstep, voffB); PG8_STAGE(PG8_SA(1, 0), cA + kstep, voffA); PG8_STAGE(PG8_SB(1, 1), cB + hstep + kstep, voffB);
        PG8_WAIT_V(6); PG8_BAR;
    }
    for (;;) {
        const bool has_next = S.next(ui + 1, nxt);
        const char* nA = has_next ? (const char*)g.A + (size_t)nxt.pm * tstep : cA; const char* nB = has_next ? (const char*)g.Bt + (size_t)nxt.pn * tstep : cB;
        for (int t = 0; t < nt; t += 2) {
            const bool last = (t == nt - 2);
            const char* a1 = cA + (size_t)(t + 1) * kstep;
            const char* a2 = last ? nA : cA + (size_t)(t + 2) * kstep; const char* b2 = last ? nB : cB + (size_t)(t + 2) * kstep;
            const char* a3 = a2 + kstep; const char* b3 = b2 + kstep;
            if (last && has_next) S.a_ready(nxt);
            if constexpr (SP2) {
            PG8_LDB(B0, 0, 0); PG8_LDB(B1, 0, 1); PG8_SCHED; PG8_LDA(At, 0, 0); PG8_STAGE(PG8_SA(1, 1), a1 + hstep, voffA);
            PG8_WAIT_V(8); PG8_WAIT_L(0); PG8_BAR; PG8_MMA(0, 0, At, B0); PG8_MMA(0, 1, At, B1); PG8_BAR; PG8_SCHED;
            PG8_LDA(At, 0, 1); PG8_STAGE(PG8_SB(0, 0), b2, voffB); PG8_STAGE(PG8_SB(0, 1), b2 + hstep, voffB); PG8_STAGE(PG8_SA(0, 0), a2, voffA);
            PG8_WAIT_V(8); PG8_WAIT_L(0); PG8_BAR; PG8_MMA(1, 0, At, B0); PG8_MMA(1, 1, At, B1); PG8_BAR; PG8_SCHED;
            PG8_LDB(B0, 1, 0); PG8_LDB(B1, 1, 1); PG8_SCHED; PG8_LDA(At, 1, 0); PG8_STAGE(PG8_SA(0, 1), a2 + hstep, voffA);
            PG8_WAIT_V(8); PG8_WAIT_L(0); PG8_BAR; PG8_MMA(0, 0, At, B0); PG8_MMA(0, 1, At, B1); PG8_BAR; PG8_SCHED;
            PG8_LDA(At, 1, 1); PG8_STAGE(PG8_SB(1, 0), b3, voffB); PG8_STAGE(PG8_SB(1, 1), b3 + hstep, voffB); PG8_STAGE(PG8_SA(1, 0), a3, voffA);
            PG8_WAIT_V(8); PG8_WAIT_L(0); PG8_BAR; PG8_MMA(1, 0, At, B0); PG8_MMA(1, 1, At, B1); PG8_BAR; PG8_SCHED;
            } else {
            PG8_LDB(B0, 0, 0); PG8_SCHED; PG8_LDA(At, 0, 0); PG8_STAGE(PG8_SA(1, 1), a1 + hstep, voffA);
            PG8_WAIT_L(8); PG8_BAR; PG8_WAIT_L(0); PG8_MMA(0, 0, At, B0); PG8_BAR; PG8_SCHED;
            PG8_LDB(B1, 0, 1); PG8_STAGE(PG8_SB(0, 0), b2, voffB);
            PG8_BAR; PG8_WAIT_L(0); PG8_MMA(0, 1, At, B1); PG8_BAR;
            PG8_LDA(At, 0, 1); PG8_STAGE(PG8_SA(0, 0), a2, voffA);
            PG8_BAR; PG8_WAIT_L(0); PG8_MMA(1, 0, At, B0); PG8_BAR; PG8_SCHED;
            PG8_STAGE(PG8_SB(0, 1), b2 + hstep, voffB);
            PG8_WAIT_V(6); PG8_BAR; PG8_MMA(1, 1, At, B1); PG8_BAR;
            PG8_LDB(B0, 1, 0); PG8_SCHED; PG8_LDA(At, 1, 0); PG8_STAGE(PG8_SA(0, 1), a2 + hstep, voffA);
            PG8_WAIT_L(8); PG8_BAR; PG8_WAIT_L(0); PG8_MMA(0, 0, At, B0); PG8_BAR; PG8_SCHED;
            PG8_LDB(B1, 1, 1); PG8_STAGE(PG8_SB(1, 0), b3, voffB);
            PG8_BAR; PG8_WAIT_L(0); PG8_MMA(0, 1, At, B1); PG8_BAR;
            PG8_LDA(At, 1, 1); PG8_STAGE(PG8_SA(1, 0), a3, voffA);
            PG8_BAR; PG8_WAIT_L(0); PG8_MMA(1, 0, At, B0); PG8_BAR; PG8_SCHED;
            PG8_STAGE(PG8_SB(1, 1), b3 + hstep, voffB);
            PG8_WAIT_V(6); PG8_BAR; PG8_MMA(1, 1, At, B1); PG8_BAR;
            }
        }
        if constexpr (ALIGN_EPI) { if (wr == 0) PG8_BAR; }
        if constexpr (!Epi::AFTER_DRAIN) { E(acc, cur, wr, wc, fr, fq); S.done(cur); }
        if (!has_next) break;
#pragma unroll
        for (int a = 0; a < 2; ++a)
#pragma unroll
            for (int b = 0; b < 2; ++b)
#pragma unroll
                for (int m = 0; m < 4; ++m)
#pragma unroll
                    for (int n = 0; n < 2; ++n) acc[a][b][m][n] = (f32x4){0.f, 0.f, 0.f, 0.f};
        cur = nxt; cA = nA; cB = nB; ++ui;
        if constexpr (ALIGN_EPI) { if (wr == 1) PG8_BAR; }
    }
    PG8_WAIT_V(0);
    if constexpr (!ALIGN_EPI) { if (wr == 0) PG8_BAR; }
    PG8_BAR;
    if constexpr (Epi::AFTER_DRAIN) { E.fused(acc, cur, wr, wc, fr, fq, lds, wid, lane); S.done(cur); }
#undef PG8_SA
#undef PG8_SB
#undef PG8_STAGE
#undef PG8_LDA
#undef PG8_LDB
#undef PG8_MMA
#undef PG8_WAIT_V
#undef PG8_WAIT_L
#undef PG8_BAR
#undef PG8_SCHED
}
}

#ifndef HY_P4_ALIGN
#define HY_P4_ALIGN true
#endif
#ifndef HY_N_LAUNCHES
#define HY_N_LAUNCHES 5
#endif

namespace hy {
#define LAS __attribute__((address_space(3)))
typedef unsigned short bf16_t;
typedef short bf16x8 __attribute__((ext_vector_type(8)));
typedef short s16x4 __attribute__((ext_vector_type(4)));
typedef float f32x4 __attribute__((ext_vector_type(4)));
typedef float f32x16 __attribute__((ext_vector_type(16)));
typedef unsigned u32x4 __attribute__((ext_vector_type(4)));
typedef unsigned u32x2 __attribute__((ext_vector_type(2)));
typedef LAS unsigned char* ldsp;

constexpr int BATCH = 32, T = 2048, D = 1024, M = BATCH * T;
constexpr int NIN = 3864, NPAD = 4096, LDP = 3904;
constexpr int C_DQ = 0, C_DK = 512, C_DV = 1024, C_DZ = 1536, C_NQ = 2048, C_NKV = 2560, C_NZ = 3328, C_NG = 3840;
constexpr float EPS = 1e-6f;
constexpr float LOG2E = 1.4426950408889634f;
constexpr float QSCALE = 0.125f * LOG2E;
constexpr float MCOEF = QSCALE * 64.0f;
constexpr float LAM_INIT = 0.2f;

constexpr size_t MiB = 1u << 20;
constexpr size_t WS_CTL = 0, CTL_BYTES = 1 * MiB;
constexpr size_t WS_WIN = 2 * MiB;
constexpr size_t WS_WOUT = 12 * MiB;
constexpr size_t WS_W1T = 14 * MiB;
constexpr size_t WS_W2T = 16 * MiB;
constexpr size_t WS_B1P = 16 * MiB + 256 * 1024;
constexpr size_t WS_KC = 17 * MiB;
constexpr size_t WS_VC = 18 * MiB;
constexpr size_t WS_XN = 32 * MiB;
constexpr size_t WS_AOUT = 160 * MiB;
constexpr size_t WS_PROJ = 288 * MiB;
constexpr size_t WS_END = 776 * MiB;
constexpr int CW_QCTR = 64;

constexpr int LDS_BYTES = 163840;
constexpr int L_IB = 81920, L_LB = L_IB + 33792, L_WSF = L_LB + 1024, L_ZT = L_WSF + 2048, L_MISC = 163328;
static_assert(L_ZT + 32768 <= L_MISC && L_MISC + 256 <= LDS_BYTES, "LDS map");

struct Args { const float* in[17]; float* out; unsigned char* ws; int ph_lo, ph_hi; };

#define LOG2E_F 1.4426950408889634f
#define LDS_FENCE() do { asm volatile("s_waitcnt lgkmcnt(0)" ::: "memory"); __builtin_amdgcn_wave_barrier(); } while (0)

__device__ __forceinline__ unsigned cvtpk(float lo, float hi) {
    typedef float f2_t __attribute__((ext_vector_type(2))); typedef __bf16 b2_t __attribute__((ext_vector_type(2)));
    f2_t v = {lo, hi}; b2_t b = __builtin_convertvector(v, b2_t); return __builtin_bit_cast(unsigned, b);
}
__device__ __forceinline__ int hy_tid(int wave) { unsigned z; asm volatile("v_mov_b32 %0, 0" : "=v"(z)); return wave * 64 + (int)__builtin_amdgcn_mbcnt_hi(~0u, __builtin_amdgcn_mbcnt_lo(~0u, z)); }
__device__ __forceinline__ float bf2f(unsigned short u) { return __builtin_bit_cast(float, (unsigned)u << 16); }
template <int K> __device__ __forceinline__ float shx(float v) {
    if constexpr (K == 32) {
        const unsigned u = __builtin_bit_cast(unsigned, v); auto rr = __builtin_amdgcn_permlane32_swap(u, u, false, false);
        return __builtin_bit_cast(float, rr[0] ^ rr[1] ^ u);
    } else return __builtin_bit_cast(float, __builtin_amdgcn_ds_swizzle(__builtin_bit_cast(int, v), (K << 10) | 0x1f));
}
template <int CTRL> __device__ __forceinline__ float dppf(float v) { return __builtin_bit_cast(float, __builtin_amdgcn_update_dpp(0, __builtin_bit_cast(int, v), CTRL, 0xf, 0xf, true)); }
__device__ __forceinline__ float red32(float v) {
    v += dppf<0xB1>(v); v += dppf<0x4E>(v); v += dppf<0x141>(v); v += dppf<0x140>(v); v += shx<16>(v);
    return v;
}
__device__ __forceinline__ float wave_sum(float v) {
    v += shx<1>(v); v += shx<2>(v); v += shx<4>(v); v += shx<8>(v); v += shx<16>(v); v += shx<32>(v);
    return v;
}
__device__ __forceinline__ float wave_max(float v) {
    v = fmaxf(v, shx<1>(v)); v = fmaxf(v, shx<2>(v)); v = fmaxf(v, shx<4>(v)); v = fmaxf(v, shx<8>(v)); v = fmaxf(v, shx<16>(v)); v = fmaxf(v, shx<32>(v));
    return v;
}
__device__ __forceinline__ float sigmf(float v) { return __builtin_amdgcn_rcpf(1.0f + __builtin_amdgcn_exp2f(-LOG2E_F * v)); }
__device__ __forceinline__ float siluf(float v) { return v * sigmf(v); }

__device__ __forceinline__ void transpose_item(const float* W, int ldw, int ncols, int n0, int k0, bf16_t* WT, int K, int p0, LAS float* scr, int lane) {
#pragma unroll 8
    for (int i = 0; i < 32; ++i) {
        const int kk = 2 * i + (lane >> 5), nn = lane & 31, n = n0 + nn;
#ifdef HY_T_NOLOAD
        scr[kk * 33 + nn] = (float)n;
#else
        scr[kk * 33 + nn] = (n < ncols) ? W[(size_t)(k0 + kk) * ldw + n] : 0.f;
#endif
    }
    LDS_FENCE();
    const int c = lane & 7;
#pragma unroll
    for (int j = 0; j < 4; ++j) {
        const int n = (lane >> 3) + 8 * j; const LAS float* s = scr + (8 * c) * 33 + n;
        u32x4 o; o.x = cvtpk(s[0 * 33], s[1 * 33]); o.y = cvtpk(s[2 * 33], s[3 * 33]); o.z = cvtpk(s[4 * 33], s[5 * 33]); o.w = cvtpk(s[6 * 33], s[7 * 33]);
#ifdef HY_T_NOSTORE
        if (o.x == 0x12345678u) *(u32x4*)(WT) = o;
#else
        *(u32x4*)(WT + (size_t)(p0 + n) * K + k0 + 8 * c) = o;
#endif
    }
    LDS_FENCE();
}
__device__ __forceinline__ void rms_rows4(const float* x0, const float* g, bf16_t* o0, int lane) {
    const f32x4* gr = (const f32x4*)g + lane;
    f32x4 v[4][4]; float s[4];
#pragma unroll
    for (int q = 0; q < 4; ++q) { const f32x4* xr = (const f32x4*)(x0 + (size_t)q * D) + lane;
#pragma unroll
        for (int j = 0; j < 4; ++j) v[q][j] = xr[64 * j]; }
#pragma unroll
    for (int q = 0; q < 4; ++q) { float a = 0.f;
#pragma unroll
        for (int j = 0; j < 4; ++j) a += (v[q][j].x * v[q][j].x + v[q][j].y * v[q][j].y) + (v[q][j].z * v[q][j].z + v[q][j].w * v[q][j].w);
        s[q] = a; }
#pragma unroll
    for (int q = 0; q < 4; ++q) s[q] = wave_sum(s[q]);
    f32x4 gj[4];
#pragma unroll
    for (int j = 0; j < 4; ++j) gj[j] = gr[64 * j];
#pragma unroll
    for (int q = 0; q < 4; ++q) { const float r = 1.0f / sqrtf(s[q] * (1.f / D) + EPS); u32x2* o8 = (u32x2*)(o0 + (size_t)q * D) + lane;
#pragma unroll
        for (int j = 0; j < 4; ++j) { const f32x4 y = (v[q][j] * r) * gj[j]; u32x2 w; w.x = cvtpk(y.x, y.y); w.y = cvtpk(y.z, y.w); o8[64 * j] = w; } }
}
__device__ __forceinline__ void p0_prologue(const Args& A, ldsp lds, int vcu, int G, int wave, int lane) {
    LAS float* scr = (LAS float*)(lds + wave * 16384);
    unsigned char* ws = A.ws;
    const int gw = vcu * 8 + wave, NGW = G * 8;
    constexpr int I_WIN = (NPAD / 32) * (D / 64), I_WOUT = (D / 32) * (D / 64), I_W1 = (256 / 32) * (2048 / 64), I_W2 = (64 / 32) * (256 / 64), I_B1 = 2 * 4 * 8;
    constexpr int NITEMS = I_WIN + I_WOUT + 2 * I_W1 + 2 * I_W2 + I_B1;
#ifndef HY_P0_SKIP_T
#ifndef HY_IT_LO
#define HY_IT_LO 0
#define HY_IT_HI NITEMS
#endif
    for (int it = gw; it < NITEMS; it += NGW) {
        int r = it;
        if (it < (HY_IT_LO) || it >= (HY_IT_HI)) continue;
#ifdef HY_WAVE_LT
        if (wave >= (HY_WAVE_LT)) continue;
#endif
        if (r < I_WIN) { const int nb = r / (D / 64), kb = r % (D / 64), p0 = 32 * nb;
            const int n0 = 256 * (p0 >> 8) + 64 * ((p0 >> 5) & 3) + 32 * ((p0 >> 7) & 1);
            transpose_item(A.in[2], NIN, NIN, n0, 64 * kb, (bf16_t*)(ws + WS_WIN), D, p0, scr, lane); continue; }
        r -= I_WIN;
        if (r < I_WOUT) { const int nb = r / (D / 64), kb = r % (D / 64); transpose_item(A.in[16], D, D, 32 * nb, 64 * kb, (bf16_t*)(ws + WS_WOUT), D, 32 * nb, scr, lane); continue; }
        r -= I_WOUT;
        if (r < 2 * I_W1) { const int wh = r / I_W1, q = r % I_W1, nb = q / 32, kb = q % 32;
            transpose_item(A.in[13] + (size_t)wh * 2048 * 256, 256, 256, 32 * nb, 64 * kb, (bf16_t*)(ws + WS_W1T) + (size_t)wh * 256 * 2048, 2048, 32 * nb, scr, lane); continue; }
        r -= 2 * I_W1;
        if (r < 2 * I_W2) { const int wh = r / I_W2, q = r % I_W2, nb = q / 4, kb = q % 4;
            transpose_item(A.in[15] + (size_t)wh * 256 * 64, 64, 64, 32 * nb, 64 * kb, (bf16_t*)(ws + WS_W2T) + (size_t)wh * 64 * 256, 256, 32 * nb, scr, lane); continue; }
        r -= 2 * I_W2;
        {
            const int wh = r >> 5, ng = (r >> 3) & 3, ksl = r & 7;
            const float* pos = A.in[12] + (size_t)wh * 2048 + ksl * 256; const float* w1 = A.in[13] + (size_t)wh * 2048 * 256 + (size_t)(ksl * 256) * 256 + ng * 64 + lane;
            float acc = 0.f;
#pragma unroll 8
            for (int k = 0; k < 256; ++k) acc = fmaf(pos[k], w1[(size_t)k * 256], acc);
            ((float*)(ws + WS_B1P))[(wh * 8 + ksl) * 256 + ng * 64 + lane] = acc;
        }
    }
#endif
#ifndef HY_P0_SKIP_R
    for (int m = 4 * gw; m < M; m += 4 * NGW) rms_rows4(A.in[0] + (size_t)m * D, A.in[1], (bf16_t*)(ws + WS_XN) + (size_t)m * D, lane);
#endif
}

struct EpiIn {
    static constexpr bool PERM = true, AFTER_DRAIN = false;
    bf16_t* P; const float* gq_d; const float* gk_d; const float* gq_n; const float* gk_n3;
    __device__ __forceinline__ void operator()(const f32x4 (&acc)[2][2][4][2], const pg8::Unit& u, int wr, int wc, int fr, int fq) const {
        const int G = u.pn * 4 + wc;
        if (G > 60) return;
        int kind = 0; const float* g = nullptr; float post = 1.f;
        if (G < 8) { kind = 1; g = gq_d; post = QSCALE; }
        else if (G < 16) { kind = 1; g = gk_d; }
        else if (G < 24) { kind = 0; }
        else if (G < 32) { kind = 2; }
        else if (G < 40) { kind = 1; g = gq_n; post = QSCALE; }
        else if (G < 52) { const int wh = (G - 40) >> 1; if (wh == 2) { kind = 1; g = gk_n3 + 64; } else if (wh == 4) { kind = 1; g = gk_n3 + 128; } }
        else if (G < 60) { kind = 2; }
        else { kind = 3; }
        f32x4 gv[2][2];
#pragma unroll
        for (int bj = 0; bj < 2; ++bj)
#pragma unroll
            for (int n = 0; n < 2; ++n) gv[bj][n] = (kind == 1) ? (*(const f32x4*)(g + 32 * bj + 8 * fq + 4 * n)) * post : (f32x4){1.f, 1.f, 1.f, 1.f};
        bf16_t* base = P + (size_t)(u.pm * 256 + wr * 64 + fr) * LDP + G * 64 + 8 * fq;
#pragma unroll
        for (int ai = 0; ai < 2; ++ai)
#pragma unroll
            for (int m = 0; m < 4; ++m) {
                f32x4 v[2][2];
#pragma unroll
                for (int bj = 0; bj < 2; ++bj)
#pragma unroll
                    for (int n = 0; n < 2; ++n) v[bj][n] = acc[ai][bj][m][n];
                if (kind == 1) {
                    float ss = 0.f;
#pragma unroll
                    for (int bj = 0; bj < 2; ++bj)
#pragma unroll
                        for (int n = 0; n < 2; ++n) { const f32x4 x = v[bj][n]; ss += (x[0] * x[0] + x[1] * x[1]) + (x[2] * x[2] + x[3] * x[3]); }
                    ss += shx<16>(ss); ss += shx<32>(ss);
                    const float r = __builtin_amdgcn_rsqf(ss * (1.f / 64.f) + EPS);
#pragma unroll
                    for (int bj = 0; bj < 2; ++bj)
#pragma unroll
                        for (int n = 0; n < 2; ++n) v[bj][n] = (v[bj][n] * r) * gv[bj][n];
                } else if (kind == 2) {
#pragma unroll
                    for (int bj = 0; bj < 2; ++bj)
#pragma unroll
                        for (int n = 0; n < 2; ++n)
#pragma unroll
                            for (int e = 0; e < 4; ++e) v[bj][n][e] = siluf(v[bj][n][e]);
                } else if (kind == 3) {
#pragma unroll
                    for (int bj = 0; bj < 2; ++bj)
#pragma unroll
                        for (int n = 0; n < 2; ++n)
#pragma unroll
                            for (int e = 0; e < 4; ++e) v[bj][n][e] = sigmf(v[bj][n][e]);
                }
                bf16_t* rowp = base + (size_t)(ai * 128 + m * 16) * LDP;
#pragma unroll
                for (int bj = 0; bj < 2; ++bj) {
                    u32x4 w; w.x = cvtpk(v[bj][0][0], v[bj][0][1]); w.y = cvtpk(v[bj][0][2], v[bj][0][3]); w.z = cvtpk(v[bj][1][0], v[bj][1][1]); w.w = cvtpk(v[bj][1][2], v[bj][1][3]);
                    *(u32x4*)(rowp + 32 * bj) = w;
                }
            }
    }
};
struct EpiOut {
    static constexpr bool PERM = false, AFTER_DRAIN = false;
    const float* x; float* out;
    __device__ __forceinline__ void operator()(const f32x4 (&acc)[2][2][4][2], const pg8::Unit& u, int wr, int wc, int fr, int fq) const {
        const int col0 = u.pn * 256 + wc * 32 + 4 * fq;
#pragma unroll
        for (int ai = 0; ai < 2; ++ai) {
            f32x4 xv[4][2][2];
#pragma unroll
            for (int m = 0; m < 4; ++m) {
                const size_t off = (size_t)(u.pm * 256 + ai * 128 + wr * 64 + m * 16 + fr) * D + col0;
#pragma unroll
                for (int bj = 0; bj < 2; ++bj)
#pragma unroll
                    for (int n = 0; n < 2; ++n) xv[m][bj][n] = *(const f32x4*)(x + off + bj * 128 + n * 16);
            }
#pragma unroll
            for (int m = 0; m < 4; ++m) {
                const size_t off = (size_t)(u.pm * 256 + ai * 128 + wr * 64 + m * 16 + fr) * D + col0;
#pragma unroll
                for (int bj = 0; bj < 2; ++bj)
#pragma unroll
                    for (int n = 0; n < 2; ++n) *(f32x4*)(out + off + bj * 128 + n * 16) = xv[m][bj][n] + acc[ai][bj][m][n];
            }
        }
    }
};

__device__ __forceinline__ void compress_phase(const Args& A, ldsp lds, int wave, int lane) {
    unsigned char* ws = A.ws;
    const bf16_t* PROJ = (const bf16_t*)(ws + WS_PROJ);
    const int tid = wave * 64 + lane, fr = lane & 15, kq = lane >> 4, rg4 = wave & 3, ch = wave >> 2;
    constexpr int BROW = 144, BSLOT = 256 * BROW, HB_OFF = 2 * BSLOT;
    LAS bf16_t* hbuf = (LAS bf16_t*)(lds + HB_OFF);
    for (int uidx = blockIdx.x; uidx < 256; uidx += gridDim.x) {
        const int wh = uidx & 1, kvh = (uidx >> 1) & 1, rh = (uidx >> 2) & 1, b = uidx >> 3;
        const bf16_t* src = PROJ + (size_t)(b * T) * LDP + C_NKV + wh * 128 + kvh * 64;
        const bf16_t* w1t = (const bf16_t*)(ws + WS_W1T) + (size_t)wh * 256 * 2048;
        const bf16_t* w2t = (const bf16_t*)(ws + WS_W2T) + (size_t)wh * 64 * 256;
        const float* b1 = A.in[14] + wh * 256; const float* b1p = (const float*)(ws + WS_B1P) + wh * 8 * 256;
        const int i = rh * 64 + rg4 * 16 + fr;
        const bf16_t* bsrc = w1t + (size_t)(tid >> 1) * 2048 + (tid & 1) * 32;
        const int bdst = (tid >> 1) * BROW + (tid & 1) * 64;
        int tok0 = 16 * i; tok0 = tok0 < T - 31 ? tok0 : T - 32;
        const bf16_t* asrc = src + (size_t)tok0 * LDP + 8 * kq;
        f32x4 acc[8];
#pragma unroll
        for (int nt = 0; nt < 8; ++nt) acc[nt] = (f32x4){0.f, 0.f, 0.f, 0.f};
        u32x4 rb[4]; bf16x8 a[2], an[2];
#pragma unroll
        for (int q = 0; q < 4; ++q) rb[q] = *(const u32x4*)(bsrc + q * 8);
        a[0] = *(const bf16x8*)(asrc); a[1] = *(const bf16x8*)(asrc + 32);
#pragma unroll
        for (int q = 0; q < 4; ++q) *(LAS u32x4*)(lds + bdst + q * 16) = rb[q];
        __syncthreads();
#pragma unroll 1
        for (int ks = 0; ks < 32; ++ks) {
            const int cur = (ks & 1) * BSLOT, nxt = BSLOT - cur;
            if (ks + 1 < 32) {
#pragma unroll
                for (int q = 0; q < 4; ++q) rb[q] = *(const u32x4*)(bsrc + (ks + 1) * 64 + q * 8);
                an[0] = *(const bf16x8*)(asrc + (size_t)(ks + 1) * LDP); an[1] = *(const bf16x8*)(asrc + (size_t)(ks + 1) * LDP + 32);
            }
            const LAS unsigned char* bp = lds + cur + (ch * 128 + fr) * BROW + kq * 16;
#pragma unroll
            for (int sb = 0; sb < 2; ++sb)
#pragma unroll
                for (int nt = 0; nt < 8; ++nt) {
                    const bf16x8 bb = *(const LAS bf16x8*)(bp + nt * 16 * BROW + sb * 64);
                    acc[nt] = __builtin_amdgcn_mfma_f32_16x16x32_bf16(a[sb], bb, acc[nt], 0, 0, 0);
                }
            if (ks + 1 < 32) {
#pragma unroll
                for (int q = 0; q < 4; ++q) *(LAS u32x4*)(lds + nxt + bdst + q * 16) = rb[q];
                a[0] = an[0]; a[1] = an[1];
            }
            __syncthreads();
        }
#pragma unroll
        for (int nt = 0; nt < 8; ++nt) {
            const int col = ch * 128 + 16 * nt + fr; float bias = b1[col];
#pragma unroll
            for (int sl = 0; sl < 8; ++sl) bias += b1p[sl * 256 + col];
#pragma unroll
            for (int rg = 0; rg < 4; ++rg) { const float hv = siluf(acc[nt][rg] + bias); hbuf[(rg4 * 16 + 4 * kq + rg) * 264 + col] = (bf16_t)(cvtpk(hv, hv) & 0xffffu); }
        }
        __syncthreads();
        if (ch == 0) {
            f32x4 acc2[4];
#pragma unroll
            for (int nt = 0; nt < 4; ++nt) acc2[nt] = (f32x4){0.f, 0.f, 0.f, 0.f};
#pragma unroll
            for (int ks = 0; ks < 8; ++ks) {
                const bf16x8 av = *(const LAS bf16x8*)(hbuf + (rg4 * 16 + fr) * 264 + 32 * ks + 8 * kq);
#pragma unroll
                for (int nt = 0; nt < 4; ++nt) {
                    const bf16x8 bb = *(const bf16x8*)(w2t + (size_t)(nt * 16 + fr) * 256 + 32 * ks + 8 * kq);
                    acc2[nt] = __builtin_amdgcn_mfma_f32_16x16x32_bf16(av, bb, acc2[nt], 0, 0, 0);
                }
            }
            bf16_t* dst = (bf16_t*)(ws + (wh == 0 ? WS_KC : WS_VC)) + (size_t)((b * 2 + kvh) * 128) * 64;
            const float* gk = A.in[11];
#pragma unroll
            for (int rg = 0; rg < 4; ++rg) {
                const int io = rh * 64 + rg4 * 16 + 4 * kq + rg;
                float v[4];
#pragma unroll
                for (int nt = 0; nt < 4; ++nt) v[nt] = acc2[nt][rg];
                if (wh == 0) {
                    float ss = (v[0] * v[0] + v[1] * v[1]) + (v[2] * v[2] + v[3] * v[3]);
                    ss += shx<1>(ss); ss += shx<2>(ss); ss += shx<4>(ss); ss += shx<8>(ss);
                    const float r = 1.0f / sqrtf(ss * (1.f / 64.f) + EPS);
#pragma unroll
                    for (int nt = 0; nt < 4; ++nt) v[nt] = (v[nt] * r) * gk[16 * nt + fr];
                }
#pragma unroll
                for (int nt = 0; nt < 4; ++nt) { const float ov = (io < 127) ? v[nt] : 0.f; dst[(size_t)io * 64 + 16 * nt + fr] = (bf16_t)(cvtpk(ov, ov) & 0xffffu); }
            }
        }
        __syncthreads();
    }
}

__device__ __forceinline__ int crow(int r, int hi) { return (r & 3) + 8 * (r >> 2) + 4 * hi; }
typedef short v4i16_t __attribute__((ext_vector_type(4)));
typedef LAS const unsigned char* lcp;
__device__ __forceinline__ s16x4 vtr(lcp p) { return __builtin_bit_cast(s16x4, __builtin_amdgcn_ds_read_tr16_b64_v4i16((LAS v4i16_t*)p)); }
#define SBAR() __builtin_amdgcn_sched_barrier(0)
#define WAIT_BAR(N) asm volatile("s_waitcnt vmcnt(" #N ") lgkmcnt(0)\n\ts_barrier" ::: "memory")
__device__ __forceinline__ void glds16(const void* gsrc, unsigned lds_dst) {
    unsigned keep;
    asm volatile("s_mov_b32 %0, m0\n\ts_mov_b32 m0, %2\n\ts_nop 0\n\tglobal_load_lds_dwordx4 %1, off\n\ts_mov_b32 m0, %0" : "=&s"(keep) : "v"(gsrc), "s"(lds_dst) : "memory");
}
__device__ __forceinline__ void glds16s(unsigned voff, const void* sbase, unsigned lds_dst) {
    unsigned keep;
    asm volatile("s_mov_b32 %0, m0\n\ts_mov_b32 m0, %3\n\ts_nop 0\n\tglobal_load_lds_dwordx4 %1, %2\n\ts_mov_b32 m0, %0" : "=&s"(keep) : "v"(voff), "s"(sbase), "s"(lds_dst) : "memory");
}
constexpr int N_VR = 24576;
constexpr int N_CMP = 49152;
constexpr int D_VR = 49152;

__device__ __forceinline__ lcp lxor(lcp p, unsigned x) { return (lcp)(uintptr_t)((unsigned)(uintptr_t)p ^ x); }
template <int KH = 0>
__device__ __forceinline__ void qk_simple(f32x16& p0, f32x16& p1, lcp kp, const bf16x8 (&qr)[4], float c0) {
#pragma unroll
    for (int r = 0; r < 16; ++r) { p0[r] = c0; p1[r] = c0; }
#pragma unroll
    for (int d0 = 0; d0 < 4; ++d0) {
        const bf16x8 b0 = *(const LAS bf16x8*)(KH ? lxor(kp, d0 << 5) : kp + d0 * 2048);
        const bf16x8 b1 = *(const LAS bf16x8*)(KH ? lxor(kp, d0 << 5) + KH : kp + d0 * 2048 + 512);
        p0 = __builtin_amdgcn_mfma_f32_32x32x16_bf16(b0, qr[d0], p0, 0, 0, 0);
        p1 = __builtin_amdgcn_mfma_f32_32x32x16_bf16(b1, qr[d0], p1, 0, 0, 0);
    }
}
__device__ __forceinline__ void mask_neg(f32x16& p0, f32x16& p1, int kbase, int kmin, int kmax) {
#pragma unroll
    for (int r = 0; r < 16; ++r) {
        const int kv = kbase + (r & 3) + 8 * (r >> 2);
        if (kv < kmin || kv > kmax) p0[r] = -INFINITY;
        if (kv + 32 < kmin || kv + 32 > kmax) p1[r] = -INFINITY;
    }
}
__device__ __forceinline__ void mask_hi(f32x16& p0, f32x16& p1, int kbase, int kmax) {
#pragma unroll
    for (int r = 0; r < 16; ++r) {
        const int kv = kbase + (r & 3) + 8 * (r >> 2);
        if (kv > kmax) p0[r] = -INFINITY;
        if (kv + 32 > kmax) p1[r] = -INFINITY;
    }
}
template <bool ALIBI>
__device__ __forceinline__ void exp_all(f32x16& p0, f32x16& p1, float slope2) {
#pragma unroll
    for (int r = 0; r < 16; ++r) {
        const float cr = (float)((r & 3) + 8 * (r >> 2));
        if (ALIBI) { p0[r] = __builtin_amdgcn_exp2f(fmaf(slope2, cr, p0[r])); p1[r] = __builtin_amdgcn_exp2f(fmaf(slope2, cr + 32.f, p1[r])); }
        else { p0[r] = __builtin_amdgcn_exp2f(p0[r]); p1[r] = __builtin_amdgcn_exp2f(p1[r]); }
    }
}
__device__ __forceinline__ float rowsum(const f32x16& p0, const f32x16& p1) {
    float s = 0.f;
#pragma unroll
    for (int r = 0; r < 16; ++r) s += p0[r] + p1[r];
    return s;
}
__device__ __forceinline__ void pack_p(bf16x8 (&pa)[4], const f32x16& p0, const f32x16& p1) {
    u32x4 w;
    w.x = cvtpk(p0[0], p0[1]); w.y = cvtpk(p0[2], p0[3]); w.z = cvtpk(p0[4], p0[5]); w.w = cvtpk(p0[6], p0[7]); pa[0] = __builtin_bit_cast(bf16x8, w);
    w.x = cvtpk(p0[8], p0[9]); w.y = cvtpk(p0[10], p0[11]); w.z = cvtpk(p0[12], p0[13]); w.w = cvtpk(p0[14], p0[15]); pa[1] = __builtin_bit_cast(bf16x8, w);
    w.x = cvtpk(p1[0], p1[1]); w.y = cvtpk(p1[2], p1[3]); w.z = cvtpk(p1[4], p1[5]); w.w = cvtpk(p1[6], p1[7]); pa[2] = __builtin_bit_cast(bf16x8, w);
    w.x = cvtpk(p1[8], p1[9]); w.y = cvtpk(p1[10], p1[11]); w.z = cvtpk(p1[12], p1[13]); w.w = cvtpk(p1[14], p1[15]); pa[3] = __builtin_bit_cast(bf16x8, w);
}
template <int NDV, int VH = 0>
__device__ __forceinline__ void pv_simple(f32x16 (&o)[NDV], const f32x16& p0, const f32x16& p1, lcp vp) {
    bf16x8 pa[4]; pack_p(pa, p0, p1);
#pragma unroll
    for (int d0 = 0; d0 < NDV; ++d0)
#pragma unroll
        for (int ks = 0; ks < 4; ++ks) {
            const lcp a_ = VH ? lxor(vp, d0 << 6) + ks * (2 * VH) : vp + d0 * 4096 + ks * 1024;
            const s16x4 lo = vtr(a_), hh = vtr(a_ + (VH ? VH : 512));
            const bf16x8 vb = (bf16x8){lo[0], lo[1], lo[2], lo[3], hh[0], hh[1], hh[2], hh[3]};
            o[d0] = __builtin_amdgcn_mfma_f32_32x32x16_bf16(pa[ks], vb, o[d0], 0, 0, 0);
        }
}

struct AttnCtx {
    const bf16_t* PROJ; const bf16_t* KC; const bf16_t* VC; bf16_t* AOUT;
    const float* gsub;
    float lam;
    float M2d, M2c, M2s, M2w;
};

#ifdef HY_TSEL
#define TMARK(var) const unsigned var = (unsigned)__builtin_amdgcn_s_memrealtime()
#define TACC(slot, t1, t0) do { if (wid == 0 && (tid & 63) == 0) ((volatile LAS unsigned*)(lds + L_MISC + 128))[slot] += (t1) - (t0); } while (0)
#else
#define TMARK(var) do { } while (0)
#define TACC(slot, t1, t0) do { } while (0)
#endif
#define PKW(P, B) cvtpk(P[B], P[(B) + 1])
#define PAF(k) __builtin_bit_cast(bf16x8, pw##k)
#define PIN(x) asm volatile("" : "+v"(x))
#define MF32(a, b, c) __builtin_amdgcn_mfma_f32_32x32x16_bf16(a, b, c, 0, 0, 0)
#define VJ(buf, dblk, ks) do { const lcp a_ = VADDR(dblk, ks); vl##buf = vtr(a_); vh##buf = vtr(a_ + VHB); } while (0)
#define VADDR(dblk, ks) (lxor(vp_, (dblk) << 6) + (ks) * (2 * VHB))
#define KADDR(j) lxor(kp0 + sl_next, (j) << 5)
#define VF(buf) (bf16x8){vl##buf[0], vl##buf[1], vl##buf[2], vl##buf[3], vh##buf[0], vh##buf[1], vh##buf[2], vh##buf[3]}
#define KRD(j) do { const lcp a_ = KADDR(j); kf[2 * (j)] = *(const LAS bf16x8*)a_; kf[2 * (j) + 1] = *(const LAS bf16x8*)(a_ + KHB); SBAR(); } while (0)
#define GAPA(MF, A0, A1, A2, A3, W0, W1, PW) do { MF; sacc += A0; sacc += A1; sacc += A2; sacc += A3; PIN(sacc); W0; W1; PIN(PW); SBAR(); } while (0)
#define EX1(X, r) X[r] = __builtin_amdgcn_exp2f(X[r])
#define GAPB4(MF, X, B) do { MF; EX1(X, B); EX1(X, (B) + 1); EX1(X, (B) + 2); EX1(X, (B) + 3); PIN(X); SBAR(); } while (0)
#define GAPB2(MF, X, B) do { MF; EX1(X, B); EX1(X, (B) + 1); PIN(X); SBAR(); } while (0)
__device__ __forceinline__ unsigned split2(float x) { const unsigned h = cvtpk(x, 0.f) & 0xffffu; const float hf = __builtin_bit_cast(float, h << 16); return h | (cvtpk(0.f, x - hf) & 0xffff0000u); }
__device__ __forceinline__ unsigned dup_bf16_exact(float x) { const unsigned h = __builtin_bit_cast(unsigned, x) >> 16; return h | (h << 16); }
#define GAPA2(MF, A0, A1, W0, W1, PW) do { MF; sacc += A0; sacc += A1; PIN(sacc); W0; W1; PIN(PW); SBAR(); } while (0)
#define PHASE_A(C0_, C1_, P0_, P1_) do { \
    float sacc = (P0_[0] + P0_[1]); \
    GAPA(C0_ = MF32(__builtin_bit_cast(bf16x8, xa0), __builtin_bit_cast(bf16x8, xb), z16), P0_[2], P0_[3], P0_[4], P0_[5], pw0[0] = PKW(P0_, 0),  pw0[1] = PKW(P0_, 2),  pw0); \
    GAPA(C1_ = MF32(__builtin_bit_cast(bf16x8, xa1), __builtin_bit_cast(bf16x8, xb), z16), P0_[6], P0_[7], P0_[8], P0_[9], pw0[2] = PKW(P0_, 4),  pw0[3] = PKW(P0_, 6),  pw0); \
    GAPA(C0_ = MF32(kf[0], qr[0], C0_), P0_[10], P0_[11], P0_[12], P0_[13], pw1[0] = PKW(P0_, 8),  pw1[1] = PKW(P0_, 10), pw1); \
    GAPA(C1_ = MF32(kf[1], qr[0], C1_), P0_[14], P0_[15], P1_[0], P1_[1],   pw1[2] = PKW(P0_, 12), pw1[3] = PKW(P0_, 14), pw1); \
    GAPA(C0_ = MF32(kf[2], qr[1], C0_), P1_[2], P1_[3], P1_[4], P1_[5],     pw2[0] = PKW(P1_, 0),  pw2[1] = PKW(P1_, 2),  pw2); \
    GAPA(C1_ = MF32(kf[3], qr[1], C1_), P1_[6], P1_[7], P1_[8], P1_[9],     pw2[2] = PKW(P1_, 4),  pw2[3] = PKW(P1_, 6),  pw2); \
    GAPA(C0_ = MF32(kf[4], qr[2], C0_), P1_[10], P1_[11], P1_[12], P1_[13], pw3[0] = PKW(P1_, 8),  pw3[1] = PKW(P1_, 10), pw3); \
    GAPA2(C1_ = MF32(kf[5], qr[2], C1_), P1_[14], P1_[15],                  pw3[2] = PKW(P1_, 12), pw3[3] = PKW(P1_, 14), pw3); \
    C0_ = MF32(kf[6], qr[3], C0_); VJ(0, 0, 0); SBAR(); \
    C1_ = MF32(kf[7], qr[3], C1_); VJ(1, 1, 0); SBAR(); \
    l_reg += sacc; } while (0)

template <int PRB>
__device__ __forceinline__ void diff_unit(const AttnCtx& C0, int b, int h, int qb, ldsp lds, const int wid) {
    constexpr int probe = PRB;
    AttnCtx C = C0; if (probe) C.AOUT = (bf16_t*)((unsigned char*)C.AOUT - (WS_AOUT - WS_XN));
    { volatile LAS float* sc = (volatile LAS float*)(lds + L_MISC); C.lam = sc[4]; C.M2d = sc[5]; }
    int tid = hy_tid(wid); asm volatile("" : "+v"(tid));
    const int lane = tid & 63, r32 = lane & 31, hi = lane >> 5;
    TMARK(tm_a);
    const int cm = wid >> 2, wq = wid & 3;
    const int q0 = qb * 128, qlo = q0 + wq * 32, qpos = qlo + r32;
    const bf16_t* Pb = C.PROJ + (size_t)b * T * LDP;
    const unsigned lds0 = (unsigned)(uintptr_t)lds;
    constexpr int SLOTB = 16384;
    const float slope2 = ldexpf(1.0f, -2 * (h + 1)) * LOG2E;
    int t0 = (int)floorf(((float)(q0 - 63) - 126.0f / slope2) * (1.0f / 64.0f)) + 1; t0 = t0 < 0 ? 0 : (t0 & ~1);
    t0 = __builtin_amdgcn_readfirstlane(t0);
    const int NT = (probe & 32) ? 2 : 2 * (qb + 1) - t0;
    constexpr int KHB = 8192, VHB = 2048;
    const bf16_t* kdma = Pb + (size_t)(4 * wid) * LDP + C_DK + h * 128;
    const bf16_t* vdma = Pb + (size_t)(4 * wid) * LDP + C_DV + h * 128;
    const unsigned kvo = (unsigned)((lane >> 4) * LDP + ((lane & 15) ^ (((lane >> 4) << 2) | (wid & 3))) * 8) * 2u;
    const unsigned vvo = (unsigned)((lane >> 4) * LDP + ((lane & 15) ^ ((lane >> 4) << 2)) * 8) * 2u;
#define DTOFF(i) ((size_t)(t0 + ((i) < NT ? (i) : NT - 1)) * (64 * LDP))
#define DMA_K(i, so) do { if (probe & 1) break; const bf16_t* s_ = kdma + DTOFF(i); const unsigned d_ = (unsigned)__builtin_amdgcn_readfirstlane((int)(lds0 + (so) + wid * 1024)); glds16s(kvo, s_, d_); glds16s(kvo, s_ + 32 * LDP, d_ + 8192u); } while (0)
#define DMA_V(i, so) do { if (probe & 1) break; const bf16_t* s_ = vdma + DTOFF(i); const unsigned d_ = (unsigned)__builtin_amdgcn_readfirstlane((int)(lds0 + D_VR + (so) + wid * 1024)); glds16s(vvo, s_, d_); glds16s(vvo, s_ + 32 * LDP, d_ + 8192u); } while (0)
#define DMA_P(base, vo, i, so, half) do { if (probe & 1) break; const bf16_t* s_ = (base) + DTOFF(i) + (half) * (32 * LDP); const unsigned d_ = (unsigned)__builtin_amdgcn_readfirstlane((int)(lds0 + (so) + wid * 1024 + (half) * 8192)); glds16s(vo, s_, d_); } while (0)
#define DWB(N) do { if (!(probe & 2)) WAIT_BAR(N); } while (0)
    DMA_K(0, 0); DMA_V(0, 0); DMA_K(1, SLOTB); DMA_K(2, 2 * SLOTB);
    if (cm == 0 && !(probe & 1)) {
        const bf16_t* zs = Pb + (size_t)(qlo + (lane >> 4)) * LDP + C_DZ + h * 128 + (lane & 15) * 8;
        const unsigned zd = (unsigned)__builtin_amdgcn_readfirstlane((int)(lds0 + L_ZT + wq * 8192));
#pragma unroll
        for (int i = 0; i < 8; ++i) glds16(zs + (size_t)(4 * i) * LDP, zd + i * 1024u);
    }
    bf16x8 qr[4];
    { const bf16_t* qp = Pb + (size_t)qpos * LDP + C_DQ + h * 128 + cm * 64 + hi * 8;
#pragma unroll
      for (int d0 = 0; d0 < 4; ++d0) qr[d0] = *(const bf16x8*)(qp + d0 * 16); }
    f32x16 o[4];
#pragma unroll
    for (int d0 = 0; d0 < 4; ++d0)
#pragma unroll
        for (int r = 0; r < 16; ++r) o[d0][r] = 0.f;
    float l_reg = 0.f;
    const lcp kp0 = (lcp)lds + r32 * 256 + (((cm << 3) | hi) ^ (((r32 & 3) << 2) | ((r32 >> 2) & 3))) * 16;
    const lcp vp0 = (lcp)lds + D_VR + (4 * hi + ((lane & 15) >> 2)) * 256 + (((lane & 12) | (((lane >> 4) & 1) << 1) | ((lane >> 1) & 1))) * 16 + (lane & 1) * 8;
    int sl_prev = 0, sl_cur = 0, sl_next = SLOTB;
#define ROT() do { sl_prev = sl_cur; sl_cur = sl_next; sl_next = (sl_next == 2 * SLOTB) ? 0 : sl_next + SLOTB; } while (0)
#define DC0(t) fmaf(slope2, (float)(64 * (t0 + (t)) + 4 * hi - qpos), -C.M2d)
#define DMASK(X0, X1, t) do { if (64 * (t0 + (t)) + 63 > qlo) mask_hi(X0, X1, 64 * (t0 + (t)) + 4 * hi, qpos); } while (0)
    f32x16 pA0, pA1, pB0, pB1; bf16x8 kf[8]; s16x4 vl0, vh0, vl1, vh1, vl2, vh2; u32x4 pw0, pw1, pw2, pw3;
    const unsigned himask = hi ? 0u : 0xffffffffu;
    u32x4 xa0, xa1, xb;
    xa0.x = dup_bf16_exact((float)r32) & himask; xa1.x = dup_bf16_exact((float)(32 + r32)) & himask;
    xa0.y = 0u; xa1.y = 0u; xa0.z = 0x3f803f80u & himask; xa1.z = xa0.z; xa0.w = 0x00003f80u & himask; xa1.w = xa0.w;
    xb.x = split2(slope2) & himask; xb.y = xb.x; xb.z = split2(-slope2 * (float)qpos - C.M2d) & himask; xb.w = 0u;
    f32x16 z16;
#pragma unroll
    for (int r = 0; r < 16; ++r) z16[r] = 0.f;
    DWB(0);
    TMARK(tm_b);
    { qk_simple<KHB>(pA0, pA1, kp0, qr, DC0(0)); DMASK(pA0, pA1, 0); exp_all<true>(pA0, pA1, slope2); }
    DWB(0);
    DMA_K(3, 0); DMA_V(1, SLOTB);
    ROT();
#pragma unroll
    for (int j = 0; j < 4; ++j) { const lcp a_ = lxor(kp0 + sl_cur, j << 5); kf[2 * j] = *(const LAS bf16x8*)a_; kf[2 * j + 1] = *(const LAS bf16x8*)(a_ + KHB); }
    DWB(4);
#ifndef HY_DSPREAD
#define HY_DSPREAD 1
#endif
#if HY_DSPREAD
#define DSPREAD(k, t_, X) do { X; SBAR(); } while (0)
#else
#define DSPREAD(k, t_, X) do { if ((k) == 0) { DMA_K((t_) + 3, sl_cur); DMA_V((t_) + 1, sl_next); } } while (0)
#endif
#define DSTEP(C0_, C1_, P0_, P1_, t) do { SBAR(); \
    const lcp vp_ = vp0 + sl_prev; \
    { const unsigned tb_ = dup_bf16_exact((float)(64 * (t0 + (t)))) & himask; xa0.y = tb_; xa1.y = tb_; } \
    PHASE_A(C0_, C1_, P0_, P1_); \
    DSPREAD(0, t, DMA_P(kdma, kvo, (t) + 3, sl_cur, 0)); \
    DMASK(C0_, C1_, t); \
    SBAR(); \
    GAPB2(o[0] = MF32(PAF(0), VF(0), o[0]); VJ(2, 0, 1), C0_, 0); \
    GAPB2(o[1] = MF32(PAF(0), VF(1), o[1]); VJ(0, 1, 1), C0_, 2); \
    DSPREAD(1, t, DMA_P(vdma, vvo, (t) + 1, D_VR + sl_next, 0)); \
    KRD(0); GAPB2(o[0] = MF32(PAF(1), VF(2), o[0]); VJ(1, 0, 2), C0_, 4); \
    GAPB2(o[1] = MF32(PAF(1), VF(0), o[1]); VJ(2, 1, 2), C0_, 6); \
    DSPREAD(2, t, DMA_P(kdma, kvo, (t) + 3, sl_cur, 1)); \
    KRD(1); GAPB2(o[0] = MF32(PAF(2), VF(1), o[0]); VJ(0, 0, 3), C0_, 8); \
    GAPB2(o[1] = MF32(PAF(2), VF(2), o[1]); VJ(1, 1, 3), C0_, 10); \
    DSPREAD(3, t, DMA_P(vdma, vvo, (t) + 1, D_VR + sl_next, 1)); \
    KRD(2); GAPB2(o[0] = MF32(PAF(3), VF(0), o[0]); VJ(2, 2, 0), C0_, 12); \
    GAPB2(o[1] = MF32(PAF(3), VF(1), o[1]); VJ(0, 3, 0), C0_, 14); \
    KRD(3); GAPB2(o[2] = MF32(PAF(0), VF(2), o[2]); VJ(1, 2, 1), C1_, 0); \
    GAPB2(o[3] = MF32(PAF(0), VF(0), o[3]); VJ(2, 3, 1), C1_, 2); \
    GAPB2(o[2] = MF32(PAF(1), VF(1), o[2]); VJ(0, 2, 2), C1_, 4); \
    GAPB2(o[3] = MF32(PAF(1), VF(2), o[3]); VJ(1, 3, 2), C1_, 6); \
    GAPB2(o[2] = MF32(PAF(2), VF(0), o[2]); VJ(2, 2, 3), C1_, 8); \
    GAPB2(o[3] = MF32(PAF(2), VF(1), o[3]); VJ(0, 3, 3), C1_, 10); \
    GAPB2(o[2] = MF32(PAF(3), VF(2), o[2]), C1_, 12); \
    GAPB2(o[3] = MF32(PAF(3), VF(0), o[3]), C1_, 14); \
    } while (0)
    int t = 1;
    for (; t + 1 < NT; t += 2) {
        DSTEP(pB0, pB1, pA0, pA1, t);     DWB(4); ROT();
        DSTEP(pA0, pA1, pB0, pB1, t + 1); DWB(4); ROT();
    }
    DSTEP(pB0, pB1, pA0, pA1, t); DWB(0); ROT();
    l_reg += rowsum(pB0, pB1);
    pv_simple<4, VHB>(o, pB0, pB1, vp0 + sl_prev);
#undef DSTEP
#undef DSPREAD
#undef DMA_P
#undef DMA_K
#undef DMA_V
#undef DTOFF
#undef DC0
#undef DMASK
    DWB(0);
    TMARK(tm_c);
    l_reg += shx<32>(l_reg);
    LAS float* wsf = (LAS float*)(lds + L_WSF) + wid * 64;
    LAS float* xbuf = (LAS float*)lds + wq * 64 + lane;
    if (cm == 1) {
        if (hi == 0) wsf[r32] = l_reg;
#pragma unroll
        for (int d0 = 0; d0 < 4; ++d0)
#pragma unroll
            for (int r = 0; r < 16; ++r) xbuf[(d0 * 16 + r) * 256] = o[d0][r];
    }
    __syncthreads();
    if (cm == 0) {
        {
            const float l2 = ((const LAS float*)(lds + L_WSF))[(wid + 4) * 64 + r32];
            if (hi == 0) { wsf[r32] = C.lam * l_reg * __builtin_amdgcn_rcpf(l2); wsf[32 + r32] = EPS * l_reg * l_reg; }
            LDS_FENCE();
        }
        float ss[16];
#pragma unroll
        for (int r = 0; r < 16; ++r) ss[r] = 0.f;
#pragma unroll
        for (int r = 0; r < 16; ++r) {
            const float f = wsf[crow(r, hi)];
#pragma unroll
            for (int d0 = 0; d0 < 4; ++d0) { const float v = fmaf(-f, xbuf[(d0 * 16 + r) * 256], o[d0][r]); o[d0][r] = v; ss[r] = fmaf(v, v, ss[r]); }
        }
#pragma unroll
        for (int r = 0; r < 16; ++r) {
            const float s = red32(ss[r]);
            ss[r] = (1.0f - LAM_INIT) * __builtin_amdgcn_rsqf(fmaf(s, 1.f / 128.f, wsf[32 + crow(r, hi)]));
        }
        LAS bf16_t* zt = (LAS bf16_t*)(lds + L_ZT + wq * 8192);
#pragma unroll
        for (int d0 = 0; d0 < 4; ++d0) {
            const float gs = C.gsub[32 * d0 + r32];
#pragma unroll
            for (int r = 0; r < 16; ++r) {
                LAS bf16_t* zp = zt + crow(r, hi) * 128 + 32 * d0 + r32;
                const float v = (o[d0][r] * ss[r]) * gs * bf2f(*zp);
                *zp = (bf16_t)(cvtpk(v, v) & 0xffffu);
            }
        }
        LDS_FENCE();
        {
            bf16_t* orow = C.AOUT + ((size_t)b * T + qlo + (lane >> 4)) * D + h * 128 + (lane & 15) * 8;
#pragma unroll
            for (int j = 0; j < 8; ++j) { const u32x4 w = *(const LAS u32x4*)((lcp)zt + (4 * j + (lane >> 4)) * 256 + (lane & 15) * 16); *(u32x4*)(orow + (size_t)(4 * j) * D) = w; }
        }
    }
    __syncthreads();
    TMARK(tm_d); TACC(0, tm_b, tm_a); TACC(1, tm_c, tm_b); TACC(2, tm_d, tm_c);
#undef DWB
}

__device__ __forceinline__ void nsa_accum(f32x16 (&tot)[2], const f32x16 (&o)[2], float f, LAS float* wsf, int r32, int hi) {
    LDS_FENCE();
    if (hi == 0) wsf[r32] = f;
    LDS_FENCE();
#pragma unroll
    for (int r = 0; r < 16; ++r) { const float fr = wsf[crow(r, hi)]; tot[0][r] += o[0][r] * fr; tot[1][r] += o[1][r] * fr; }
}
__device__ __forceinline__ void nsa_accum_lds(LAS float* tp, const f32x16 (&o)[2], float f, LAS float* wsf, int r32, int hi) {
    LDS_FENCE();
    if (hi == 0) wsf[r32] = f;
    LDS_FENCE();
#pragma unroll
    for (int r = 0; r < 16; ++r) { const float fr = wsf[crow(r, hi)]; tp[r * 512] += o[0][r] * fr; tp[(16 + r) * 512] += o[1][r] * fr; }
}
__device__ __forceinline__ void nsa_unit(const AttnCtx& C0, int b, int kvh, int tb, ldsp lds, const int wid) {
    AttnCtx C = C0; { volatile LAS float* sc = (volatile LAS float*)(lds + L_MISC); C.M2c = sc[6]; C.M2s = sc[7]; C.M2w = sc[8]; }
    int tid = hy_tid(wid); asm volatile("" : "+v"(tid));
    const int lane = tid & 63, r32 = lane & 31, hi = lane >> 5;
    TMARK(tm_a);
    const int g = wid >> 1, half = wid & 1, head = kvh * 4 + g;
    const int tokl = 32 * half + r32, qpos = tb * 64 + tokl;
    const bf16_t* Pb = C.PROJ + (size_t)b * T * LDP;
    const unsigned lds0 = (unsigned)(uintptr_t)lds;
    constexpr int SLOTB = 8192;
    const int j0w = tb >= 8 ? tb - 8 : 0;
    const int NT = (tb + 1) + (tb - j0w + 1);
#ifndef HY_NK_OLD
#define HY_NK_OLD 0
#endif
#ifndef HY_NV_OLD
#define HY_NV_OLD 0
#endif
    constexpr bool NKN = !(HY_NK_OLD), NVN = !(HY_NV_OLD);
    constexpr int KHB = NKN ? 4096 : 512, VHB = NVN ? 1024 : 512;
    const bf16_t* kdma = NKN ? Pb + (size_t)(8 * wid) * LDP + C_NKV + kvh * 64 : Pb + C_NKV + kvh * 64 + wid * 8;
    const bf16_t* vdma = NVN ? Pb + (size_t)(8 * wid) * LDP + C_NKV + kvh * 64 : Pb + (size_t)(16 * (wid & 3)) * LDP + C_NKV + kvh * 64 + (wid >> 2) * 32;
    const unsigned kvo = NKN ? (unsigned)((lane >> 3) * LDP + ((lane & 7) ^ (((lane >> 4) & 3) | (((wid >> 1) & 1) << 2))) * 8) * 2u : (unsigned)lane * (LDP * 2);
    const unsigned vvo = NVN ? (unsigned)((lane >> 3) * LDP + ((lane & 7) ^ (((lane >> 4) & 1) << 2)) * 8) * 2u : (unsigned)((lane >> 2) * LDP + (lane & 3) * 8) * 2u;
#undef VADDR
#undef KADDR
#define VADDR(dblk, ks) (NVN ? lxor(vp_, (dblk) << 6) + (ks) * 2048 : vp_ + ((dblk) * 4096 + (ks) * 1024))
#define KADDR(j) (NKN ? lxor(kp0 + sl_next, (j) << 5) : kp0 + sl_next + (j) * 2048)
#define NTOFF(i) ({ const int i_ = (i) < NT ? (i) : NT - 1; (i_ <= tb) ? (size_t)256 + (size_t)i_ * (64 * LDP) : (size_t)512 + (size_t)(j0w + i_ - tb - 1) * (64 * LDP); })
#define DMA_K(i, so) glds16s(kvo, kdma + NTOFF(i), (unsigned)__builtin_amdgcn_readfirstlane((int)(lds0 + (so) + wid * 1024)))
#define DMA_V(i, so) glds16s(vvo, vdma + NTOFF(i) + 128, (unsigned)__builtin_amdgcn_readfirstlane((int)(lds0 + N_VR + (so) + wid * 1024)))
    DMA_K(0, 0); DMA_V(0, 0); DMA_K(1, SLOTB); DMA_K(2, 2 * SLOTB);
    {
        const bf16_t* kc = C.KC + (size_t)((b * 2 + kvh) * 128) * 64 + (size_t)lane * 64 + wid * 8;
        const bf16_t* vc = C.VC + (size_t)((b * 2 + kvh) * 128) * 64 + (size_t)(16 * (wid & 3) + (lane >> 2)) * 64 + (wid >> 2) * 32 + (lane & 3) * 8;
        const unsigned d_ = (unsigned)__builtin_amdgcn_readfirstlane((int)(lds0 + N_CMP + wid * 1024));
        glds16(kc, d_); glds16(vc, d_ + 8192u); glds16(kc + 64 * 64, d_ + 16384u); glds16(vc + 64 * 64, d_ + 24576u);
    }
    {
        const bf16_t* zs = Pb + (size_t)(tb * 64 + 32 * half + (lane >> 3)) * LDP + C_NZ + head * 64 + (lane & 7) * 8;
        const unsigned zd = (unsigned)__builtin_amdgcn_readfirstlane((int)(lds0 + L_ZT + wid * 4096));
#pragma unroll
        for (int i = 0; i < 4; ++i) glds16(zs + (size_t)(8 * i) * LDP, zd + i * 1024u);
    }
    bf16x8 qr[4];
    { const bf16_t* qp = Pb + (size_t)qpos * LDP + C_NQ + head * 64 + hi * 8;
#pragma unroll
      for (int d0 = 0; d0 < 4; ++d0) qr[d0] = *(const bf16x8*)(qp + d0 * 16); }
    LAS float* wsf = (LAS float*)(lds + L_WSF) + wid * 64;
    const bf16_t* gatep = Pb + (size_t)qpos * LDP + C_NG + head;
    if (hi == 0) wsf[32 + r32] = bf2f(gatep[8]);
    const float slope2 = ldexpf(1.0f, -(head + 1)) * LOG2E;
    const lcp kp0 = NKN ? (lcp)lds + r32 * 128 + (hi ^ (((r32 >> 1) & 3) | (((r32 >> 4) & 1) << 2))) * 16 : (lcp)lds + hi * 1024 + r32 * 16;
    const lcp vp0 = NVN ? (lcp)lds + N_VR + (4 * hi + ((lane & 15) >> 2)) * 128 + ((((lane >> 3) & 1) << 2) | (((lane >> 4) & 1) << 1) | ((lane >> 1) & 1)) * 16 + (lane & 1) * 8
                        : (lcp)lds + N_VR + ((lane >> 4) & 1) * 32 + (lane & 3) * 8 + (4 * hi + ((lane & 15) >> 2)) * 64;
    f32x16 tot[2];
#pragma unroll
    for (int r = 0; r < 16; ++r) { tot[0][r] = 0.f; tot[1][r] = 0.f; }
    unsigned selmask;
    WAIT_BAR(0);
    TMARK(tm_b);
    {
        f32x16 o[2];
#pragma unroll
        for (int r = 0; r < 16; ++r) { o[0][r] = 0.f; o[1][r] = 0.f; }
        const int cmax = (qpos >= 31) ? ((qpos - 31) >> 4) : -1;
        const lcp kpc = (lcp)lds + N_CMP + hi * 1024 + r32 * 16;
        const lcp vpc = (lcp)lds + N_CMP + 8192 + ((lane >> 4) & 1) * 32 + (lane & 3) * 8 + (4 * hi + ((lane & 15) >> 2)) * 64;
        float Gs[16], Ts[16], l = 0.f;
#pragma unroll
        for (int tt = 0; tt < 2; ++tt) {
            f32x16 p0, p1;
            qk_simple(p0, p1, kpc + tt * 16384, qr, -C.M2c);
            mask_hi(p0, p1, 64 * tt + 4 * hi, cmax);
            exp_all<false>(p0, p1, 0.f);
            l += rowsum(p0, p1);
#pragma unroll
            for (int i = 0; i < 4; ++i) {
                Gs[tt * 8 + i] = (p0[4 * i] + p0[4 * i + 1]) + (p0[4 * i + 2] + p0[4 * i + 3]); Ts[tt * 8 + i] = p0[4 * i + 3];
                Gs[tt * 8 + 4 + i] = (p1[4 * i] + p1[4 * i + 1]) + (p1[4 * i + 2] + p1[4 * i + 3]); Ts[tt * 8 + 4 + i] = p1[4 * i + 3];
            }
            pv_simple<2>(o, p0, p1, vpc + tt * 16384);
        }
        l += shx<32>(l);
        const float invl = (l > 0.f) ? 1.0f / l : 0.f;
        LAS float* IB = (LAS float*)(lds + L_IB) + (g * 64 + tokl) * 33;
#pragma unroll
        for (int q = 0; q < 16; ++q) {
            const float recv = shx<32>(Ts[q]);
            if (hi == 1) Gs[q] += recv;
            else if (q + 1 < 16) Gs[q + 1] += recv;
        }
#pragma unroll
        for (int q = 0; q < 16; ++q) IB[2 * q + hi] = Gs[q];
        if (hi == 0) ((LAS float*)(lds + L_LB))[g * 64 + tokl] = invl;
        nsa_accum(tot, o, bf2f(gatep[0]) * invl, wsf, r32, hi);
    }
    WAIT_BAR(0);
    if (tb <= 7) selmask = (2u << tb) - 1u;
    else {
        float imp[32];
        const LAS float* I0 = (const LAS float*)(lds + L_IB) + tokl * 33;
        float il[4];
#pragma unroll
        for (int gg = 0; gg < 4; ++gg) il[gg] = ((const LAS float*)(lds + L_LB))[gg * 64 + tokl];
#pragma unroll
        for (int s = 0; s < 32; ++s) {
            float a = 0.f;
#pragma unroll
            for (int gg = 0; gg < 4; ++gg) a = fmaf(I0[gg * 64 * 33 + s], il[gg], a);
            imp[s] = a;
        }
        unsigned sel = 0u;
#pragma unroll 1
        for (int it = 0; it < 5; ++it) {
            float bv = -1.0f; int best = 0;
#pragma unroll
            for (int s = 1; s < 30; ++s) { const bool ok = (s <= tb - 2) && (((sel >> s) & 1u) == 0u) && (imp[s] > bv); if (ok) { bv = imp[s]; best = s; } }
            sel |= 1u << best;
        }
        selmask = (sel & ~1u) | 1u | (1u << (tb - 1)) | (1u << tb);
    }
    TMARK(tm_c);
    f32x16 o[2];
#pragma unroll
    for (int r = 0; r < 16; ++r) { o[0][r] = 0.f; o[1][r] = 0.f; }
    float l_reg = 0.f;
    int sl_prev = 0, sl_cur = 0, sl_next = SLOTB;
#define NJ(i) (((i) <= tb) ? (i) : j0w + (i) - tb - 1)
#define NC0(i) ({ const int j_ = NJ(i); float c_ = fmaf(slope2, (float)(64 * j_ + 4 * hi - qpos), ((i) <= tb) ? -C.M2s : -C.M2w); if ((i) <= tb && ((selmask >> j_) & 1u) == 0u) c_ = -INFINITY; c_; })
#define NMASK(X0, X1, i) do { const int j_ = NJ(i); if (j_ == tb) mask_hi(X0, X1, 64 * j_ + 4 * hi, qpos); else if ((i) > tb && j_ == tb - 8) mask_neg(X0, X1, 64 * j_ + 4 * hi, qpos - 511, qpos); } while (0)
    const int qw0 = tb * 64 + 32 * half;
    const int dthr = __builtin_amdgcn_readfirstlane((int)(126.0f / slope2) + 1);
#ifndef HY_NSA_LIGHT
#define HY_NSA_LIGHT 0
#endif
#define NDEAD(i) ((i) >= 0 && qw0 - 64 * NJ(i) - 63 > dthr)
    f32x16 pA0, pA1, pB0, pB1; bf16x8 kf[8]; s16x4 vl0, vh0, vl1, vh1, vl2, vh2; u32x4 pw0, pw1, pw2, pw3;
    const unsigned himask = hi ? 0u : 0xffffffffu;
    u32x4 xa0, xa1, xb;
    xa0.x = dup_bf16_exact((float)r32) & himask; xa1.x = dup_bf16_exact((float)(32 + r32)) & himask;
    xa0.y = 0u; xa1.y = 0u; xa0.z = 0x3f803f80u & himask; xa1.z = xa0.z; xa0.w = 0x00003f80u & himask; xa1.w = xa0.w;
    xb.x = split2(slope2) & himask; xb.y = xb.x; xb.z = split2(-slope2 * (float)qpos - C.M2s) & himask; xb.w = 0u;
    f32x16 z16;
#pragma unroll
    for (int r = 0; r < 16; ++r) z16[r] = 0.f;
    { qk_simple<NKN ? 4096 : 0>(pA0, pA1, kp0, qr, NC0(0)); NMASK(pA0, pA1, 0); exp_all<true>(pA0, pA1, slope2); }
    WAIT_BAR(0);
    DMA_K(3, 0); DMA_V(1, SLOTB);
    LAS float* tp = (LAS float*)(lds + N_CMP) + tid;
#pragma unroll
    for (int r = 0; r < 16; ++r) { tp[r * 512] = tot[0][r]; tp[(16 + r) * 512] = tot[1][r]; }
    ROT();
#pragma unroll
    for (int j = 0; j < 4; ++j) { const lcp a_ = NKN ? lxor(kp0 + sl_cur, j << 5) : kp0 + sl_cur + j * 2048; kf[2 * j] = *(const LAS bf16x8*)a_; kf[2 * j + 1] = *(const LAS bf16x8*)(a_ + KHB); }
    WAIT_BAR(2);
#define NFLUSH(t) do { if ((t) == tb + 1) { float lt_ = l_reg + shx<32>(l_reg); const float gs_ = wsf[32 + r32]; \
        nsa_accum_lds(tp, o, gs_ / lt_, wsf, r32, hi); _Pragma("unroll") for (int r = 0; r < 16; ++r) { o[0][r] = 0.f; o[1][r] = 0.f; } l_reg = 0.f; } } while (0)
#ifndef HY_NSPREAD
#define HY_NSPREAD 0
#endif
#if HY_NSPREAD
#define NSPREAD0(X) do { } while (0)
#define NSPREAD1(X) do { X; SBAR(); } while (0)
#else
#define NSPREAD0(X) do { X; } while (0)
#define NSPREAD1(X) do { } while (0)
#endif
#define NSTEP(C0_, C1_, P0_, P1_, t) do { SBAR(); \
    const lcp vp_ = vp0 + sl_prev; \
    { const int j_ = NJ(t); const unsigned tb_ = dup_bf16_exact((float)(64 * j_)) & himask; xa0.y = tb_; xa1.y = tb_; \
      if ((t) <= tb) xb.w = (((selmask >> j_) & 1u) ? 0u : 0x0000c6eau) & himask; \
      else if ((t) == tb + 1) { xb.z = split2(-slope2 * (float)qpos - C.M2w) & himask; xb.w = 0u; } } \
    PHASE_A(C0_, C1_, P0_, P1_); \
    DMA_K((t) + 3, sl_cur); NSPREAD0(DMA_V((t) + 1, sl_next)); \
    NMASK(C0_, C1_, t); \
    SBAR(); \
    GAPB4(o[0] = MF32(PAF(0), VF(0), o[0]); VJ(2, 0, 1), C0_, 0); \
    GAPB4(o[1] = MF32(PAF(0), VF(1), o[1]); VJ(0, 1, 1), C0_, 4); \
    KRD(0); GAPB4(o[0] = MF32(PAF(1), VF(2), o[0]); VJ(1, 0, 2), C0_, 8); \
    NSPREAD1(DMA_V((t) + 1, sl_next)); \
    KRD(1); GAPB4(o[1] = MF32(PAF(1), VF(0), o[1]); VJ(2, 1, 2), C0_, 12); \
    KRD(2); GAPB4(o[0] = MF32(PAF(2), VF(1), o[0]); VJ(0, 0, 3), C1_, 0); \
    KRD(3); GAPB4(o[1] = MF32(PAF(2), VF(2), o[1]); VJ(1, 1, 3), C1_, 4); \
    GAPB4(o[0] = MF32(PAF(3), VF(0), o[0]), C1_, 8); \
    GAPB4(o[1] = MF32(PAF(3), VF(1), o[1]), C1_, 12); \
    NFLUSH(t); \
    } while (0)
    int t = 1;
    for (; t + 1 < NT; t += 2) {
        NSTEP(pB0, pB1, pA0, pA1, t);     WAIT_BAR(2); ROT();
        NSTEP(pA0, pA1, pB0, pB1, t + 1); WAIT_BAR(2); ROT();
    }
    if (t < NT) {
        NSTEP(pB0, pB1, pA0, pA1, t); WAIT_BAR(0); ROT();
        l_reg += rowsum(pB0, pB1);
        pv_simple<2, NVN ? 1024 : 0>(o, pB0, pB1, vp0 + sl_prev);
    } else {
        WAIT_BAR(0);
        l_reg += rowsum(pA0, pA1);
        pv_simple<2, NVN ? 1024 : 0>(o, pA0, pA1, vp0 + sl_prev);
    }
#undef NSTEP
#undef NDEAD
#undef NFLUSH
#undef NMASK
#undef NC0
#undef NJ
#undef DMA_K
#undef DMA_V
#undef NTOFF
    TMARK(tm_d);
    {
        const float gw_ = bf2f(gatep[16]);
        const float lt_ = l_reg + shx<32>(l_reg);
        nsa_accum_lds(tp, o, gw_ / lt_, wsf, r32, hi);
    }
    {
        LAS bf16_t* zt = (LAS bf16_t*)(lds + L_ZT + wid * 4096);
#pragma unroll
        for (int d0 = 0; d0 < 2; ++d0)
#pragma unroll
            for (int r = 0; r < 16; ++r) {
                LAS bf16_t* zp = zt + crow(r, hi) * 64 + 32 * d0 + r32;
                const float v = tp[(d0 * 16 + r) * 512] * bf2f(*zp);
                *zp = (bf16_t)(cvtpk(v, v) & 0xffffu);
            }
        LDS_FENCE();
        bf16_t* orow = C.AOUT + ((size_t)b * T + tb * 64 + 32 * half + (lane >> 3)) * D + 512 + head * 64 + (lane & 7) * 8;
#pragma unroll
        for (int j = 0; j < 4; ++j) { const u32x4 w = *(const LAS u32x4*)((lcp)zt + (8 * j + (lane >> 3)) * 128 + (lane & 7) * 16); *(u32x4*)(orow + (size_t)(8 * j) * D) = w; }
    }
    asm volatile("s_waitcnt lgkmcnt(0)\n\ts_barrier" ::: "memory");
    TMARK(tm_e); TACC(3, tm_b, tm_a); TACC(4, tm_c, tm_b); TACC(5, tm_d, tm_c); TACC(6, tm_e, tm_d);
}
#undef ROT

__device__ __forceinline__ void attn_phase(const Args& A, ldsp lds, const int wave, int lane, const int qword = CW_QCTR) {
    const bool t0 = (wave == 0 && lane == 0);
    unsigned char* ws = A.ws;
    AttnCtx C;
    C.PROJ = (const bf16_t*)(ws + WS_PROJ); C.KC = (const bf16_t*)(ws + WS_KC); C.VC = (const bf16_t*)(ws + WS_VC); C.AOUT = (bf16_t*)(ws + WS_AOUT);
    C.gsub = A.in[9];
    {
        const float sa = wave_sum(A.in[5][lane] * A.in[6][lane]), sb = wave_sum(A.in[7][lane] * A.in[8][lane]);
        C.lam = expf(sa) - expf(sb) + LAM_INIT;
        const float mqd = wave_max(fabsf(A.in[3][lane])), mkd = wave_max(fabsf(A.in[4][lane])), mqn = wave_max(fabsf(A.in[10][lane]));
        const float mk0 = wave_max(fabsf(A.in[11][lane])), mk1 = wave_max(fabsf(A.in[11][64 + lane])), mk2 = wave_max(fabsf(A.in[11][128 + lane]));
        C.M2d = MCOEF * mqd * mkd; C.M2c = MCOEF * mqn * mk0; C.M2s = MCOEF * mqn * mk1; C.M2w = MCOEF * mqn * mk2;
        if (t0) { LAS float* sc = (LAS float*)(lds + L_MISC); sc[4] = C.lam; sc[5] = C.M2d; sc[6] = C.M2c; sc[7] = C.M2s; sc[8] = C.M2w; }
        C.lam = 0.f; C.M2d = 0.f; C.M2c = 0.f; C.M2s = 0.f; C.M2w = 0.f;
    }
#ifndef HY_QLEN
#define HY_QLEN 512
#define HY_QEXTRA_R 0
#endif
    unsigned* qctr = (unsigned*)(ws + WS_CTL) + qword;
    volatile LAS unsigned* bc = (volatile LAS unsigned*)(lds + L_MISC);
    const unsigned x0 = (unsigned)__builtin_amdgcn_s_getreg((3 << 11) | 20) & 7u;
    unsigned skip = 0u;
    for (;;) {
        if (t0) {
            unsigned found = 0xffffffffu;
            for (unsigned a = skip; a < 8u; ++a) {
                const unsigned x = (x0 + a) & 7u;
                const unsigned idx = atomicAdd(qctr + 64 * x, 1u);
                if (idx < (unsigned)HY_QLEN) { found = x * 1024u + idx; break; }
                skip = a + 1u;
            }
            bc[0] = found;
        }
        __syncthreads();
        const unsigned u = (unsigned)__builtin_amdgcn_readfirstlane((int)bc[0]);
        __syncthreads();
        if (u == 0xffffffffu) break;
        const int x = (int)(u >> 10); int idx = (int)(u & 1023u), b, r;
        if (idx < 256) { b = 4 * x + (idx >> 6); r = idx & 63; }
        else if (idx < 512) { b = 4 * x + ((idx - 256) >> 6); r = 64 + ((idx - 256) & 63); }
        else { idx -= 512; b = 4 * x + (idx >> 6); r = (idx & 63) + HY_QEXTRA_R; }
#ifndef HY_NO_DIFF
#ifndef HY_PROBE
#define HY_PROBE 0
#endif
        if (r < 64) { if ((HY_PROBE) != 0 && (u & 1023u) >= 512u) diff_unit<HY_PROBE>(C, b, r >> 4, 15 - (r & 15), lds, wave); else diff_unit<0>(C, b, r >> 4, 15 - (r & 15), lds, wave); }
#endif
#ifndef HY_NO_NSA
        if (r >= 64) nsa_unit(C, b, (r - 64) >> 5, 31 - ((r - 64) & 31), lds, wave);
#endif
    }
}

#define XB_TMO      128
#define XB_XCNT(j)  (256  + 64 * (j))
#define XB_XSUB(j)  (1280 + 64 * (j))
#define XB_XGEN(j)  (2304 + 64 * (j))
#define XB_TOP      3328
#define XB_TOPGEN   3392
#define XCD_BAR_WORDS 3456
#define XB_SPIN_CAP (1u << 22)
__device__ __forceinline__ unsigned xb_ld(unsigned* p)              { return __hip_atomic_load(p, __ATOMIC_RELAXED, __HIP_MEMORY_SCOPE_AGENT); }
__device__ __forceinline__ unsigned xb_add(unsigned* p, unsigned v) { return __hip_atomic_fetch_add(p, v, __ATOMIC_RELAXED, __HIP_MEMORY_SCOPE_AGENT); }
__device__ __forceinline__ unsigned xb_xcc_id() { return (unsigned)__builtin_amdgcn_s_getreg((3 << 11) | 20) & 0xFu; }
#define XB_SPIN(cond, bar) do { unsigned _sp = 0; while (cond) { __builtin_amdgcn_s_sleep(1); \
    if ((++_sp & 255u) == 0u) { if (xb_ld(&(bar)[XB_TMO])) break; if (_sp > XB_SPIN_CAP) { atomicAdd(&(bar)[XB_TMO], 1u); break; } } } } while (0)
struct XcdBarrier { unsigned* bar; unsigned x; volatile LAS unsigned* st; };
__device__ __forceinline__ XcdBarrier xcd_barrier_post(unsigned* bar, volatile LAS unsigned* st, bool t0) {
    XcdBarrier b; b.bar = bar; b.x = xb_xcc_id(); b.st = st;
    if (t0) (void)xb_add(&bar[XB_XCNT(b.x)], 1u);
    return b;
}
__device__ __forceinline__ void xcd_barrier_complete(unsigned* bar, unsigned x, unsigned& nloc, unsigned& nx) {
    const unsigned G = gridDim.x * gridDim.y * gridDim.z;
    unsigned sum, cnt, mine, sp = 0u;
    for (;;) {
        sum = 0u; cnt = 0u; mine = 0u;
#pragma unroll
        for (unsigned j = 0; j < 16; ++j) { const unsigned c = xb_ld(&bar[XB_XCNT(j)]); sum += c; cnt += (c > 0u) ? 1u : 0u; mine = (j == x) ? c : mine; }
        if (sum == G) break;
        __builtin_amdgcn_s_sleep(1);
        if ((++sp & 255u) == 0u) { if (xb_ld(&bar[XB_TMO])) break; if (sp > XB_SPIN_CAP) { atomicAdd(&bar[XB_TMO], 1u); break; } }
    }
    nloc = mine > 0u ? mine : 1u; nx = cnt > 0u ? cnt : 1u;
}
__device__ __forceinline__ void xcd_barrier(const XcdBarrier& b, bool t0) {
    asm volatile("s_waitcnt vmcnt(0)" ::: "memory");
    __syncthreads();
    if (t0) {
        unsigned* bar = b.bar;
        __builtin_amdgcn_s_waitcnt(0);
        unsigned nloc = b.st[0], nx = b.st[1];
        if (nloc == 0u) { xcd_barrier_complete(bar, b.x, nloc, nx); b.st[0] = nloc; b.st[1] = nx; }
        const unsigned old = xb_add(&bar[XB_XSUB(b.x)], 1u);
        const unsigned gen = old / nloc;
        if (old + 1u == (gen + 1u) * nloc) {
            __builtin_amdgcn_fence(__ATOMIC_RELEASE, "agent");
            asm volatile("s_waitcnt vmcnt(0)" ::: "memory");
            const unsigned og = xb_add(&bar[XB_TOP], 1u);
            const unsigned tg = og / nx;
            if (og + 1u == (tg + 1u) * nx) xb_add(&bar[XB_TOPGEN], 1u);
            else XB_SPIN(xb_ld(&bar[XB_TOPGEN]) == tg, bar);
            __builtin_amdgcn_fence(__ATOMIC_ACQUIRE, "agent");
            xb_add(&bar[XB_XGEN(b.x)], 1u);
            asm volatile("s_waitcnt vmcnt(0)" ::: "memory");
        } else {
            XB_SPIN(xb_ld(&bar[XB_XGEN(b.x)]) == gen, bar);
            __builtin_amdgcn_fence(__ATOMIC_ACQUIRE, "agent");
            asm volatile("s_waitcnt vmcnt(0)" ::: "memory");
        }
    }
    __syncthreads();
}
constexpr int CW_BAR = 4096;

__global__ void __launch_bounds__(512, 2) hymba_fwd(Args args) {
    extern __shared__ __attribute__((aligned(16))) unsigned char lds_raw[];
    ldsp lds = (ldsp)lds_raw;
    const int wave = __builtin_amdgcn_readfirstlane((int)threadIdx.x >> 6);
    const int G = gridDim.x; const int bx = blockIdx.x; const int vcu = (G % 8 == 0) ? (bx % 8) * (G / 8) + bx / 8 : bx;
    unsigned char* ws = args.ws;
    const int lo = args.ph_lo, hi = args.ph_hi;
#ifndef HY_PHASE_MASK
#define HY_PHASE_MASK 31
#endif
#define IN(k) ((((HY_PHASE_MASK) >> (k)) & 1) && lo <= (k) && (k) < hi)
#if HY_N_LAUNCHES == 1
    const bool t0 = (wave == 0) && ((hy_tid(wave) & 63) == 0);
    { volatile LAS unsigned* st = (volatile LAS unsigned*)(lds + L_MISC + 64); if (t0) { st[0] = 0u; st[1] = 0u; } __syncthreads(); }
    const XcdBarrier bar = xcd_barrier_post((unsigned*)(ws + WS_CTL) + CW_BAR, (volatile LAS unsigned*)(lds + L_MISC + 64), t0);
#define SEAM(k) do { if (IN(k) && IN((k) + 1)) { xcd_barrier(bar, (wave == 0) && ((hy_tid(wave) & 63) == 0)); } } while (0)
#else
#define SEAM(k) do { } while (0)
#endif
#ifdef HY_TSEL
    if (wave == 0 && (hy_tid(wave) & 63) < 16) ((volatile LAS unsigned*)(lds + L_MISC + 128))[hy_tid(wave) & 63] = 0u;
    __syncthreads();
#endif
#ifdef HY_TS_PHASE
    unsigned long long ts_[6]; ts_[0] = __builtin_amdgcn_s_memrealtime();
#define TS(k) do { ts_[k] = __builtin_amdgcn_s_memrealtime(); } while (0)
#else
#define TS(k) do { } while (0)
#endif
#ifndef HY_DUP_PHASE
#define HY_DUP_PHASE -1
#endif
#if HY_DUP_PHASE >= 0
#define DUP(k) for (int rep_ = 0; rep_ < __builtin_amdgcn_readfirstlane((HY_DUP_PHASE) == (k) ? 2 : 1); rep_ = __builtin_amdgcn_readfirstlane(rep_ + 1))
#else
#define DUP(k) for (int rep_ = 0, once_ = 1; once_; once_ = 0)
#endif
    if (IN(0)) DUP(0) { p0_prologue(args, lds, vcu, G, wave, hy_tid(wave) & 63); }
    SEAM(0); TS(1);
    if (IN(1)) DUP(1) {
        pg8::Gemm g{(const bf16_t*)(ws + WS_XN), (const bf16_t*)(ws + WS_WIN), M, NPAD, D}; pg8::StaticOrder S; S.init(M, NPAD, G, bx);
        EpiIn E{(bf16_t*)(ws + WS_PROJ), args.in[3], args.in[4], args.in[10], args.in[11]};
        pg8::gemm_phase<EpiIn, pg8::StaticOrder, true, true>((PG8_LAS unsigned char*)lds, g, S, E, wave);
    }
    SEAM(1); TS(2);
    if (IN(2)) DUP(2) { compress_phase(args, lds, wave, hy_tid(wave) & 63); }
    SEAM(2); TS(3);
#ifdef HY_TSEL
    const unsigned tp3a_ = (unsigned)__builtin_amdgcn_s_memrealtime();
#endif
    if (IN(3)) DUP(3) { attn_phase(args, lds, wave, hy_tid(wave) & 63, CW_QCTR + 512 * rep_); }
#ifdef HY_TSEL
    const unsigned tp3b_ = (unsigned)__builtin_amdgcn_s_memrealtime();
#endif
    SEAM(3); TS(4);
    if (IN(4)) DUP(4) {
        pg8::Gemm g{(const bf16_t*)(ws + WS_AOUT), (const bf16_t*)(ws + WS_WOUT), M, D, D}; pg8::StaticOrder S; S.init(M, D, G, bx);
        EpiOut E{args.in[0], args.out};
        pg8::gemm_phase<EpiOut, pg8::StaticOrder, true, true>((PG8_LAS unsigned char*)lds, g, S, E, wave);
    }
#ifdef HY_TS_PHASE
    xcd_barrier(bar, (wave == 0) && ((hy_tid(wave) & 63) == 0)); TS(5);
    if (bx == 0) { float v = (float)(ts_[HY_TS_PHASE + 1] - ts_[HY_TS_PHASE]) * 0.01f; v = exp2f(floorf(log2f(v) * 12.f + 0.5f) / 12.f);
        const int t = hy_tid(wave);
        for (size_t i = t; i < (size_t)M * D / 4; i += 512) ((f32x4*)args.out)[i] = (f32x4){v, v, v, v}; }
#endif
#ifdef HY_TSEL
    xcd_barrier(bar, (wave == 0) && ((hy_tid(wave) & 63) == 0));
    if (bx == 0) { volatile LAS unsigned* tmv = (volatile LAS unsigned*)(lds + L_MISC + 128);
        const float tot_ = (float)(tp3b_ - tp3a_); const float x_ = (HY_TSEL) == 7 ? tot_ * 0.01f / 50.f   : 20.f * (float)tmv[HY_TSEL] / tot_;
        const float v = 100.f * (10.f + floorf(x_)); const int t = hy_tid(wave);
        for (size_t i = t; i < (size_t)M * D / 4; i += 512) ((f32x4*)args.out)[i] = (f32x4){v, v, v, v}; }
#endif
#undef IN
#undef SEAM
}
}

extern "C" void kernel_launch(void* const* d_in, const int* in_sizes, int n_in, void* d_out, int out_size, void* d_ws, size_t ws_size, hipStream_t stream) {
    using namespace hy;
    static int grid = 0;
    if (grid == 0) {
        if (n_in != 17 || in_sizes[0] != M * D || out_size != M * D || ws_size < WS_END) {
            fprintf(stderr, "kernel_launch: unexpected shapes (n_in %d, in0 %d, out %d, ws %zu)\n", n_in, n_in > 0 ? in_sizes[0] : -1, out_size, ws_size); grid = -1; return; }
        { const int want[17] = {M * D, D, D * NIN, 64, 64, 64, 64, 64, 64, 128, 64, 192, 2 * 32 * 64, 2 * 2048 * 256, 2 * 256, 2 * 256 * 64, D * D};
          for (int i = 0; i < 17; ++i) if (in_sizes[i] != want[i]) { fprintf(stderr, "kernel_launch: input %d has %d elements, expected %d\n", i, in_sizes[i], want[i]); grid = -1; return; } }
        int dev = 0, cus = 0, per_cu = 0;
        if (hipGetDevice(&dev) != hipSuccess || hipDeviceGetAttribute(&cus, hipDeviceAttributeMultiprocessorCount, dev) != hipSuccess) { grid = -1; return; }
        if (hipFuncSetAttribute((const void*)hymba_fwd, hipFuncAttributeMaxDynamicSharedMemorySize, LDS_BYTES) != hipSuccess) { fprintf(stderr, "kernel_launch: hipFuncSetAttribute failed\n"); grid = -1; return; }
        if (hipOccupancyMaxActiveBlocksPerMultiprocessor(&per_cu, (const void*)hymba_fwd, 512, LDS_BYTES) != hipSuccess || per_cu < 1) { fprintf(stderr, "kernel_launch: occupancy query says %d blocks per CU\n", per_cu); grid = -1; return; }
        (void)hipGetLastError();
        grid = cus * 1;
    }
    if (grid < 0) return;
    (void)hipMemsetAsync((char*)d_ws + WS_CTL, 0, CTL_BYTES, stream);
    Args a{};
    for (int i = 0; i < 17; ++i) a.in[i] = (const float*)d_in[i];
    a.out = (float*)d_out; a.ws = (unsigned char*)d_ws;
#if HY_N_LAUNCHES == 1
    a.ph_lo = 0; a.ph_hi = 5;
    void* kargs[] = {&a};
    hipError_t e = hipLaunchCooperativeKernel((const void*)hymba_fwd, dim3(grid), dim3(512), kargs, LDS_BYTES, stream);
    if (e != hipSuccess) fprintf(stderr, "kernel_launch: cooperative launch failed: %s (grid %d)\n", hipGetErrorString(e), grid);
#else
    for (int p = 0; p < 5; ++p) { a.ph_lo = p; a.ph_hi = p + 1; hipLaunchKernelGGL(hymba_fwd, dim3(grid), dim3(512), LDS_BYTES, stream, a); }
#endif
}
```

```cpp
#include <hip/hip_runtime.h>
#include <cstdio>
#include <cstdint>
#include <cmath>
#define HY_N_LAUNCHES 1
namespace pg8 {
#define PG8_LAS __attribute__((address_space(3)))
typedef unsigned short bf16_t;
typedef short bf16x8 __attribute__((ext_vector_type(8)));
typedef float f32x4 __attribute__((ext_vector_type(4)));
typedef unsigned u32x4 __attribute__((ext_vector_type(4)));
constexpr int BM = 256, BK = 64, HALF = 128, HTB = HALF * BK * 2  , STAGE_BYTES = 8 * HTB, NXCD = 8, WGM = 8;

__host__ __device__ __forceinline__ int lds_byte(int r, int c) { const int st = (r >> 4) * 2 + (c >> 5), rr = r & 15, cc = c & 31, ob = rr * 64 + cc * 2; return st * 1024 + (ob ^ (((ob >> 9) & 1) << 5)); }
__host__ __device__ __forceinline__ void stage_rc(int b, int& R, int& C) { const int st = b / 1024, sb = b % 1024, swz = sb ^ (((sb >> 9) & 1) << 5); R = (st >> 1) * 16 + swz / 64; C = (st & 1) * 32 + (swz % 64) / 2; }
__host__ __device__ __forceinline__ int perm32(int rho) { const int n = rho >> 4, i = rho & 15; return 8 * (i >> 2) + 4 * n + (i & 3); }

struct Unit { int pm, pn; };
struct Gemm { const bf16_t* A; const bf16_t* Bt; int M, N, K; };

struct StaticOrder {
    int nM, nN, nwg, G, c;
    __host__ __device__ void init(int M, int N, int G_, int c_) { nM = M / BM; nN = N / BM; nwg = nM * nN; G = G_; c = c_; }
    __host__ __device__ bool next(int i, Unit& u) const {
        const long L = (long)i * G + c; if (L >= nwg) return false;
        int wgid = (int)L; { const int q = nwg / NXCD, r = nwg % NXCD, xcd = wgid % NXCD, off = wgid / NXCD; wgid = (xcd < r ? xcd * (q + 1) : r * (q + 1) + (xcd - r) * q) + off; }
        const int nig = WGM * nN, gid = wgid / nig, fm = gid * WGM, gsz = (nM - fm) < WGM ? (nM - fm) : WGM;
        u.pm = fm + ((wgid % nig) % gsz); u.pn = (wgid % nig) / gsz; return true;
    }
    __device__ __forceinline__ void a_ready(const Unit&) const {}
    __device__ __forceinline__ void done(const Unit&) const {}
};

template <class Epi, class Sched, bool ALIGN_EPI = false, bool SP2 = false>
__device__ __forceinline__ void gemm_phase(PG8_LAS unsigned char* lds, const Gemm g, const Sched& S, const Epi& E, const int wid) {
    unsigned z_; asm volatile("v_mov_b32 %0, 0" : "=v"(z_));
    const int tid = wid * 64 + (int)__builtin_amdgcn_mbcnt_hi(~0u, __builtin_amdgcn_mbcnt_lo(~0u, z_)), lane = tid & 63, wr = wid >> 2, wc = wid & 3, fr = lane & 15, fq = lane >> 4;
    const int K = g.K, nt = K / BK;
    unsigned voffA[2], voffB[2];
#pragma unroll
    for (int i = 0; i < 2; ++i) { int R, C; stage_rc(tid * 16 + i * 8192, R, C); const int Rb = Epi::PERM ? ((R & ~31) + perm32(R & 31)) : R;
        voffA[i] = (unsigned)(R * K + C) * 2u; voffB[i] = (unsigned)(Rb * K + C) * 2u; }
    const size_t kstep = (size_t)(BK * 2);
    const size_t hstep = (size_t)HALF * K * 2;
    const size_t tstep = 2 * hstep;
    const unsigned ldsw = (unsigned)wid * 1024u;
    const int aoff = lds_byte(wr * 64 + fr, fq * 8), boff = lds_byte(wc * 32 + fr, fq * 8);
#define PG8_SA(b, h) (((b) * 2 + (h)) * HTB)
#define PG8_SB(b, h) ((4 + (b) * 2 + (h)) * HTB)
#define PG8_STAGE(bufoff, gbase, voff) do { _Pragma("unroll") for (int _i = 0; _i < 2; ++_i) \
        __builtin_amdgcn_global_load_lds((const unsigned*)((const char*)(gbase) + (voff)[_i]), (PG8_LAS unsigned*)(lds + (bufoff) + ldsw + _i * 8192), 16, 0, 0); } while (0)
#define PG8_LDA(dst, b, h) do { _Pragma("unroll") for (int m = 0; m < 4; ++m) _Pragma("unroll") for (int k = 0; k < 2; ++k) dst[m][k] = *(const PG8_LAS bf16x8*)(lds + PG8_SA(b, h) + aoff + m * 2048 + k * 1024); } while (0)
#define PG8_LDB(dst, b, h) do { _Pragma("unroll") for (int n = 0; n < 2; ++n) _Pragma("unroll") for (int k = 0; k < 2; ++k) dst[n][k] = *(const PG8_LAS bf16x8*)(lds + PG8_SB(b, h) + boff + n * 2048 + k * 1024); } while (0)
#define PG8_MMA(ai, bj, At, Bt) do { __builtin_amdgcn_s_setprio(1); _Pragma("unroll") for (int m = 0; m < 4; ++m) _Pragma("unroll") for (int n = 0; n < 2; ++n) _Pragma("unroll") for (int k = 0; k < 2; ++k) \
        acc[ai][bj][m][n] = __builtin_amdgcn_mfma_f32_16x16x32_bf16(Bt[n][k], At[m][k], acc[ai][bj][m][n], 0, 0, 0); __builtin_amdgcn_s_setprio(0); } while (0)
#define PG8_WAIT_V(n) asm volatile("s_waitcnt vmcnt(" #n ")" ::: "memory")
#define PG8_WAIT_L(n) asm volatile("s_waitcnt lgkmcnt(" #n ")" ::: "memory")
#define PG8_BAR __builtin_amdgcn_s_barrier()
#define PG8_SCHED __builtin_amdgcn_sched_barrier(0)
    Unit cur, nxt; int ui = 0;
    if (!S.next(0, cur)) return;
    f32x4 acc[2][2][4][2];
#pragma unroll
    for (int a = 0; a < 2; ++a)
#pragma unroll
        for (int b = 0; b < 2; ++b)
#pragma unroll
            for (int m = 0; m < 4; ++m)
#pragma unroll
                for (int n = 0; n < 2; ++n) acc[a][b][m][n] = (f32x4){0.f, 0.f, 0.f, 0.f};
    bf16x8 At[4][2], B0[2][2], B1[2][2];
    const char* cA = (const char*)g.A + (size_t)cur.pm * tstep; const char* cB = (const char*)g.Bt + (size_t)cur.pn * tstep;
    S.a_ready(cur);
    if constexpr (SP2) {
        PG8_STAGE(PG8_SB(0, 0), cB, voffB); PG8_STAGE(PG8_SB(0, 1), cB + hstep, voffB); PG8_STAGE(PG8_SA(0, 0), cA, voffA); PG8_STAGE(PG8_SA(0, 1), cA + hstep, voffA);
        if (wr == 1) PG8_BAR;
        PG8_WAIT_V(2); PG8_BAR;
        PG8_STAGE(PG8_SB(1, 0), cB + kstep, voffB); PG8_STAGE(PG8_SA(1, 0), cA + kstep, voffA); PG8_STAGE(PG8_SB(1, 1), cB + hstep + kstep, voffB);
        PG8_WAIT_V(6); PG8_BAR;
    } else {
        PG8_STAGE(PG8_SB(0, 0), cB, voffB); PG8_STAGE(PG8_SA(0, 0), cA, voffA); PG8_STAGE(PG8_SB(0, 1), cB + hstep, voffB); PG8_STAGE(PG8_SA(0, 1), cA + hstep, voffA);
        if (wr == 1) PG8_BAR;
        PG8_WAIT_V(4); PG8_BAR;
        PG8_STAGE(PG8_SB(1, 0), cB + kstep, voffB); PG8_STAGE(PG8_SA(1, 0), cA + kstep, voffA); PG8_STAGE(PG8_SB(1, 1), cB + hstep + kstep, voffB);
        PG8_WAIT_V(6); PG8_BAR;
    }
    for (;;) {
        const bool has_next = S.next(ui + 1, nxt);
        const char* nA = has_next ? (const char*)g.A + (size_t)nxt.pm * tstep : cA; const char* nB = has_next ? (const char*)g.Bt + (size_t)nxt.pn * tstep : cB;
        for (int t = 0; t < nt; t += 2) {
            const bool last = (t == nt - 2);
            const char* a1 = cA + (size_t)(t + 1) * kstep;
            const char* a2 = last ? nA : cA + (size_t)(t + 2) * kstep; const char* b2 = last ? nB : cB + (size_t)(t + 2) * kstep;
            const char* a3 = a2 + kstep; const char* b3 = b2 + kstep;
            if (last && has_next) S.a_ready(nxt);
            if constexpr (SP2) {
            PG8_LDB(B0, 0, 0); PG8_LDB(B1, 0, 1); PG8_SCHED; PG8_LDA(At, 0, 0); PG8_STAGE(PG8_SA(1, 1), a1 + hstep, voffA);
            PG8_WAIT_V(8); PG8_WAIT_L(0); PG8_BAR; PG8_MMA(0, 0, At, B0); PG8_MMA(0, 1, At, B1); PG8_BAR; PG8_SCHED;
            PG8_LDA(At, 0, 1); PG8_STAGE(PG8_SB(0, 0), b2, voffB); PG8_STAGE(PG8_SB(0, 1), b2 + hstep, voffB); PG8_STAGE(PG8_SA(0, 0), a2, voffA);
            PG8_WAIT_V(8); PG8_WAIT_L(0); PG8_BAR; PG8_MMA(1, 0, At, B0); PG8_MMA(1, 1, At, B1); PG8_BAR; PG8_SCHED;
            PG8_LDB(B0, 1, 0); PG8_LDB(B1, 1, 1); PG8_SCHED; PG8_LDA(At, 1, 0); PG8_STAGE(PG8_SA(0, 1), a2 + hstep, voffA);
            PG8_WAIT_V(8); PG8_WAIT_L(0); PG8_BAR; PG8_MMA(0, 0, At, B0); PG8_MMA(0, 1, At, B1); PG8_BAR; PG8_SCHED;
            PG8_LDA(At, 1, 1); PG8_STAGE(PG8_SB(1, 0), b3, voffB); PG8_STAGE(PG8_SB(1, 1), b3 + hstep, voffB); PG8_STAGE(PG8_SA(1, 0), a3, voffA);
            PG8_WAIT_V(8); PG8_WAIT_L(0); PG8_BAR; PG8_MMA(1, 0, At, B0); PG8_MMA(1, 1, At, B1); PG8_BAR; PG8_SCHED;
            } else {
            PG8_LDB(B0, 0, 0); PG8_SCHED; PG8_LDA(At, 0, 0); PG8_STAGE(PG8_SA(1, 1), a1 + hstep, voffA);
            PG8_WAIT_L(8); PG8_BAR; PG8_WAIT_L(0); PG8_MMA(0, 0, At, B0); PG8_BAR; PG8_SCHED;
            PG8_LDB(B1, 0, 1); PG8_STAGE(PG8_SB(0, 0), b2, voffB);
            PG8_BAR; PG8_WAIT_L(0); PG8_MMA(0, 1, At, B1); PG8_BAR;
            PG8_LDA(At, 0, 1); PG8_STAGE(PG8_SA(0, 0), a2, voffA);
            PG8_BAR; PG8_WAIT_L(0); PG8_MMA(1, 0, At, B0); PG8_BAR; PG8_SCHED;
            PG8_STAGE(PG8_SB(0, 1), b2 + hstep, voffB);
            PG8_WAIT_V(6); PG8_BAR; PG8_MMA(1, 1, At, B1); PG8_BAR;
            PG8_LDB(B0, 1, 0); PG8_SCHED; PG8_LDA(At, 1, 0); PG8_STAGE(PG8_SA(0, 1), a2 + hstep, voffA);
            PG8_WAIT_L(8); PG8_BAR; PG8_WAIT_L(0); PG8_MMA(0, 0, At, B0); PG8_BAR; PG8_SCHED;
            PG8_LDB(B1, 1, 1); PG8_STAGE(PG8_SB(1, 0), b3, voffB);
            PG8_BAR; PG8_WAIT_L(0); PG8_MMA(0, 1, At, B1); PG8_BAR;
            PG8_LDA(At, 1, 1); PG8_STAGE(PG8_SA(1, 0), a3, voffA);
            PG8_BAR; PG8_WAIT_L(0); PG8_MMA(1, 0, At, B0); PG8_BAR; PG8_SCHED;
            PG8_STAGE(PG8_SB(1, 1), b3 + hstep, voffB);
            PG8_WAIT_V(6); PG8_BAR; PG8_MMA(1, 1, At, B1); PG8_BAR;
            }
        }
        if constexpr (ALIGN_EPI) { if (wr == 0) PG8_BAR; }
        if constexpr (!Epi::AFTER_DRAIN) { E(acc, cur, wr, wc, fr, fq); S.done(cur); }
        if (!has_next) break;
#pragma unroll
        for (int a = 0; a < 2; ++a)
#pragma unroll
            for (int b = 0; b < 2; ++b)
#pragma unroll
                for (int m = 0; m < 4; ++m)
#pragma unroll
                    for (int n = 0; n < 2; ++n) acc[a][b][m][n] = (f32x4){0.f, 0.f, 0.f, 0.f};
        cur = nxt; cA = nA; cB = nB; ++ui;
        if constexpr (ALIGN_EPI) { if (wr == 1) PG8_BAR; }
    }
    PG8_WAIT_V(0);
    if constexpr (!ALIGN_EPI) { if (wr == 0) PG8_BAR; }
    PG8_BAR;
    if constexpr (Epi::AFTER_DRAIN) { E.fused(acc, cur, wr, wc, fr, fq, lds, wid, lane); S.done(cur); }
#undef PG8_SA
#undef PG8_SB
#undef PG8_STAGE
#undef PG8_LDA
#undef PG8_LDB
#undef PG8_MMA
#undef PG8_WAIT_V
#undef PG8_WAIT_L
#undef PG8_BAR
#undef PG8_SCHED
}
}

#ifndef HY_P4_ALIGN
#define HY_P4_ALIGN true
#endif
#ifndef HY_N_LAUNCHES
#define HY_N_LAUNCHES 5
#endif

namespace hy {
#define LAS __attribute__((address_space(3)))
typedef unsigned short bf16_t;
typedef short bf16x8 __attribute__((ext_vector_type(8)));
typedef short s16x4 __attribute__((ext_vector_type(4)));
typedef float f32x4 __attribute__((ext_vector_type(4)));
typedef float f32x16 __attribute__((ext_vector_type(16)));
typedef unsigned u32x4 __attribute__((ext_vector_type(4)));
typedef unsigned u32x2 __attribute__((ext_vector_type(2)));
typedef LAS unsigned char* ldsp;

constexpr int BATCH = 32, T = 2048, D = 1024, M = BATCH * T;
constexpr int NIN = 3864, NPAD = 4096, LDP = 3904;
constexpr int C_DQ = 0, C_DK = 512, C_DV = 1024, C_DZ = 1536, C_NQ = 2048, C_NKV = 2560, C_NZ = 3328, C_NG = 3840;
constexpr float EPS = 1e-6f;
constexpr float LOG2E = 1.4426950408889634f;
constexpr float QSCALE = 0.125f * LOG2E;
constexpr float MCOEF = QSCALE * 64.0f;
constexpr float LAM_INIT = 0.2f;

constexpr size_t MiB = 1u << 20;
constexpr size_t WS_CTL = 0, CTL_BYTES = 1 * MiB;
constexpr size_t WS_WIN = 2 * MiB;
constexpr size_t WS_WOUT = 12 * MiB;
constexpr size_t WS_W1T = 14 * MiB;
constexpr size_t WS_W2T = 16 * MiB;
constexpr size_t WS_B1P = 16 * MiB + 256 * 1024;
constexpr size_t WS_KC = 17 * MiB;
constexpr size_t WS_VC = 18 * MiB;
constexpr size_t WS_XN = 32 * MiB;
constexpr size_t WS_AOUT = 160 * MiB;
constexpr size_t WS_PROJ = 288 * MiB;
constexpr size_t WS_END = 776 * MiB;
constexpr int CW_QCTR = 64;

constexpr int LDS_BYTES = 163840;
constexpr int L_IB = 81920, L_LB = L_IB + 33792, L_WSF = L_LB + 1024, L_ZT = L_WSF + 2048, L_MISC = 163328;
static_assert(L_ZT + 32768 <= L_MISC && L_MISC + 256 <= LDS_BYTES, "LDS map");

struct Args { const float* in[17]; float* out; unsigned char* ws; int ph_lo, ph_hi; };

#define LOG2E_F 1.4426950408889634f
#define LDS_FENCE() do { asm volatile("s_waitcnt lgkmcnt(0)" ::: "memory"); __builtin_amdgcn_wave_barrier(); } while (0)

__device__ __forceinline__ unsigned cvtpk(float lo, float hi) {
    typedef float f2_t __attribute__((ext_vector_type(2))); typedef __bf16 b2_t __attribute__((ext_vector_type(2)));
    f2_t v = {lo, hi}; b2_t b = __builtin_convertvector(v, b2_t); return __builtin_bit_cast(unsigned, b);
}
__device__ __forceinline__ int hy_tid(int wave) { unsigned z; asm volatile("v_mov_b32 %0, 0" : "=v"(z)); return wave * 64 + (int)__builtin_amdgcn_mbcnt_hi(~0u, __builtin_amdgcn_mbcnt_lo(~0u, z)); }
__device__ __forceinline__ float bf2f(unsigned short u) { return __builtin_bit_cast(float, (unsigned)u << 16); }
template <int K> __device__ __forceinline__ float shx(float v) {
    if constexpr (K == 32) {
        const unsigned u = __builtin_bit_cast(unsigned, v); auto rr = __builtin_amdgcn_permlane32_swap(u, u, false, false);
        return __builtin_bit_cast(float, rr[0] ^ rr[1] ^ u);
    } else return __builtin_bit_cast(float, __builtin_amdgcn_ds_swizzle(__builtin_bit_cast(int, v), (K << 10) | 0x1f));
}
template <int CTRL> __device__ __forceinline__ float dppf(float v) { return __builtin_bit_cast(float, __builtin_amdgcn_update_dpp(0, __builtin_bit_cast(int, v), CTRL, 0xf, 0xf, true)); }
__device__ __forceinline__ float red32(float v) {
    v += dppf<0xB1>(v); v += dppf<0x4E>(v); v += dppf<0x141>(v); v += dppf<0x140>(v); v += shx<16>(v);
    return v;
}
__device__ __forceinline__ float wave_sum(float v) {
    v += shx<1>(v); v += shx<2>(v); v += shx<4>(v); v += shx<8>(v); v += shx<16>(v); v += shx<32>(v);
    return v;
}
__device__ __forceinline__ float wave_max(float v) {
    v = fmaxf(v, shx<1>(v)); v = fmaxf(v, shx<2>(v)); v = fmaxf(v, shx<4>(v)); v = fmaxf(v, shx<8>(v)); v = fmaxf(v, shx<16>(v)); v = fmaxf(v, shx<32>(v));
    return v;
}
__device__ __forceinline__ float sigmf(float v) { return __builtin_amdgcn_rcpf(1.0f + __builtin_amdgcn_exp2f(-LOG2E_F * v)); }
__device__ __forceinline__ float siluf(float v) { return v * sigmf(v); }

__device__ __forceinline__ void transpose_item(const float* W, int ldw, int ncols, int n0, int k0, bf16_t* WT, int K, int p0, LAS float* scr, int lane) {
#pragma unroll 8
    for (int i = 0; i < 32; ++i) {
        const int kk = 2 * i + (lane >> 5), nn = lane & 31, n = n0 + nn;
#ifdef HY_T_NOLOAD
        scr[kk * 33 + nn] = (float)n;
#else
        scr[kk * 33 + nn] = (n < ncols) ? W[(size_t)(k0 + kk) * ldw + n] : 0.f;
#endif
    }
    LDS_FENCE();
    const int c = lane & 7;
#pragma unroll
    for (int j = 0; j < 4; ++j) {
        const int n = (lane >> 3) + 8 * j; const LAS float* s = scr + (8 * c) * 33 + n;
        u32x4 o; o.x = cvtpk(s[0 * 33], s[1 * 33]); o.y = cvtpk(s[2 * 33], s[3 * 33]); o.z = cvtpk(s[4 * 33], s[5 * 33]); o.w = cvtpk(s[6 * 33], s[7 * 33]);
#ifdef HY_T_NOSTORE
        if (o.x == 0x12345678u) *(u32x4*)(WT) = o;
#else
        *(u32x4*)(WT + (size_t)(p0 + n) * K + k0 + 8 * c) = o;
#endif
    }
    LDS_FENCE();
}
__device__ __forceinline__ void rms_rows4(const float* x0, const float* g, bf16_t* o0, int lane) {
    const f32x4* gr = (const f32x4*)g + lane;
    f32x4 v[4][4]; float s[4];
#pragma unroll
    for (int q = 0; q < 4; ++q) { const f32x4* xr = (const f32x4*)(x0 + (size_t)q * D) + lane;
#pragma unroll
        for (int j = 0; j < 4; ++j) v[q][j] = xr[64 * j]; }
#pragma unroll
    for (int q = 0; q < 4; ++q) { float a = 0.f;
#pragma unroll
        for (int j = 0; j < 4; ++j) a += (v[q][j].x * v[q][j].x + v[q][j].y * v[q][j].y) + (v[q][j].z * v[q][j].z + v[q][j].w * v[q][j].w);
        s[q] = a; }
#pragma unroll
    for (int q = 0; q < 4; ++q) s[q] = wave_sum(s[q]);
    f32x4 gj[4];
#pragma unroll
    for (int j = 0; j < 4; ++j) gj[j] = gr[64 * j];
#pragma unroll
    for (int q = 0; q < 4; ++q) { const float r = 1.0f / sqrtf(s[q] * (1.f / D) + EPS); u32x2* o8 = (u32x2*)(o0 + (size_t)q * D) + lane;
#pragma unroll
        for (int j = 0; j < 4; ++j) { const f32x4 y = (v[q][j] * r) * gj[j]; u32x2 w; w.x = cvtpk(y.x, y.y); w.y = cvtpk(y.z, y.w); o8[64 * j] = w; } }
}
__device__ __forceinline__ void p0_prologue(const Args& A, ldsp lds, int vcu, int G, int wave, int lane) {
    LAS float* scr = (LAS float*)(lds + wave * 16384);
    unsigned char* ws = A.ws;
    const int gw = vcu * 8 + wave, NGW = G * 8;
    constexpr int I_WIN = (NPAD / 32) * (D / 64), I_WOUT = (D / 32) * (D / 64), I_W1 = (256 / 32) * (2048 / 64), I_W2 = (64 / 32) * (256 / 64), I_B1 = 2 * 4 * 8;
    constexpr int NITEMS = I_WIN + I_WOUT + 2 * I_W1 + 2 * I_W2 + I_B1;
#ifndef HY_P0_SKIP_T
#ifndef HY_IT_LO
#define HY_IT_LO 0
#define HY_IT_HI NITEMS
#endif
    for (int it = gw; it < NITEMS; it += NGW) {
        int r = it;
        if (it < (HY_IT_LO) || it >= (HY_IT_HI)) continue;
#ifdef HY_WAVE_LT
        if (wave >= (HY_WAVE_LT)) continue;
#endif
        if (r < I_WIN) { const int nb = r / (D / 64), kb = r % (D / 64), p0 = 32 * nb;
            const int n0 = 256 * (p0 >> 8) + 64 * ((p0 >> 5) & 3) + 32 * ((p0 >> 7) & 1);
            transpose_item(A.in[2], NIN, NIN, n0, 64 * kb, (bf16_t*)(ws + WS_WIN), D, p0, scr, lane); continue; }
        r -= I_WIN;
        if (r < I_WOUT) { const int nb = r / (D / 64), kb = r % (D / 64); transpose_item(A.in[16], D, D, 32 * nb, 64 * kb, (bf16_t*)(ws + WS_WOUT), D, 32 * nb, scr, lane); continue; }
        r -= I_WOUT;
        if (r < 2 * I_W1) { const int wh = r / I_W1, q = r % I_W1, nb = q / 32, kb = q % 32;
            transpose_item(A.in[13] + (size_t)wh * 2048 * 256, 256, 256, 32 * nb, 64 * kb, (bf16_t*)(ws + WS_W1T) + (size_t)wh * 256 * 2048, 2048, 32 * nb, scr, lane); continue; }
        r -= 2 * I_W1;
        if (r < 2 * I_W2) { const int wh = r / I_W2, q = r % I_W2, nb = q / 4, kb = q % 4;
            transpose_item(A.in[15] + (size_t)wh * 256 * 64, 64, 64, 32 * nb, 64 * kb, (bf16_t*)(ws + WS_W2T) + (size_t)wh * 64 * 256, 256, 32 * nb, scr, lane); continue; }
        r -= 2 * I_W2;
        {
            const int wh = r >> 5, ng = (r >> 3) & 3, ksl = r & 7;
            const float* pos = A.in[12] + (size_t)wh * 2048 + ksl * 256; const float* w1 = A.in[13] + (size_t)wh * 2048 * 256 + (size_t)(ksl * 256) * 256 + ng * 64 + lane;
            float acc = 0.f;
#pragma unroll 8
            for (int k = 0; k < 256; ++k) acc = fmaf(pos[k], w1[(size_t)k * 256], acc);
            ((float*)(ws + WS_B1P))[(wh * 8 + ksl) * 256 + ng * 64 + lane] = acc;
        }
    }
#endif
#ifndef HY_P0_SKIP_R
    for (int m = 4 * gw; m < M; m += 4 * NGW) rms_rows4(A.in[0] + (size_t)m * D, A.in[1], (bf16_t*)(ws + WS_XN) + (size_t)m * D, lane);
#endif
}

struct EpiIn {
    static constexpr bool PERM = true, AFTER_DRAIN = false;
    bf16_t* P; const float* gq_d; const float* gk_d; const float* gq_n; const float* gk_n3;
    __device__ __forceinline__ void operator()(const f32x4 (&acc)[2][2][4][2], const pg8::Unit& u, int wr, int wc, int fr, int fq) const {
        const int G = u.pn * 4 + wc;
        if (G > 60) return;
        int kind = 0; const float* g = nullptr; float post = 1.f;
        if (G < 8) { kind = 1; g = gq_d; post = QSCALE; }
        else if (G < 16) { kind = 1; g = gk_d; }
        else if (G < 24) { kind = 0; }
        else if (G < 32) { kind = 2; }
        else if (G < 40) { kind = 1; g = gq_n; post = QSCALE; }
        else if (G < 52) { const int wh = (G - 40) >> 1; if (wh == 2) { kind = 1; g = gk_n3 + 64; } else if (wh == 4) { kind = 1; g = gk_n3 + 128; } }
        else if (G < 60) { kind = 2; }
        else { kind = 3; }
        f32x4 gv[2][2];
#pragma unroll
        for (int bj = 0; bj < 2; ++bj)
#pragma unroll
            for (int n = 0; n < 2; ++n) gv[bj][n] = (kind == 1) ? (*(const f32x4*)(g + 32 * bj + 8 * fq + 4 * n)) * post : (f32x4){1.f, 1.f, 1.f, 1.f};
        bf16_t* base = P + (size_t)(u.pm * 256 + wr * 64 + fr) * LDP + G * 64 + 8 * fq;
#pragma unroll
        for (int ai = 0; ai < 2; ++ai)
#pragma unroll
            for (int m = 0; m < 4; ++m) {
                f32x4 v[2][2];
#pragma unroll
                for (int bj = 0; bj < 2; ++bj)
#pragma unroll
                    for (int n = 0; n < 2; ++n) v[bj][n] = acc[ai][bj][m][n];
                if (kind == 1) {
                    float ss = 0.f;
#pragma unroll
                    for (int bj = 0; bj < 2; ++bj)
#pragma unroll
                        for (int n = 0; n < 2; ++n) { const f32x4 x = v[bj][n]; ss += (x[0] * x[0] + x[1] * x[1]) + (x[2] * x[2] + x[3] * x[3]); }
                    ss += shx<16>(ss); ss += shx<32>(ss);
                    const float r = __builtin_amdgcn_rsqf(ss * (1.f / 64.f) + EPS);
#pragma unroll
                    for (int bj = 0; bj < 2; ++bj)
#pragma unroll
                        for (int n = 0; n < 2; ++n) v[bj][n] = (v[bj][n] * r) * gv[bj][n];
                } else if (kind == 2) {
#pragma unroll
                    for (int bj = 0; bj < 2; ++bj)
#pragma unroll
                        for (int n = 0; n < 2; ++n)
#pragma unroll
                            for (int e = 0; e < 4; ++e) v[bj][n][e] = siluf(v[bj][n][e]);
                } else if (kind == 3) {
#pragma unroll
                    for (int bj = 0; bj < 2; ++bj)
#pragma unroll
                        for (int n = 0; n < 2; ++n)
#pragma unroll
                            for (int e = 0; e < 4; ++e) v[bj][n][e] = sigmf(v[bj][n][e]);
                }
                bf16_t* rowp = base + (size_t)(ai * 128 + m * 16) * LDP;
#pragma unroll
                for (int bj = 0; bj < 2; ++bj) {
                    u32x4 w; w.x = cvtpk(v[bj][0][0], v[bj][0][1]); w.y = cvtpk(v[bj][0][2], v[bj][0][3]); w.z = cvtpk(v[bj][1][0], v[bj][1][1]); w.w = cvtpk(v[bj][1][2], v[bj][1][3]);
                    *(u32x4*)(rowp + 32 * bj) = w;
                }
            }
    }
};
struct EpiOut {
    static constexpr bool PERM = false, AFTER_DRAIN = false;
    const float* x; float* out;
    __device__ __forceinline__ void operator()(const f32x4 (&acc)[2][2][4][2], const pg8::Unit& u, int wr, int wc, int fr, int fq) const {
        const int col0 = u.pn * 256 + wc * 32 + 4 * fq;
#pragma unroll
        for (int ai = 0; ai < 2; ++ai) {
            f32x4 xv[4][2][2];
#pragma unroll
            for (int m = 0; m < 4; ++m) {
                const size_t off = (size_t)(u.pm * 256 + ai * 128 + wr * 64 + m * 16 + fr) * D + col0;
#pragma unroll
                for (int bj = 0; bj < 2; ++bj)
#pragma unroll
                    for (int n = 0; n < 2; ++n) xv[m][bj][n] = *(const f32x4*)(x + off + bj * 128 + n * 16);
            }
#pragma unroll
            for (int m = 0; m < 4; ++m) {
                const size_t off = (size_t)(u.pm * 256 + ai * 128 + wr * 64 + m * 16 + fr) * D + col0;
#pragma unroll
                for (int bj = 0; bj < 2; ++bj)
#pragma unroll
                    for (int n = 0; n < 2; ++n) *(f32x4*)(out + off + bj * 128 + n * 16) = xv[m][bj][n] + acc[ai][bj][m][n];
            }
        }
    }
};

__device__ __forceinline__ void compress_phase(const Args& A, ldsp lds, int wave, int lane) {
    unsigned char* ws = A.ws;
    const bf16_t* PROJ = (const bf16_t*)(ws + WS_PROJ);
    const int tid = wave * 64 + lane, fr = lane & 15, kq = lane >> 4, rg4 = wave & 3, ch = wave >> 2;
    constexpr int BROW = 144, BSLOT = 256 * BROW, HB_OFF = 2 * BSLOT;
    LAS bf16_t* hbuf = (LAS bf16_t*)(lds + HB_OFF);
    for (int uidx = blockIdx.x; uidx < 256; uidx += gridDim.x) {
        const int wh = uidx & 1, kvh = (uidx >> 1) & 1, rh = (uidx >> 2) & 1, b = uidx >> 3;
        const bf16_t* src = PROJ + (size_t)(b * T) * LDP + C_NKV + wh * 128 + kvh * 64;
        const bf16_t* w1t = (const bf16_t*)(ws + WS_W1T) + (size_t)wh * 256 * 2048;
        const bf16_t* w2t = (const bf16_t*)(ws + WS_W2T) + (size_t)wh * 64 * 256;
        const float* b1 = A.in[14] + wh * 256; const float* b1p = (const float*)(ws + WS_B1P) + wh * 8 * 256;
        const int i = rh * 64 + rg4 * 16 + fr;
        const bf16_t* bsrc = w1t + (size_t)(tid >> 1) * 2048 + (tid & 1) * 32;
        const int bdst = (tid >> 1) * BROW + (tid & 1) * 64;
        int tok0 = 16 * i; tok0 = tok0 < T - 31 ? tok0 : T - 32;
        const bf16_t* asrc = src + (size_t)tok0 * LDP + 8 * kq;
        f32x4 acc[8];
#pragma unroll
        for (int nt = 0; nt < 8; ++nt) acc[nt] = (f32x4){0.f, 0.f, 0.f, 0.f};
        u32x4 rb[4]; bf16x8 a[2], an[2];
#pragma unroll
        for (int q = 0; q < 4; ++q) rb[q] = *(const u32x4*)(bsrc + q * 8);
        a[0] = *(const bf16x8*)(asrc); a[1] = *(const bf16x8*)(asrc + 32);
#pragma unroll
        for (int q = 0; q < 4; ++q) *(LAS u32x4*)(lds + bdst + q * 16) = rb[q];
        __syncthreads();
#pragma unroll 1
        for (int ks = 0; ks < 32; ++ks) {
            const int cur = (ks & 1) * BSLOT, nxt = BSLOT - cur;
            if (ks + 1 < 32) {
#pragma unroll
                for (int q = 0; q < 4; ++q) rb[q] = *(const u32x4*)(bsrc + (ks + 1) * 64 + q * 8);
                an[0] = *(const bf16x8*)(asrc + (size_t)(ks + 1) * LDP); an[1] = *(const bf16x8*)(asrc + (size_t)(ks + 1) * LDP + 32);
            }
            const LAS unsigned char* bp = lds + cur + (ch * 128 + fr) * BROW + kq * 16;
#pragma unroll
            for (int sb = 0; sb < 2; ++sb)
#pragma unroll
                for (int nt = 0; nt < 8; ++nt) {
                    const bf16x8 bb = *(const LAS bf16x8*)(bp + nt * 16 * BROW + sb * 64);
                    acc[nt] = __builtin_amdgcn_mfma_f32_16x16x32_bf16(a[sb], bb, acc[nt], 0, 0, 0);
                }
            if (ks + 1 < 32) {
#pragma unroll
                for (int q = 0; q < 4; ++q) *(LAS u32x4*)(lds + nxt + bdst + q * 16) = rb[q];
                a[0] = an[0]; a[1] = an[1];
            }
            __syncthreads();
        }
#pragma unroll
        for (int nt = 0; nt < 8; ++nt) {
            const int col = ch * 128 + 16 * nt + fr; float bias = b1[col];
#pragma unroll
            for (int sl = 0; sl < 8; ++sl) bias += b1p[sl * 256 + col];
#pragma unroll
            for (int rg = 0; rg < 4; ++rg) { const float hv = siluf(acc[nt][rg] + bias); hbuf[(rg4 * 16 + 4 * kq + rg) * 264 + col] = (bf16_t)(cvtpk(hv, hv) & 0xffffu); }
        }
        __syncthreads();
        if (ch == 0) {
            f32x4 acc2[4];
#pragma unroll
            for (int nt = 0; nt < 4; ++nt) acc2[nt] = (f32x4){0.f, 0.f, 0.f, 0.f};
#pragma unroll
            for (int ks = 0; ks < 8; ++ks) {
                const bf16x8 av = *(const LAS bf16x8*)(hbuf + (rg4 * 16 + fr) * 264 + 32 * ks + 8 * kq);
#pragma unroll
                for (int nt = 0; nt < 4; ++nt) {
                    const bf16x8 bb = *(const bf16x8*)(w2t + (size_t)(nt * 16 + fr) * 256 + 32 * ks + 8 * kq);
                    acc2[nt] = __builtin_amdgcn_mfma_f32_16x16x32_bf16(av, bb, acc2[nt], 0, 0, 0);
                }
            }
            bf16_t* dst = (bf16_t*)(ws + (wh == 0 ? WS_KC : WS_VC)) + (size_t)((b * 2 + kvh) * 128) * 64;
            const float* gk = A.in[11];
#pragma unroll
            for (int rg = 0; rg < 4; ++rg) {
                const int io = rh * 64 + rg4 * 16 + 4 * kq + rg;
                float v[4];
#pragma unroll
                for (int nt = 0; nt < 4; ++nt) v[nt] = acc2[nt][rg];
                if (wh == 0) {
                    float ss = (v[0] * v[0] + v[1] * v[1]) + (v[2] * v[2] + v[3] * v[3]);
                    ss += shx<1>(ss); ss += shx<2>(ss); ss += shx<4>(ss); ss += shx<8>(ss);
                    const float r = 1.0f / sqrtf(ss * (1.f / 64.f) + EPS);
#pragma unroll
                    for (int nt = 0; nt < 4; ++nt) v[nt] = (v[nt] * r) * gk[16 * nt + fr];
                }
#pragma unroll
                for (int nt = 0; nt < 4; ++nt) { const float ov = (io < 127) ? v[nt] : 0.f; dst[(size_t)io * 64 + 16 * nt + fr] = (bf16_t)(cvtpk(ov, ov) & 0xffffu); }
            }
        }
        __syncthreads();
    }
}

__device__ __forceinline__ int crow(int r, int hi) { return (r & 3) + 8 * (r >> 2) + 4 * hi; }
typedef short v4i16_t __attribute__((ext_vector_type(4)));
typedef LAS const unsigned char* lcp;
__device__ __forceinline__ s16x4 vtr(lcp p) { return __builtin_bit_cast(s16x4, __builtin_amdgcn_ds_read_tr16_b64_v4i16((LAS v4i16_t*)p)); }
#define SBAR() __builtin_amdgcn_sched_barrier(0)
#define WAIT_BAR(N) asm volatile("s_waitcnt vmcnt(" #N ") lgkmcnt(0)\n\ts_barrier" ::: "memory")
__device__ __forceinline__ void glds16(const void* gsrc, unsigned lds_dst) {
    unsigned keep;
    asm volatile("s_mov_b32 %0, m0\n\ts_mov_b32 m0, %2\n\ts_nop 0\n\tglobal_load_lds_dwordx4 %1, off\n\ts_mov_b32 m0, %0" : "=&s"(keep) : "v"(gsrc), "s"(lds_dst) : "memory");
}
__device__ __forceinline__ void glds16s(unsigned voff, const void* sbase, unsigned lds_dst) {
    unsigned keep;
    asm volatile("s_mov_b32 %0, m0\n\ts_mov_b32 m0, %3\n\ts_nop 0\n\tglobal_load_lds_dwordx4 %1, %2\n\ts_mov_b32 m0, %0" : "=&s"(keep) : "v"(voff), "s"(sbase), "s"(lds_dst) : "memory");
}
constexpr int N_VR = 24576;
constexpr int N_CMP = 49152;
constexpr int D_VR = 49152;

__device__ __forceinline__ lcp lxor(lcp p, unsigned x) { return (lcp)(uintptr_t)((unsigned)(uintptr_t)p ^ x); }
template <int KH = 0>
__device__ __forceinline__ void qk_simple(f32x16& p0, f32x16& p1, lcp kp, const bf16x8 (&qr)[4], float c0) {
#pragma unroll
    for (int r = 0; r < 16; ++r) { p0[r] = c0; p1[r] = c0; }
#pragma unroll
    for (int d0 = 0; d0 < 4; ++d0) {
        const bf16x8 b0 = *(const LAS bf16x8*)(KH ? lxor(kp, d0 << 5) : kp + d0 * 2048);
        const bf16x8 b1 = *(const LAS bf16x8*)(KH ? lxor(kp, d0 << 5) + KH : kp + d0 * 2048 + 512);
        p0 = __builtin_amdgcn_mfma_f32_32x32x16_bf16(b0, qr[d0], p0, 0, 0, 0);
        p1 = __builtin_amdgcn_mfma_f32_32x32x16_bf16(b1, qr[d0], p1, 0, 0, 0);
    }
}
__device__ __forceinline__ void mask_neg(f32x16& p0, f32x16& p1, int kbase, int kmin, int kmax) {
#pragma unroll
    for (int r = 0; r < 16; ++r) {
        const int kv = kbase + (r & 3) + 8 * (r >> 2);
        if (kv < kmin || kv > kmax) p0[r] = -INFINITY;
        if (kv + 32 < kmin || kv + 32 > kmax) p1[r] = -INFINITY;
    }
}
__device__ __forceinline__ void mask_hi(f32x16& p0, f32x16& p1, int kbase, int kmax) {
#pragma unroll
    for (int r = 0; r < 16; ++r) {
        const int kv = kbase + (r & 3) + 8 * (r >> 2);
        if (kv > kmax) p0[r] = -INFINITY;
        if (kv + 32 > kmax) p1[r] = -INFINITY;
    }
}
template <bool ALIBI>
__device__ __forceinline__ void exp_all(f32x16& p0, f32x16& p1, float slope2) {
#pragma unroll
    for (int r = 0; r < 16; ++r) {
        const float cr = (float)((r & 3) + 8 * (r >> 2));
        if (ALIBI) { p0[r] = __builtin_amdgcn_exp2f(fmaf(slope2, cr, p0[r])); p1[r] = __builtin_amdgcn_exp2f(fmaf(slope2, cr + 32.f, p1[r])); }
        else { p0[r] = __builtin_amdgcn_exp2f(p0[r]); p1[r] = __builtin_amdgcn_exp2f(p1[r]); }
    }
}
__device__ __forceinline__ float rowsum(const f32x16& p0, const f32x16& p1) {
    float s = 0.f;
#pragma unroll
    for (int r = 0; r < 16; ++r) s += p0[r] + p1[r];
    return s;
}
__device__ __forceinline__ void pack_p(bf16x8 (&pa)[4], const f32x16& p0, const f32x16& p1) {
    u32x4 w;
    w.x = cvtpk(p0[0], p0[1]); w.y = cvtpk(p0[2], p0[3]); w.z = cvtpk(p0[4], p0[5]); w.w = cvtpk(p0[6], p0[7]); pa[0] = __builtin_bit_cast(bf16x8, w);
    w.x = cvtpk(p0[8], p0[9]); w.y = cvtpk(p0[10], p0[11]); w.z = cvtpk(p0[12], p0[13]); w.w = cvtpk(p0[14], p0[15]); pa[1] = __builtin_bit_cast(bf16x8, w);
    w.x = cvtpk(p1[0], p1[1]); w.y = cvtpk(p1[2], p1[3]); w.z = cvtpk(p1[4], p1[5]); w.w = cvtpk(p1[6], p1[7]); pa[2] = __builtin_bit_cast(bf16x8, w);
    w.x = cvtpk(p1[8], p1[9]); w.y = cvtpk(p1[10], p1[11]); w.z = cvtpk(p1[12], p1[13]); w.w = cvtpk(p1[14], p1[15]); pa[3] = __builtin_bit_cast(bf16x8, w);
}
template <int NDV, int VH = 0>
__device__ __forceinline__ void pv_simple(f32x16 (&o)[NDV], const f32x16& p0, const f32x16& p1, lcp vp) {
    bf16x8 pa[4]; pack_p(pa, p0, p1);
#pragma unroll
    for (int d0 = 0; d0 < NDV; ++d0)
#pragma unroll
        for (int ks = 0; ks < 4; ++ks) {
            const lcp a_ = VH ? lxor(vp, d0 << 6) + ks * (2 * VH) : vp + d0 * 4096 + ks * 1024;
            const s16x4 lo = vtr(a_), hh = vtr(a_ + (VH ? VH : 512));
            const bf16x8 vb = (bf16x8){lo[0], lo[1], lo[2], lo[3], hh[0], hh[1], hh[2], hh[3]};
            o[d0] = __builtin_amdgcn_mfma_f32_32x32x16_bf16(pa[ks], vb, o[d0], 0, 0, 0);
        }
}

struct AttnCtx {
    const bf16_t* PROJ; const bf16_t* KC; const bf16_t* VC; bf16_t* AOUT;
    const float* gsub;
    float lam;
    float M2d, M2c, M2s, M2w;
};

#ifdef HY_TSEL
#define TMARK(var) const unsigned var = (unsigned)__builtin_amdgcn_s_memrealtime()
#define TACC(slot, t1, t0) do { if (wid == 0 && (tid & 63) == 0) ((volatile LAS unsigned*)(lds + L_MISC + 128))[slot] += (t1) - (t0); } while (0)
#else
#define TMARK(var) do { } while (0)
#define TACC(slot, t1, t0) do { } while (0)
#endif
#define PKW(P, B) cvtpk(P[B], P[(B) + 1])
#define PAF(k) __builtin_bit_cast(bf16x8, pw##k)
#define PIN(x) asm volatile("" : "+v"(x))
#define MF32(a, b, c) __builtin_amdgcn_mfma_f32_32x32x16_bf16(a, b, c, 0, 0, 0)
#define VJ(buf, dblk, ks) do { const lcp a_ = VADDR(dblk, ks); vl##buf = vtr(a_); vh##buf = vtr(a_ + VHB); } while (0)
#define VADDR(dblk, ks) (lxor(vp_, (dblk) << 6) + (ks) * (2 * VHB))
#define KADDR(j) lxor(kp0 + sl_next, (j) << 5)
#define VF(buf) (bf16x8){vl##buf[0], vl##buf[1], vl##buf[2], vl##buf[3], vh##buf[0], vh##buf[1], vh##buf[2], vh##buf[3]}
#define KRD(j) do { const lcp a_ = KADDR(j); kf[2 * (j)] = *(const LAS bf16x8*)a_; kf[2 * (j) + 1] = *(const LAS bf16x8*)(a_ + KHB); SBAR(); } while (0)
#define GAPA(MF, A0, A1, A2, A3, W0, W1, PW) do { MF; sacc += A0; sacc += A1; sacc += A2; sacc += A3; PIN(sacc); W0; W1; PIN(PW); SBAR(); } while (0)
#define EX1(X, r) X[r] = __builtin_amdgcn_exp2f(X[r])
#define GAPB4(MF, X, B) do { MF; EX1(X, B); EX1(X, (B) + 1); EX1(X, (B) + 2); EX1(X, (B) + 3); PIN(X); SBAR(); } while (0)
#define GAPB2(MF, X, B) do { MF; EX1(X, B); EX1(X, (B) + 1); PIN(X); SBAR(); } while (0)
__device__ __forceinline__ unsigned split2(float x) { const unsigned h = cvtpk(x, 0.f) & 0xffffu; const float hf = __builtin_bit_cast(float, h << 16); return h | (cvtpk(0.f, x - hf) & 0xffff0000u); }
__device__ __forceinline__ unsigned dup_bf16_exact(float x) { const unsigned h = __builtin_bit_cast(unsigned, x) >> 16; return h | (h << 16); }
#define GAPA2(MF, A0, A1, W0, W1, PW) do { MF; sacc += A0; sacc += A1; PIN(sacc); W0; W1; PIN(PW); SBAR(); } while (0)
#define PHASE_A(C0_, C1_, P0_, P1_) do { \
    float sacc = (P0_[0] + P0_[1]); \
    GAPA(C0_ = MF32(__builtin_bit_cast(bf16x8, xa0), __builtin_bit_cast(bf16x8, xb), z16), P0_[2], P0_[3], P0_[4], P0_[5], pw0[0] = PKW(P0_, 0),  pw0[1] = PKW(P0_, 2),  pw0); \
    PA_HOOK0; \
    GAPA(C1_ = MF32(__builtin_bit_cast(bf16x8, xa1), __builtin_bit_cast(bf16x8, xb), z16), P0_[6], P0_[7], P0_[8], P0_[9], pw0[2] = PKW(P0_, 4),  pw0[3] = PKW(P0_, 6),  pw0); \
    GAPA(C0_ = MF32(kf[0], qr[0], C0_), P0_[10], P0_[11], P0_[12], P0_[13], pw1[0] = PKW(P0_, 8),  pw1[1] = PKW(P0_, 10), pw1); \
    PA_HOOK1; \
    GAPA(C1_ = MF32(kf[1], qr[0], C1_), P0_[14], P0_[15], P1_[0], P1_[1],   pw1[2] = PKW(P0_, 12), pw1[3] = PKW(P0_, 14), pw1); \
    GAPA(C0_ = MF32(kf[2], qr[1], C0_), P1_[2], P1_[3], P1_[4], P1_[5],     pw2[0] = PKW(P1_, 0),  pw2[1] = PKW(P1_, 2),  pw2); \
    PA_HOOK2; \
    GAPA(C1_ = MF32(kf[3], qr[1], C1_), P1_[6], P1_[7], P1_[8], P1_[9],     pw2[2] = PKW(P1_, 4),  pw2[3] = PKW(P1_, 6),  pw2); \
    GAPA(C0_ = MF32(kf[4], qr[2], C0_), P1_[10], P1_[11], P1_[12], P1_[13], pw3[0] = PKW(P1_, 8),  pw3[1] = PKW(P1_, 10), pw3); \
    PA_HOOK3; \
    GAPA2(C1_ = MF32(kf[5], qr[2], C1_), P1_[14], P1_[15],                  pw3[2] = PKW(P1_, 12), pw3[3] = PKW(P1_, 14), pw3); \
    C0_ = MF32(kf[6], qr[3], C0_); VJ(0, 0, 0); SBAR(); \
    C1_ = MF32(kf[7], qr[3], C1_); VJ(1, 1, 0); SBAR(); \
    l_reg += sacc; } while (0)

template <int PRB>
__device__ __forceinline__ void diff_unit(const AttnCtx& C0, int b, int h, int qb, ldsp lds, const int wid) {
    constexpr int probe = PRB;
    AttnCtx C = C0; if (probe) C.AOUT = (bf16_t*)((unsigned char*)C.AOUT - (WS_AOUT - WS_XN));
    { volatile LAS float* sc = (volatile LAS float*)(lds + L_MISC); C.lam = sc[4]; C.M2d = sc[5]; }
    int tid = hy_tid(wid); asm volatile("" : "+v"(tid));
    const int lane = tid & 63, r32 = lane & 31, hi = lane >> 5;
    TMARK(tm_a);
    const int cm = wid >> 2, wq = wid & 3;
    const int q0 = qb * 128, qlo = q0 + wq * 32, qpos = qlo + r32;
    const bf16_t* Pb = C.PROJ + (size_t)b * T * LDP;
    const unsigned lds0 = (unsigned)(uintptr_t)lds;
    constexpr int SLOTB = 16384;
    const float slope2 = ldexpf(1.0f, -2 * (h + 1)) * LOG2E;
    int t0 = (int)floorf(((float)(q0 - 63) - 126.0f / slope2) * (1.0f / 64.0f)) + 1; t0 = t0 < 0 ? 0 : (t0 & ~1);
    t0 = __builtin_amdgcn_readfirstlane(t0);
    const int NT = (probe & 32) ? 2 : 2 * (qb + 1) - t0;
    constexpr int KHB = 8192, VHB = 2048;
    const bf16_t* kdma = Pb + (size_t)(4 * wid) * LDP + C_DK + h * 128;
    const bf16_t* vdma = Pb + (size_t)(4 * wid) * LDP + C_DV + h * 128;
    const unsigned kvo = (unsigned)((lane >> 4) * LDP + ((lane & 15) ^ (((lane >> 4) << 2) | (wid & 3))) * 8) * 2u;
    const unsigned vvo = (unsigned)((lane >> 4) * LDP + ((lane & 15) ^ ((lane >> 4) << 2)) * 8) * 2u;
#define DTOFF(i) ((size_t)(t0 + ((i) < NT ? (i) : NT - 1)) * (64 * LDP))
#define DMA_K(i, so) do { if (probe & 1) break; const bf16_t* s_ = kdma + DTOFF(i); const unsigned d_ = (unsigned)__builtin_amdgcn_readfirstlane((int)(lds0 + (so) + wid * 1024)); glds16s(kvo, s_, d_); glds16s(kvo, s_ + 32 * LDP, d_ + 8192u); } while (0)
#define DMA_V(i, so) do { if (probe & 1) break; const bf16_t* s_ = vdma + DTOFF(i); const unsigned d_ = (unsigned)__builtin_amdgcn_readfirstlane((int)(lds0 + D_VR + (so) + wid * 1024)); glds16s(vvo, s_, d_); glds16s(vvo, s_ + 32 * LDP, d_ + 8192u); } while (0)
#define DMA_P(base, vo, i, so, half) do { if (probe & 1) break; const bf16_t* s_ = (base) + DTOFF(i) + (half) * (32 * LDP); const unsigned d_ = (unsigned)__builtin_amdgcn_readfirstlane((int)(lds0 + (so) + wid * 1024 + (half) * 8192)); glds16s(vo, s_, d_); } while (0)
#define DWB(N) do { if (!(probe & 2)) WAIT_BAR(N); } while (0)
    DMA_K(0, 0); DMA_V(0, 0); DMA_K(1, SLOTB); DMA_K(2, 2 * SLOTB);
    if (cm == 0 && !(probe & 1)) {
        const bf16_t* zs = Pb + (size_t)(qlo + (lane >> 4)) * LDP + C_DZ + h * 128 + (lane & 15) * 8;
        const unsigned zd = (unsigned)__builtin_amdgcn_readfirstlane((int)(lds0 + L_ZT + wq * 8192));
#pragma unroll
        for (int i = 0; i < 8; ++i) glds16(zs + (size_t)(4 * i) * LDP, zd + i * 1024u);
    }
    bf16x8 qr[4];
    { const bf16_t* qp = Pb + (size_t)qpos * LDP + C_DQ + h * 128 + cm * 64 + hi * 8;
#pragma unroll
      for (int d0 = 0; d0 < 4; ++d0) qr[d0] = *(const bf16x8*)(qp + d0 * 16); }
    f32x16 o[4];
#pragma unroll
    for (int d0 = 0; d0 < 4; ++d0)
#pragma unroll
        for (int r = 0; r < 16; ++r) o[d0][r] = 0.f;
    float l_reg = 0.f;
    const lcp kp0 = (lcp)lds + r32 * 256 + (((cm << 3) | hi) ^ (((r32 & 3) << 2) | ((r32 >> 2) & 3))) * 16;
    const lcp vp0 = (lcp)lds + D_VR + (4 * hi + ((lane & 15) >> 2)) * 256 + (((lane & 12) | (((lane >> 4) & 1) << 1) | ((lane >> 1) & 1))) * 16 + (lane & 1) * 8;
    int sl_prev = 0, sl_cur = 0, sl_next = SLOTB;
#define ROT() do { sl_prev = sl_cur; sl_cur = sl_next; sl_next = (sl_next == 2 * SLOTB) ? 0 : sl_next + SLOTB; } while (0)
#define DC0(t) fmaf(slope2, (float)(64 * (t0 + (t)) + 4 * hi - qpos), -C.M2d)
#define DMASK(X0, X1, t) do { if (64 * (t0 + (t)) + 63 > qlo) mask_hi(X0, X1, 64 * (t0 + (t)) + 4 * hi, qpos); } while (0)
    f32x16 pA0, pA1, pB0, pB1; bf16x8 kf[8]; s16x4 vl0, vh0, vl1, vh1, vl2, vh2; u32x4 pw0, pw1, pw2, pw3;
    const unsigned himask = hi ? 0u : 0xffffffffu;
    u32x4 xa0, xa1, xb;
    xa0.x = dup_bf16_exact((float)r32) & himask; xa1.x = dup_bf16_exact((float)(32 + r32)) & himask;
    xa0.y = 0u; xa1.y = 0u; xa0.z = 0x3f803f80u & himask; xa1.z = xa0.z; xa0.w = 0x00003f80u & himask; xa1.w = xa0.w;
    xb.x = split2(slope2) & himask; xb.y = xb.x; xb.z = split2(-slope2 * (float)qpos - C.M2d) & himask; xb.w = 0u;
    f32x16 z16;
#pragma unroll
    for (int r = 0; r < 16; ++r) z16[r] = 0.f;
    DWB(0);
    TMARK(tm_b);
    { qk_simple<KHB>(pA0, pA1, kp0, qr, DC0(0)); DMASK(pA0, pA1, 0); exp_all<true>(pA0, pA1, slope2); }
    DWB(0);
    DMA_K(3, 0); DMA_V(1, SLOTB);
    ROT();
#pragma unroll
    for (int j = 0; j < 4; ++j) { const lcp a_ = lxor(kp0 + sl_cur, j << 5); kf[2 * j] = *(const LAS bf16x8*)a_; kf[2 * j + 1] = *(const LAS bf16x8*)(a_ + KHB); }
    DWB(4);
#ifndef HY_DSPREAD
#define HY_DSPREAD 1
#endif
#if HY_DSPREAD == 2
#define DSPREAD(k, t_, X) do { } while (0)
#define PA_HOOK0 do { DMA_P(kdma, kvo, tq_ + 3, sl_cur, 0); SBAR(); } while (0)
#define PA_HOOK1 do { DMA_P(vdma, vvo, tq_ + 1, D_VR + sl_next, 0); SBAR(); } while (0)
#define PA_HOOK2 do { DMA_P(kdma, kvo, tq_ + 3, sl_cur, 1); SBAR(); } while (0)
#define PA_HOOK3 do { DMA_P(vdma, vvo, tq_ + 1, D_VR + sl_next, 1); SBAR(); } while (0)
#elif HY_DSPREAD
#define DSPREAD(k, t_, X) do { X; SBAR(); } while (0)
#else
#define DSPREAD(k, t_, X) do { if ((k) == 0) { DMA_K((t_) + 3, sl_cur); DMA_V((t_) + 1, sl_next); } } while (0)
#endif
#ifndef PA_HOOK0
#define PA_HOOK0 do { } while (0)
#define PA_HOOK1 do { } while (0)
#define PA_HOOK2 do { } while (0)
#define PA_HOOK3 do { } while (0)
#endif
#define DSTEP(C0_, C1_, P0_, P1_, t) do { SBAR(); \
    const int tq_ = (t); \
    const lcp vp_ = vp0 + sl_prev; \
    { const unsigned tb_ = dup_bf16_exact((float)(64 * (t0 + (t)))) & himask; xa0.y = tb_; xa1.y = tb_; } \
    PHASE_A(C0_, C1_, P0_, P1_); \
    DSPREAD(0, t, DMA_P(kdma, kvo, (t) + 3, sl_cur, 0)); \
    DMASK(C0_, C1_, t); \
    SBAR(); \
    GAPB2(o[0] = MF32(PAF(0), VF(0), o[0]); VJ(2, 0, 1), C0_, 0); \
    GAPB2(o[1] = MF32(PAF(0), VF(1), o[1]); VJ(0, 1, 1), C0_, 2); \
    DSPREAD(1, t, DMA_P(vdma, vvo, (t) + 1, D_VR + sl_next, 0)); \
    KRD(0); GAPB2(o[0] = MF32(PAF(1), VF(2), o[0]); VJ(1, 0, 2), C0_, 4); \
    GAPB2(o[1] = MF32(PAF(1), VF(0), o[1]); VJ(2, 1, 2), C0_, 6); \
    DSPREAD(2, t, DMA_P(kdma, kvo, (t) + 3, sl_cur, 1)); \
    KRD(1); GAPB2(o[0] = MF32(PAF(2), VF(1), o[0]); VJ(0, 0, 3), C0_, 8); \
    GAPB2(o[1] = MF32(PAF(2), VF(2), o[1]); VJ(1, 1, 3), C0_, 10); \
    DSPREAD(3, t, DMA_P(vdma, vvo, (t) + 1, D_VR + sl_next, 1)); \
    KRD(2); GAPB2(o[0] = MF32(PAF(3), VF(0), o[0]); VJ(2, 2, 0), C0_, 12); \
    GAPB2(o[1] = MF32(PAF(3), VF(1), o[1]); VJ(0, 3, 0), C0_, 14); \
    KRD(3); GAPB2(o[2] = MF32(PAF(0), VF(2), o[2]); VJ(1, 2, 1), C1_, 0); \
    GAPB2(o[3] = MF32(PAF(0), VF(0), o[3]); VJ(2, 3, 1), C1_, 2); \
    GAPB2(o[2] = MF32(PAF(1), VF(1), o[2]); VJ(0, 2, 2), C1_, 4); \
    GAPB2(o[3] = MF32(PAF(1), VF(2), o[3]); VJ(1, 3, 2), C1_, 6); \
    GAPB2(o[2] = MF32(PAF(2), VF(0), o[2]); VJ(2, 2, 3), C1_, 8); \
    GAPB2(o[3] = MF32(PAF(2), VF(1), o[3]); VJ(0, 3, 3), C1_, 10); \
    GAPB2(o[2] = MF32(PAF(3), VF(2), o[2]), C1_, 12); \
    GAPB2(o[3] = MF32(PAF(3), VF(0), o[3]), C1_, 14); \
    } while (0)
    int t = 1;
    for (; t + 1 < NT; t += 2) {
        DSTEP(pB0, pB1, pA0, pA1, t);     DWB(4); ROT();
        DSTEP(pA0, pA1, pB0, pB1, t + 1); DWB(4); ROT();
    }
    DSTEP(pB0, pB1, pA0, pA1, t); DWB(0); ROT();
    l_reg += rowsum(pB0, pB1);
    pv_simple<4, VHB>(o, pB0, pB1, vp0 + sl_prev);
#undef DSTEP
#undef PA_HOOK0
#undef PA_HOOK1
#undef PA_HOOK2
#undef PA_HOOK3
#undef DSPREAD
#undef DMA_P
#undef DMA_K
#undef DMA_V
#undef DTOFF
#undef DC0
#undef DMASK
    DWB(0);
    TMARK(tm_c);
    l_reg += shx<32>(l_reg);
    LAS float* wsf = (LAS float*)(lds + L_WSF) + wid * 64;
    LAS float* xbuf = (LAS float*)lds + wq * 64 + lane;
    if (cm == 1) {
        if (hi == 0) wsf[r32] = l_reg;
#pragma unroll
        for (int d0 = 0; d0 < 4; ++d0)
#pragma unroll
            for (int r = 0; r < 16; ++r) xbuf[(d0 * 16 + r) * 256] = o[d0][r];
    }
    __syncthreads();
    if (cm == 0) {
        {
            const float l2 = ((const LAS float*)(lds + L_WSF))[(wid + 4) * 64 + r32];
            if (hi == 0) { wsf[r32] = C.lam * l_reg * __builtin_amdgcn_rcpf(l2); wsf[32 + r32] = EPS * l_reg * l_reg; }
            LDS_FENCE();
        }
        float ss[16];
#pragma unroll
        for (int r = 0; r < 16; ++r) ss[r] = 0.f;
#pragma unroll
        for (int r = 0; r < 16; ++r) {
            const float f = wsf[crow(r, hi)];
#pragma unroll
            for (int d0 = 0; d0 < 4; ++d0) { const float v = fmaf(-f, xbuf[(d0 * 16 + r) * 256], o[d0][r]); o[d0][r] = v; ss[r] = fmaf(v, v, ss[r]); }
        }
#pragma unroll
        for (int r = 0; r < 16; ++r) {
            const float s = red32(ss[r]);
            ss[r] = (1.0f - LAM_INIT) * __builtin_amdgcn_rsqf(fmaf(s, 1.f / 128.f, wsf[32 + crow(r, hi)]));
        }
        LAS bf16_t* zt = (LAS bf16_t*)(lds + L_ZT + wq * 8192);
#pragma unroll
        for (int d0 = 0; d0 < 4; ++d0) {
            const float gs = C.gsub[32 * d0 + r32];
#pragma unroll
            for (int r = 0; r < 16; ++r) {
                LAS bf16_t* zp = zt + crow(r, hi) * 128 + 32 * d0 + r32;
                const float v = (o[d0][r] * ss[r]) * gs * bf2f(*zp);
                *zp = (bf16_t)(cvtpk(v, v) & 0xffffu);
            }
        }
        LDS_FENCE();
        {
            bf16_t* orow = C.AOUT + ((size_t)b * T + qlo + (lane >> 4)) * D + h * 128 + (lane & 15) * 8;
#pragma unroll
            for (int j = 0; j < 8; ++j) { const u32x4 w = *(const LAS u32x4*)((lcp)zt + (4 * j + (lane >> 4)) * 256 + (lane & 15) * 16); *(u32x4*)(orow + (size_t)(4 * j) * D) = w; }
        }
    }
    __syncthreads();
    TMARK(tm_d); TACC(0, tm_b, tm_a); TACC(1, tm_c, tm_b); TACC(2, tm_d, tm_c);
#undef DWB
}

__device__ __forceinline__ void nsa_accum(f32x16 (&tot)[2], const f32x16 (&o)[2], float f, LAS float* wsf, int r32, int hi) {
    LDS_FENCE();
    if (hi == 0) wsf[r32] = f;
    LDS_FENCE();
#pragma unroll
    for (int r = 0; r < 16; ++r) { const float fr = wsf[crow(r, hi)]; tot[0][r] += o[0][r] * fr; tot[1][r] += o[1][r] * fr; }
}
__device__ __forceinline__ void nsa_accum_lds(LAS float* tp, const f32x16 (&o)[2], float f, LAS float* wsf, int r32, int hi) {
    LDS_FENCE();
    if (hi == 0) wsf[r32] = f;
    LDS_FENCE();
#pragma unroll
    for (int r = 0; r < 16; ++r) { const float fr = wsf[crow(r, hi)]; tp[r * 512] += o[0][r] * fr; tp[(16 + r) * 512] += o[1][r] * fr; }
}
__device__ __forceinline__ void nsa_unit(const AttnCtx& C0, int b, int kvh, int tb, ldsp lds, const int wid, const int prb = 0) {
    AttnCtx C = C0; if (prb) C.AOUT = (bf16_t*)((unsigned char*)C.AOUT - (WS_AOUT - WS_XN)); { volatile LAS float* sc = (volatile LAS float*)(lds + L_MISC); C.M2c = sc[6]; C.M2s = sc[7]; C.M2w = sc[8]; }
    int tid = hy_tid(wid); asm volatile("" : "+v"(tid));
    const int lane = tid & 63, r32 = lane & 31, hi = lane >> 5;
    TMARK(tm_a);
    const int g = wid >> 1, half = wid & 1, head = kvh * 4 + g;
    const int tokl = 32 * half + r32, qpos = tb * 64 + tokl;
    const bf16_t* Pb = C.PROJ + (size_t)b * T * LDP;
    const unsigned lds0 = (unsigned)(uintptr_t)lds;
    constexpr int SLOTB = 8192;
    const int j0w = tb >= 8 ? tb - 8 : 0;
    const int NT = (tb + 1) + (tb - j0w + 1);
#ifndef HY_NK_OLD
#define HY_NK_OLD 0
#endif
#ifndef HY_NV_OLD
#define HY_NV_OLD 0
#endif
    constexpr bool NKN = !(HY_NK_OLD), NVN = !(HY_NV_OLD);
    constexpr int KHB = NKN ? 4096 : 512, VHB = NVN ? 1024 : 512;
    const bf16_t* kdma = NKN ? Pb + (size_t)(8 * wid) * LDP + C_NKV + kvh * 64 : Pb + C_NKV + kvh * 64 + wid * 8;
    const bf16_t* vdma = NVN ? Pb + (size_t)(8 * wid) * LDP + C_NKV + kvh * 64 : Pb + (size_t)(16 * (wid & 3)) * LDP + C_NKV + kvh * 64 + (wid >> 2) * 32;
    const unsigned kvo = NKN ? (unsigned)((lane >> 3) * LDP + ((lane & 7) ^ (((lane >> 4) & 3) | (((wid >> 1) & 1) << 2))) * 8) * 2u : (unsigned)lane * (LDP * 2);
    const unsigned vvo = NVN ? (unsigned)((lane >> 3) * LDP + ((lane & 7) ^ (((lane >> 4) & 1) << 2)) * 8) * 2u : (unsigned)((lane >> 2) * LDP + (lane & 3) * 8) * 2u;
#undef VADDR
#undef KADDR
#define VADDR(dblk, ks) (NVN ? lxor(vp_, (dblk) << 6) + (ks) * 2048 : vp_ + ((dblk) * 4096 + (ks) * 1024))
#define KADDR(j) (NKN ? lxor(kp0 + sl_next, (j) << 5) : kp0 + sl_next + (j) * 2048)
#define NTOFF(i) ({ const int i_ = (i) < NT ? (i) : NT - 1; (i_ <= tb) ? (size_t)256 + (size_t)i_ * (64 * LDP) : (size_t)512 + (size_t)(j0w + i_ - tb - 1) * (64 * LDP); })
#define DMA_K(i, so) glds16s(kvo, kdma + NTOFF(i), (unsigned)__builtin_amdgcn_readfirstlane((int)(lds0 + (so) + wid * 1024)))
#define DMA_V(i, so) glds16s(vvo, vdma + NTOFF(i) + 128, (unsigned)__builtin_amdgcn_readfirstlane((int)(lds0 + N_VR + (so) + wid * 1024)))
    DMA_K(0, 0); DMA_V(0, 0); DMA_K(1, SLOTB); DMA_K(2, 2 * SLOTB);
    {
        const bf16_t* kc = C.KC + (size_t)((b * 2 + kvh) * 128) * 64 + (size_t)lane * 64 + wid * 8;
        const bf16_t* vc = C.VC + (size_t)((b * 2 + kvh) * 128) * 64 + (size_t)(16 * (wid & 3) + (lane >> 2)) * 64 + (wid >> 2) * 32 + (lane & 3) * 8;
        const unsigned d_ = (unsigned)__builtin_amdgcn_readfirstlane((int)(lds0 + N_CMP + wid * 1024));
        glds16(kc, d_); glds16(vc, d_ + 8192u); glds16(kc + 64 * 64, d_ + 16384u); glds16(vc + 64 * 64, d_ + 24576u);
    }
    {
        const bf16_t* zs = Pb + (size_t)(tb * 64 + 32 * half + (lane >> 3)) * LDP + C_NZ + head * 64 + (lane & 7) * 8;
        const unsigned zd = (unsigned)__builtin_amdgcn_readfirstlane((int)(lds0 + L_ZT + wid * 4096));
#pragma unroll
        for (int i = 0; i < 4; ++i) glds16(zs + (size_t)(8 * i) * LDP, zd + i * 1024u);
    }
    bf16x8 qr[4];
    { const bf16_t* qp = Pb + (size_t)qpos * LDP + C_NQ + head * 64 + hi * 8;
#pragma unroll
      for (int d0 = 0; d0 < 4; ++d0) qr[d0] = *(const bf16x8*)(qp + d0 * 16); }
    LAS float* wsf = (LAS float*)(lds + L_WSF) + wid * 64;
    const bf16_t* gatep = Pb + (size_t)qpos * LDP + C_NG + head;
    if (hi == 0) wsf[32 + r32] = bf2f(gatep[8]);
    const float slope2 = ldexpf(1.0f, -(head + 1)) * LOG2E;
    const lcp kp0 = NKN ? (lcp)lds + r32 * 128 + (hi ^ (((r32 >> 1) & 3) | (((r32 >> 4) & 1) << 2))) * 16 : (lcp)lds + hi * 1024 + r32 * 16;
    const lcp vp0 = NVN ? (lcp)lds + N_VR + (4 * hi + ((lane & 15) >> 2)) * 128 + ((((lane >> 3) & 1) << 2) | (((lane >> 4) & 1) << 1) | ((lane >> 1) & 1)) * 16 + (lane & 1) * 8
                        : (lcp)lds + N_VR + ((lane >> 4) & 1) * 32 + (lane & 3) * 8 + (4 * hi + ((lane & 15) >> 2)) * 64;
    f32x16 tot[2];
#pragma unroll
    for (int r = 0; r < 16; ++r) { tot[0][r] = 0.f; tot[1][r] = 0.f; }
    unsigned selmask;
    WAIT_BAR(0);
    TMARK(tm_b);
    {
        f32x16 o[2];
#pragma unroll
        for (int r = 0; r < 16; ++r) { o[0][r] = 0.f; o[1][r] = 0.f; }
        const int cmax = (qpos >= 31) ? ((qpos - 31) >> 4) : -1;
        const lcp kpc = (lcp)lds + N_CMP + hi * 1024 + r32 * 16;
        const lcp vpc = (lcp)lds + N_CMP + 8192 + ((lane >> 4) & 1) * 32 + (lane & 3) * 8 + (4 * hi + ((lane & 15) >> 2)) * 64;
        float Gs[16], Ts[16], l = 0.f;
#pragma unroll
        for (int tt = 0; tt < 2; ++tt) {
            f32x16 p0, p1;
            qk_simple(p0, p1, kpc + tt * 16384, qr, -C.M2c);
            mask_hi(p0, p1, 64 * tt + 4 * hi, cmax);
            exp_all<false>(p0, p1, 0.f);
            l += rowsum(p0, p1);
#pragma unroll
            for (int i = 0; i < 4; ++i) {
                Gs[tt * 8 + i] = (p0[4 * i] + p0[4 * i + 1]) + (p0[4 * i + 2] + p0[4 * i + 3]); Ts[tt * 8 + i] = p0[4 * i + 3];
                Gs[tt * 8 + 4 + i] = (p1[4 * i] + p1[4 * i + 1]) + (p1[4 * i + 2] + p1[4 * i + 3]); Ts[tt * 8 + 4 + i] = p1[4 * i + 3];
            }
            pv_simple<2>(o, p0, p1, vpc + tt * 16384);
        }
        l += shx<32>(l);
        const float invl = (l > 0.f) ? 1.0f / l : 0.f;
        LAS float* IB = (LAS float*)(lds + L_IB) + (g * 64 + tokl) * 33;
#pragma unroll
        for (int q = 0; q < 16; ++q) {
            const float recv = shx<32>(Ts[q]);
            if (hi == 1) Gs[q] += recv;
            else if (q + 1 < 16) Gs[q + 1] += recv;
        }
#pragma unroll
        for (int q = 0; q < 16; ++q) IB[2 * q + hi] = Gs[q];
        if (hi == 0) ((LAS float*)(lds + L_LB))[g * 64 + tokl] = invl;
        nsa_accum(tot, o, bf2f(gatep[0]) * invl, wsf, r32, hi);
    }
    WAIT_BAR(0);
    if (tb <= 7) selmask = (2u << tb) - 1u;
    else {
        float imp[32];
        const LAS float* I0 = (const LAS float*)(lds + L_IB) + tokl * 33;
        float il[4];
#pragma unroll
        for (int gg = 0; gg < 4; ++gg) il[gg] = ((const LAS float*)(lds + L_LB))[gg * 64 + tokl];
#pragma unroll
        for (int s = 0; s < 32; ++s) {
            float a = 0.f;
#pragma unroll
            for (int gg = 0; gg < 4; ++gg) a = fmaf(I0[gg * 64 * 33 + s], il[gg], a);
            imp[s] = a;
        }
        unsigned sel = 0u;
#pragma unroll 1
        for (int it = 0; it < 5; ++it) {
            float bv = -1.0f; int best = 0;
#pragma unroll
            for (int s = 1; s < 30; ++s) { const bool ok = (s <= tb - 2) && (((sel >> s) & 1u) == 0u) && (imp[s] > bv); if (ok) { bv = imp[s]; best = s; } }
            sel |= 1u << best;
        }
        selmask = (sel & ~1u) | 1u | (1u << (tb - 1)) | (1u << tb);
    }
    TMARK(tm_c);
    f32x16 o[2];
#pragma unroll
    for (int r = 0; r < 16; ++r) { o[0][r] = 0.f; o[1][r] = 0.f; }
    float l_reg = 0.f;
    int sl_prev = 0, sl_cur = 0, sl_next = SLOTB;
#define NJ(i) (((i) <= tb) ? (i) : j0w + (i) - tb - 1)
#define NC0(i) ({ const int j_ = NJ(i); float c_ = fmaf(slope2, (float)(64 * j_ + 4 * hi - qpos), ((i) <= tb) ? -C.M2s : -C.M2w); if ((i) <= tb && ((selmask >> j_) & 1u) == 0u) c_ = -INFINITY; c_; })
#define NMASK(X0, X1, i) do { const int j_ = NJ(i); if (j_ == tb) mask_hi(X0, X1, 64 * j_ + 4 * hi, qpos); else if ((i) > tb && j_ == tb - 8) mask_neg(X0, X1, 64 * j_ + 4 * hi, qpos - 511, qpos); } while (0)
    const int qw0 = tb * 64 + 32 * half;
    const int dthr = __builtin_amdgcn_readfirstlane((int)(126.0f / slope2) + 1);
#ifndef HY_NSA_LIGHT
#define HY_NSA_LIGHT 0
#endif
#define NDEAD(i) ((i) >= 0 && qw0 - 64 * NJ(i) - 63 > dthr)
#ifndef HY_NPROBE
#define HY_NPROBE 0
#endif
    int jd = qw0 - 63 - dthr; jd = jd > 0 ? (jd + 63) >> 6 : 0; jd = jd < tb ? jd : tb;
    if (prb && (wid < 4 || (HY_NPROBE) > 1)) jd = 1000;
    jd = __builtin_amdgcn_readfirstlane(jd);
    f32x16 pA0, pA1, pB0, pB1; bf16x8 kf[8]; s16x4 vl0, vh0, vl1, vh1, vl2, vh2; u32x4 pw0, pw1, pw2, pw3;
#pragma unroll
    for (int r = 0; r < 16; ++r) { pB0[r] = 0.f; pB1[r] = 0.f; }
    const unsigned himask = hi ? 0u : 0xffffffffu;
    u32x4 xa0, xa1, xb;
    xa0.x = dup_bf16_exact((float)r32) & himask; xa1.x = dup_bf16_exact((float)(32 + r32)) & himask;
    xa0.y = 0u; xa1.y = 0u; xa0.z = 0x3f803f80u & himask; xa1.z = xa0.z; xa0.w = 0x00003f80u & himask; xa1.w = xa0.w;
    xb.x = split2(slope2) & himask; xb.y = xb.x; xb.z = split2(-slope2 * (float)qpos - C.M2s) & himask; xb.w = 0u;
    f32x16 z16;
#pragma unroll
    for (int r = 0; r < 16; ++r) z16[r] = 0.f;
    { qk_simple<NKN ? 4096 : 0>(pA0, pA1, kp0, qr, NC0(0)); NMASK(pA0, pA1, 0); exp_all<true>(pA0, pA1, slope2); }
    WAIT_BAR(0);
    DMA_K(3, 0); DMA_V(1, SLOTB);
    LAS float* tp = (LAS float*)(lds + N_CMP) + tid;
#pragma unroll
    for (int r = 0; r < 16; ++r) { tp[r * 512] = tot[0][r]; tp[(16 + r) * 512] = tot[1][r]; }
    ROT();
#pragma unroll
    for (int j = 0; j < 4; ++j) { const lcp a_ = NKN ? lxor(kp0 + sl_cur, j << 5) : kp0 + sl_cur + j * 2048; kf[2 * j] = *(const LAS bf16x8*)a_; kf[2 * j + 1] = *(const LAS bf16x8*)(a_ + KHB); }
    WAIT_BAR(2);
#define NFLUSH(t) do { if ((t) == tb + 1) { float lt_ = l_reg + shx<32>(l_reg); const float gs_ = wsf[32 + r32]; \
        nsa_accum_lds(tp, o, gs_ / lt_, wsf, r32, hi); _Pragma("unroll") for (int r = 0; r < 16; ++r) { o[0][r] = 0.f; o[1][r] = 0.f; } l_reg = 0.f; } } while (0)
#ifndef HY_NSPREAD
#define HY_NSPREAD 0
#endif
#if HY_NSPREAD == 2
#define NSPREADK(X) do { } while (0)
#define NSPREAD0(X) do { } while (0)
#define NSPREAD1(X) do { } while (0)
#define PA_HOOK0 do { } while (0)
#define PA_HOOK1 do { DMA_K(tq_ + 3, sl_cur); SBAR(); } while (0)
#define PA_HOOK2 do { } while (0)
#define PA_HOOK3 do { DMA_V(tq_ + 1, sl_next); SBAR(); } while (0)
#elif HY_NSPREAD
#define NSPREAD0(X) do { } while (0)
#define NSPREAD1(X) do { X; SBAR(); } while (0)
#else
#define NSPREAD0(X) do { X; } while (0)
#define NSPREAD1(X) do { } while (0)
#endif
#ifndef NSPREADK
#define NSPREADK(X) do { X; } while (0)
#endif
#ifndef PA_HOOK0
#define PA_HOOK0 do { } while (0)
#define PA_HOOK1 do { } while (0)
#define PA_HOOK2 do { } while (0)
#define PA_HOOK3 do { } while (0)
#endif
#define NSTEP(C0_, C1_, P0_, P1_, t) do { SBAR(); \
    const int tq_ = (t); \
    const lcp vp_ = vp0 + sl_prev; \
    { const int j_ = NJ(t); const unsigned tb_ = dup_bf16_exact((float)(64 * j_)) & himask; xa0.y = tb_; xa1.y = tb_; \
      if ((t) <= tb) xb.w = (((selmask >> j_) & 1u) ? 0u : 0x0000c6eau) & himask; \
      else if ((t) == tb + 1) { xb.z = split2(-slope2 * (float)qpos - C.M2w) & himask; xb.w = 0u; } } \
    PHASE_A(C0_, C1_, P0_, P1_); \
    NSPREADK(DMA_K((t) + 3, sl_cur)); NSPREAD0(DMA_V((t) + 1, sl_next)); \
    NMASK(C0_, C1_, t); \
    SBAR(); \
    GAPB4(o[0] = MF32(PAF(0), VF(0), o[0]); VJ(2, 0, 1), C0_, 0); \
    GAPB4(o[1] = MF32(PAF(0), VF(1), o[1]); VJ(0, 1, 1), C0_, 4); \
    KRD(0); GAPB4(o[0] = MF32(PAF(1), VF(2), o[0]); VJ(1, 0, 2), C0_, 8); \
    NSPREAD1(DMA_V((t) + 1, sl_next)); \
    KRD(1); GAPB4(o[1] = MF32(PAF(1), VF(0), o[1]); VJ(2, 1, 2), C0_, 12); \
    KRD(2); GAPB4(o[0] = MF32(PAF(2), VF(1), o[0]); VJ(0, 0, 3), C1_, 0); \
    KRD(3); GAPB4(o[1] = MF32(PAF(2), VF(2), o[1]); VJ(1, 1, 3), C1_, 4); \
    GAPB4(o[0] = MF32(PAF(3), VF(0), o[0]), C1_, 8); \
    GAPB4(o[1] = MF32(PAF(3), VF(1), o[1]), C1_, 12); \
    NFLUSH(t); \
    } while (0)
    int t = 1;
#pragma unroll 1
    for (; t < jd && t < NT; ++t) { SBAR(); DMA_K(t + 3, sl_cur); DMA_V(t + 1, sl_next); KRD(0); KRD(1); KRD(2); KRD(3); WAIT_BAR(2); ROT(); }
    for (; t + 1 < NT; t += 2) {
        NSTEP(pB0, pB1, pA0, pA1, t);     WAIT_BAR(2); ROT();
        NSTEP(pA0, pA1, pB0, pB1, t + 1); WAIT_BAR(2); ROT();
    }
    if (t < NT) {
        NSTEP(pB0, pB1, pA0, pA1, t); WAIT_BAR(2); ROT();
        WAIT_BAR(0);
        l_reg += rowsum(pB0, pB1);
        pv_simple<2, NVN ? 1024 : 0>(o, pB0, pB1, vp0 + sl_prev);
    } else {
        WAIT_BAR(0);
        l_reg += rowsum(pA0, pA1);
        pv_simple<2, NVN ? 1024 : 0>(o, pA0, pA1, vp0 + sl_prev);
    }
#undef NSTEP
#undef PA_HOOK0
#undef PA_HOOK1
#undef PA_HOOK2
#undef PA_HOOK3
#undef NDEAD
#undef NFLUSH
#undef NMASK
#undef NC0
#undef NJ
#undef DMA_K
#undef DMA_V
#undef NTOFF
    TMARK(tm_d);
    {
        const float gw_ = bf2f(gatep[16]);
        const float lt_ = l_reg + shx<32>(l_reg);
        nsa_accum_lds(tp, o, gw_ / lt_, wsf, r32, hi);
    }
    {
        LAS bf16_t* zt = (LAS bf16_t*)(lds + L_ZT + wid * 4096);
#pragma unroll
        for (int d0 = 0; d0 < 2; ++d0)
#pragma unroll
            for (int r = 0; r < 16; ++r) {
                LAS bf16_t* zp = zt + crow(r, hi) * 64 + 32 * d0 + r32;
                const float v = tp[(d0 * 16 + r) * 512] * bf2f(*zp);
                *zp = (bf16_t)(cvtpk(v, v) & 0xffffu);
            }
        LDS_FENCE();
        bf16_t* orow = C.AOUT + ((size_t)b * T + tb * 64 + 32 * half + (lane >> 3)) * D + 512 + head * 64 + (lane & 7) * 8;
#pragma unroll
        for (int j = 0; j < 4; ++j) { const u32x4 w = *(const LAS u32x4*)((lcp)zt + (8 * j + (lane >> 3)) * 128 + (lane & 7) * 16); *(u32x4*)(orow + (size_t)(8 * j) * D) = w; }
    }
    asm volatile("s_waitcnt lgkmcnt(0)\n\ts_barrier" ::: "memory");
    TMARK(tm_e); TACC(3, tm_b, tm_a); TACC(4, tm_c, tm_b); TACC(5, tm_d, tm_c); TACC(6, tm_e, tm_d);
}
#undef ROT

__device__ __forceinline__ void attn_phase(const Args& A, ldsp lds, const int wave, int lane, const int qword = CW_QCTR) {
    const bool t0 = (wave == 0 && lane == 0);
    unsigned char* ws = A.ws;
    AttnCtx C;
    C.PROJ = (const bf16_t*)(ws + WS_PROJ); C.KC = (const bf16_t*)(ws + WS_KC); C.VC = (const bf16_t*)(ws + WS_VC); C.AOUT = (bf16_t*)(ws + WS_AOUT);
    C.gsub = A.in[9];
    {
        const float sa = wave_sum(A.in[5][lane] * A.in[6][lane]), sb = wave_sum(A.in[7][lane] * A.in[8][lane]);
        C.lam = expf(sa) - expf(sb) + LAM_INIT;
        const float mqd = wave_max(fabsf(A.in[3][lane])), mkd = wave_max(fabsf(A.in[4][lane])), mqn = wave_max(fabsf(A.in[10][lane]));
        const float mk0 = wave_max(fabsf(A.in[11][lane])), mk1 = wave_max(fabsf(A.in[11][64 + lane])), mk2 = wave_max(fabsf(A.in[11][128 + lane]));
        C.M2d = MCOEF * mqd * mkd; C.M2c = MCOEF * mqn * mk0; C.M2s = MCOEF * mqn * mk1; C.M2w = MCOEF * mqn * mk2;
        if (t0) { LAS float* sc = (LAS float*)(lds + L_MISC); sc[4] = C.lam; sc[5] = C.M2d; sc[6] = C.M2c; sc[7] = C.M2s; sc[8] = C.M2w; }
        C.lam = 0.f; C.M2d = 0.f; C.M2c = 0.f; C.M2s = 0.f; C.M2w = 0.f;
    }
#ifndef HY_QLEN
#define HY_QLEN 512
#define HY_QEXTRA_R 0
#endif
    unsigned* qctr = (unsigned*)(ws + WS_CTL) + qword;
    volatile LAS unsigned* bc = (volatile LAS unsigned*)(lds + L_MISC);
    const unsigned x0 = (unsigned)__builtin_amdgcn_s_getreg((3 << 11) | 20) & 7u;
    unsigned skip = 0u;
    for (;;) {
        if (t0) {
            unsigned found = 0xffffffffu;
            for (unsigned a = skip; a < 8u; ++a) {
                const unsigned x = (x0 + a) & 7u;
                const unsigned idx = atomicAdd(qctr + 64 * x, 1u);
                if (idx < (unsigned)HY_QLEN) { found = x * 1024u + idx; break; }
                skip = a + 1u;
            }
            bc[0] = found;
        }
        __syncthreads();
        const unsigned u = (unsigned)__builtin_amdgcn_readfirstlane((int)bc[0]);
        __syncthreads();
        if (u == 0xffffffffu) break;
        const int x = (int)(u >> 10); int idx = (int)(u & 1023u), b, r;
        if (idx < 256) { b = 4 * x + (idx >> 6); r = idx & 63; }
        else if (idx < 512) { b = 4 * x + ((idx - 256) >> 6); r = 64 + ((idx - 256) & 63); }
        else { idx -= 512; b = 4 * x + (idx >> 6); r = (idx & 63) + HY_QEXTRA_R; }
#ifndef HY_NO_DIFF
#ifndef HY_PROBE
#define HY_PROBE 0
#endif
        if (r < 64) { if ((HY_PROBE) != 0 && (u & 1023u) >= 512u) diff_unit<HY_PROBE>(C, b, r >> 4, 15 - (r & 15), lds, wave); else diff_unit<0>(C, b, r >> 4, 15 - (r & 15), lds, wave); }
#endif
#ifndef HY_NO_NSA
        if (r >= 64) nsa_unit(C, b, (r - 64) >> 5, 31 - ((r - 64) & 31), lds, wave, ((HY_NPROBE) != 0 && (u & 1023u) >= 512u) ? 1 : 0);
#endif
    }
}

#define XB_TMO      128
#define XB_XCNT(j)  (256  + 64 * (j))
#define XB_XSUB(j)  (1280 + 64 * (j))
#define XB_XGEN(j)  (2304 + 64 * (j))
#define XB_TOP      3328
#define XB_TOPGEN   3392
#define XCD_BAR_WORDS 3456
#define XB_SPIN_CAP (1u << 22)
__device__ __forceinline__ unsigned xb_ld(unsigned* p)              { return __hip_atomic_load(p, __ATOMIC_RELAXED, __HIP_MEMORY_SCOPE_AGENT); }
__device__ __forceinline__ unsigned xb_add(unsigned* p, unsigned v) { return __hip_atomic_fetch_add(p, v, __ATOMIC_RELAXED, __HIP_MEMORY_SCOPE_AGENT); }
__device__ __forceinline__ unsigned xb_xcc_id() { return (unsigned)__builtin_amdgcn_s_getreg((3 << 11) | 20) & 0xFu; }
#define XB_SPIN(cond, bar) do { unsigned _sp = 0; while (cond) { __builtin_amdgcn_s_sleep(1); \
    if ((++_sp & 255u) == 0u) { if (xb_ld(&(bar)[XB_TMO])) break; if (_sp > XB_SPIN_CAP) { atomicAdd(&(bar)[XB_TMO], 1u); break; } } } } while (0)
struct XcdBarrier { unsigned* bar; unsigned x; volatile LAS unsigned* st; };
__device__ __forceinline__ XcdBarrier xcd_barrier_post(unsigned* bar, volatile LAS unsigned* st, bool t0) {
    XcdBarrier b; b.bar = bar; b.x = xb_xcc_id(); b.st = st;
    if (t0) (void)xb_add(&bar[XB_XCNT(b.x)], 1u);
    return b;
}
__device__ __forceinline__ void xcd_barrier_complete(unsigned* bar, unsigned x, unsigned& nloc, unsigned& nx) {
    const unsigned G = gridDim.x * gridDim.y * gridDim.z;
    unsigned sum, cnt, mine, sp = 0u;
    for (;;) {
        sum = 0u; cnt = 0u; mine = 0u;
#pragma unroll
        for (unsigned j = 0; j < 16; ++j) { const unsigned c = xb_ld(&bar[XB_XCNT(j)]); sum += c; cnt += (c > 0u) ? 1u : 0u; mine = (j == x) ? c : mine; }
        if (sum == G) break;
        __builtin_amdgcn_s_sleep(1);
        if ((++sp & 255u) == 0u) { if (xb_ld(&bar[XB_TMO])) break; if (sp > XB_SPIN_CAP) { atomicAdd(&bar[XB_TMO], 1u); break; } }
    }
    nloc = mine > 0u ? mine : 1u; nx = cnt > 0u ? cnt : 1u;
}
__device__ __forceinline__ void xcd_barrier(const XcdBarrier& b, bool t0) {
    asm volatile("s_waitcnt vmcnt(0)" ::: "memory");
    __syncthreads();
    if (t0) {
        unsigned* bar = b.bar;
        __builtin_amdgcn_s_waitcnt(0);
        unsigned nloc = b.st[0], nx = b.st[1];
        if (nloc == 0u) { xcd_barrier_complete(bar, b.x, nloc, nx); b.st[0] = nloc; b.st[1] = nx; }
        const unsigned old = xb_add(&bar[XB_XSUB(b.x)], 1u);
        const unsigned gen = old / nloc;
        if (old + 1u == (gen + 1u) * nloc) {
            __builtin_amdgcn_fence(__ATOMIC_RELEASE, "agent");
            asm volatile("s_waitcnt vmcnt(0)" ::: "memory");
            const unsigned og = xb_add(&bar[XB_TOP], 1u);
            const unsigned tg = og / nx;
            if (og + 1u == (tg + 1u) * nx) xb_add(&bar[XB_TOPGEN], 1u);
            else XB_SPIN(xb_ld(&bar[XB_TOPGEN]) == tg, bar);
            __builtin_amdgcn_fence(__ATOMIC_ACQUIRE, "agent");
            xb_add(&bar[XB_XGEN(b.x)], 1u);
            asm volatile("s_waitcnt vmcnt(0)" ::: "memory");
        } else {
            XB_SPIN(xb_ld(&bar[XB_XGEN(b.x)]) == gen, bar);
            __builtin_amdgcn_fence(__ATOMIC_ACQUIRE, "agent");
            asm volatile("s_waitcnt vmcnt(0)" ::: "memory");
        }
    }
    __syncthreads();
}
constexpr int CW_BAR = 4096;

__global__ void __launch_bounds__(512, 2) hymba_fwd(Args args) {
    extern __shared__ __attribute__((aligned(16))) unsigned char lds_raw[];
    ldsp lds = (ldsp)lds_raw;
    const int wave = __builtin_amdgcn_readfirstlane((int)threadIdx.x >> 6);
    const int G = gridDim.x; const int bx = blockIdx.x; const int vcu = (G % 8 == 0) ? (bx % 8) * (G / 8) + bx / 8 : bx;
    unsigned char* ws = args.ws;
    const int lo = args.ph_lo, hi = args.ph_hi;
#ifndef HY_PHASE_MASK
#define HY_PHASE_MASK 31
#endif
#define IN(k) ((((HY_PHASE_MASK) >> (k)) & 1) && lo <= (k) && (k) < hi)
#if HY_N_LAUNCHES == 1
    const bool t0 = (wave == 0) && ((hy_tid(wave) & 63) == 0);
    { volatile LAS unsigned* st = (volatile LAS unsigned*)(lds + L_MISC + 64); if (t0) { st[0] = 0u; st[1] = 0u; } __syncthreads(); }
    const XcdBarrier bar = xcd_barrier_post((unsigned*)(ws + WS_CTL) + CW_BAR, (volatile LAS unsigned*)(lds + L_MISC + 64), t0);
#define SEAM(k) do { if (IN(k) && IN((k) + 1)) { xcd_barrier(bar, (wave == 0) && ((hy_tid(wave) & 63) == 0)); } } while (0)
#else
#define SEAM(k) do { } while (0)
#endif
#ifdef HY_TSEL
    if (wave == 0 && (hy_tid(wave) & 63) < 16) ((volatile LAS unsigned*)(lds + L_MISC + 128))[hy_tid(wave) & 63] = 0u;
    __syncthreads();
#endif
#ifdef HY_TS_PHASE
    unsigned long long ts_[6]; ts_[0] = __builtin_amdgcn_s_memrealtime();
#define TS(k) do { ts_[k] = __builtin_amdgcn_s_memrealtime(); } while (0)
#else
#define TS(k) do { } while (0)
#endif
#ifndef HY_DUP_PHASE
#define HY_DUP_PHASE -1
#endif
#if HY_DUP_PHASE >= 0
#define DUP(k) for (int rep_ = 0; rep_ < __builtin_amdgcn_readfirstlane((HY_DUP_PHASE) == (k) ? 2 : 1); rep_ = __builtin_amdgcn_readfirstlane(rep_ + 1))
#else
#define DUP(k) for (int rep_ = 0, once_ = 1; once_; once_ = 0)
#endif
    if (IN(0)) DUP(0) { p0_prologue(args, lds, vcu, G, wave, hy_tid(wave) & 63); }
    SEAM(0); TS(1);
    if (IN(1)) DUP(1) {
        pg8::Gemm g{(const bf16_t*)(ws + WS_XN), (const bf16_t*)(ws + WS_WIN), M, NPAD, D}; pg8::StaticOrder S; S.init(M, NPAD, G, bx);
        EpiIn E{(bf16_t*)(ws + WS_PROJ), args.in[3], args.in[4], args.in[10], args.in[11]};
        pg8::gemm_phase<EpiIn, pg8::StaticOrder, true, true>((PG8_LAS unsigned char*)lds, g, S, E, wave);
    }
    SEAM(1); TS(2);
    if (IN(2)) DUP(2) { compress_phase(args, lds, wave, hy_tid(wave) & 63); }
    SEAM(2); TS(3);
#ifdef HY_TSEL
    const unsigned tp3a_ = (unsigned)__builtin_amdgcn_s_memrealtime();
#endif
    if (IN(3)) DUP(3) { attn_phase(args, lds, wave, hy_tid(wave) & 63, CW_QCTR + 512 * rep_); }
#ifdef HY_TSEL
    const unsigned tp3b_ = (unsigned)__builtin_amdgcn_s_memrealtime();
#endif
    SEAM(3); TS(4);
    if (IN(4)) DUP(4) {
        pg8::Gemm g{(const bf16_t*)(ws + WS_AOUT), (const bf16_t*)(ws + WS_WOUT), M, D, D}; pg8::StaticOrder S; S.init(M, D, G, bx);
        EpiOut E{args.in[0], args.out};
        pg8::gemm_phase<EpiOut, pg8::StaticOrder, true, true>((PG8_LAS unsigned char*)lds, g, S, E, wave);
    }
#ifdef HY_TS_PHASE
    xcd_barrier(bar, (wave == 0) && ((hy_tid(wave) & 63) == 0)); TS(5);
    if (bx == 0) { float v = (float)(ts_[HY_TS_PHASE + 1] - ts_[HY_TS_PHASE]) * 0.01f; v = exp2f(floorf(log2f(v) * 12.f + 0.5f) / 12.f);
        const int t = hy_tid(wave);
        for (size_t i = t; i < (size_t)M * D / 4; i += 512) ((f32x4*)args.out)[i] = (f32x4){v, v, v, v}; }
#endif
#ifdef HY_TSEL
    xcd_barrier(bar, (wave == 0) && ((hy_tid(wave) & 63) == 0));
    if (bx == 0) { volatile LAS unsigned* tmv = (volatile LAS unsigned*)(lds + L_MISC + 128);
        const float tot_ = (float)(tp3b_ - tp3a_); const float x_ = (HY_TSEL) == 7 ? tot_ * 0.01f / 50.f   : 20.f * (float)tmv[HY_TSEL] / tot_;
        const float v = 100.f * (10.f + floorf(x_)); const int t = hy_tid(wave);
        for (size_t i = t; i < (size_t)M * D / 4; i += 512) ((f32x4*)args.out)[i] = (f32x4){v, v, v, v}; }
#endif
#undef IN
#undef SEAM
}
}

extern "C" void kernel_launch(void* const* d_in, const int* in_sizes, int n_in, void* d_out, int out_size, void* d_ws, size_t ws_size, hipStream_t stream) {
    using namespace hy;
    static int grid = 0;
    if (grid == 0) {
        if (n_in != 17 || in_sizes[0] != M * D || out_size != M * D || ws_size < WS_END) {
            fprintf(stderr, "kernel_launch: unexpected shapes (n_in %d, in0 %d, out %d, ws %zu)\n", n_in, n_in > 0 ? in_sizes[0] : -1, out_size, ws_size); grid = -1; return; }
        { const int want[17] = {M * D, D, D * NIN, 64, 64, 64, 64, 64, 64, 128, 64, 192, 2 * 32 * 64, 2 * 2048 * 256, 2 * 256, 2 * 256 * 64, D * D};
          for (int i = 0; i < 17; ++i) if (in_sizes[i] != want[i]) { fprintf(stderr, "kernel_launch: input %d has %d elements, expected %d\n", i, in_sizes[i], want[i]); grid = -1; return; } }
        int dev = 0, cus = 0, per_cu = 0;
        if (hipGetDevice(&dev) != hipSuccess || hipDeviceGetAttribute(&cus, hipDeviceAttributeMultiprocessorCount, dev) != hipSuccess) { grid = -1; return; }
        if (hipFuncSetAttribute((const void*)hymba_fwd, hipFuncAttributeMaxDynamicSharedMemorySize, LDS_BYTES) != hipSuccess) { fprintf(stderr, "kernel_launch: hipFuncSetAttribute failed\n"); grid = -1; return; }
        if (hipOccupancyMaxActiveBlocksPerMultiprocessor(&per_cu, (const void*)hymba_fwd, 512, LDS_BYTES) != hipSuccess || per_cu < 1) { fprintf(stderr, "kernel_launch: occupancy query says %d blocks per CU\n", per_cu); grid = -1; return; }
        (void)hipGetLastError();
        grid = cus * 1;
    }
    if (grid < 0) return;
    (void)hipMemsetAsync((char*)d_ws + WS_CTL, 0, CTL_BYTES, stream);
    Args a{};
    for (int i = 0; i < 17; ++i) a.in[i] = (const float*)d_in[i];
    a.out = (float*)d_out; a.ws = (unsigned char*)d_ws;
#if HY_N_LAUNCHES == 1
    a.ph_lo = 0; a.ph_hi = 5;
    void* kargs[] = {&a};
    hipError_t e = hipLaunchCooperativeKernel((const void*)hymba_fwd, dim3(grid), dim3(512), kargs, LDS_BYTES, stream);
    if (e != hipSuccess) fprintf(stderr, "kernel_launch: cooperative launch failed: %s (grid %d)\n", hipGetErrorString(e), grid);
#else
    for (int p = 0; p < 5; ++p) { a.ph_lo = p; a.ph_hi = p + 1; hipLaunchKernelGGL(hymba_fwd, dim3(grid), dim3(512), LDS_BYTES, stream, a); }
#endif
}
```

```cpp
#include <hip/hip_runtime.h>
#include <cstdio>
#include <cstdint>
#include <cmath>
#define HY_N_LAUNCHES 1
namespace pg8 {
#define PG8_LAS __attribute__((address_space(3)))
typedef unsigned short bf16_t;
typedef short bf16x8 __attribute__((ext_vector_type(8)));
typedef float f32x4 __attribute__((ext_vector_type(4)));
typedef unsigned u32x4 __attribute__((ext_vector_type(4)));
constexpr int BM = 256, BK = 64, HALF = 128, HTB = HALF * BK * 2  , STAGE_BYTES = 8 * HTB, NXCD = 8, WGM = 8;

__host__ __device__ __forceinline__ int lds_byte(int r, int c) { const int st = (r >> 4) * 2 + (c >> 5), rr = r & 15, cc = c & 31, ob = rr * 64 + cc * 2; return st * 1024 + (ob ^ (((ob >> 9) & 1) << 5)); }
__host__ __device__ __forceinline__ void stage_rc(int b, int& R, int& C) { const int st = b / 1024, sb = b % 1024, swz = sb ^ (((sb >> 9) & 1) << 5); R = (st >> 1) * 16 + swz / 64; C = (st & 1) * 32 + (swz % 64) / 2; }
__host__ __device__ __forceinline__ int perm32(int rho) { const int n = rho >> 4, i = rho & 15; return 8 * (i >> 2) + 4 * n + (i & 3); }

struct Unit { int pm, pn; };
struct Gemm { const bf16_t* A; const bf16_t* Bt; int M, N, K; };

struct StaticOrder {
    int nM, nN, nwg, G, c;
    __host__ __device__ void init(int M, int N, int G_, int c_) { nM = M / BM; nN = N / BM; nwg = nM * nN; G = G_; c = c_; }
    __host__ __device__ bool next(int i, Unit& u) const {
        const long L = (long)i * G + c; if (L >= nwg) return false;
        int wgid = (int)L; { const int q = nwg / NXCD, r = nwg % NXCD, xcd = wgid % NXCD, off = wgid / NXCD; wgid = (xcd < r ? xcd * (q + 1) : r * (q + 1) + (xcd - r) * q) + off; }
        const int nig = WGM * nN, gid = wgid / nig, fm = gid * WGM, gsz = (nM - fm) < WGM ? (nM - fm) : WGM;
        u.pm = fm + ((wgid % nig) % gsz); u.pn = (wgid % nig) / gsz; return true;
    }
    __device__ __forceinline__ void a_ready(const Unit&) const {}
    __device__ __forceinline__ void done(const Unit&) const {}
};

template <class Epi, class Sched, bool ALIGN_EPI = false, bool SP2 = false>
__device__ __forceinline__ void gemm_phase(PG8_LAS unsigned char* lds, const Gemm g, const Sched& S, const Epi& E, const int wid) {
    unsigned z_; asm volatile("v_mov_b32 %0, 0" : "=v"(z_));
    const int tid = wid * 64 + (int)__builtin_amdgcn_mbcnt_hi(~0u, __builtin_amdgcn_mbcnt_lo(~0u, z_)), lane = tid & 63, wr = wid >> 2, wc = wid & 3, fr = lane & 15, fq = lane >> 4;
    const int K = g.K, nt = K / BK;
    unsigned voffA[2], voffB[2];
#pragma unroll
    for (int i = 0; i < 2; ++i) { int R, C; stage_rc(tid * 16 + i * 8192, R, C); const int Rb = Epi::PERM ? ((R & ~31) + perm32(R & 31)) : R;
        voffA[i] = (unsigned)(R * K + C) * 2u; voffB[i] = (unsigned)(Rb * K + C) * 2u; }
    const size_t kstep = (size_t)(BK * 2);
    const size_t hstep = (size_t)HALF * K * 2;
    const size_t tstep = 2 * hstep;
    const unsigned ldsw = (unsigned)wid * 1024u;
    const int aoff = lds_byte(wr * 64 + fr, fq * 8), boff = lds_byte(wc * 32 + fr, fq * 8);
#define PG8_SA(b, h) (((b) * 2 + (h)) * HTB)
#define PG8_SB(b, h) ((4 + (b) * 2 + (h)) * HTB)
#define PG8_STAGE(bufoff, gbase, voff) do { _Pragma("unroll") for (int _i = 0; _i < 2; ++_i) \
        __builtin_amdgcn_global_load_lds((const unsigned*)((const char*)(gbase) + (voff)[_i]), (PG8_LAS unsigned*)(lds + (bufoff) + ldsw + _i * 8192), 16, 0, 0); } while (0)
#define PG8_LDA(dst, b, h) do { _Pragma("unroll") for (int m = 0; m < 4; ++m) _Pragma("unroll") for (int k = 0; k < 2; ++k) dst[m][k] = *(const PG8_LAS bf16x8*)(lds + PG8_SA(b, h) + aoff + m * 2048 + k * 1024); } while (0)
#define PG8_LDB(dst, b, h) do { _Pragma("unroll") for (int n = 0; n < 2; ++n) _Pragma("unroll") for (int k = 0; k < 2; ++k) dst[n][k] = *(const PG8_LAS bf16x8*)(lds + PG8_SB(b, h) + boff + n * 2048 + k * 1024); } while (0)
#define PG8_MMA(ai, bj, At, Bt) do { __builtin_amdgcn_s_setprio(1); _Pragma("unroll") for (int m = 0; m < 4; ++m) _Pragma("unroll") for (int n = 0; n < 2; ++n) _Pragma("unroll") for (int k = 0; k < 2; ++k) \
        acc[ai][bj][m][n] = __builtin_amdgcn_mfma_f32_16x16x32_bf16(Bt[n][k], At[m][k], acc[ai][bj][m][n], 0, 0, 0); __builtin_amdgcn_s_setprio(0); } while (0)
#define PG8_WAIT_V(n) asm volatile("s_waitcnt vmcnt(" #n ")" ::: "memory")
#define PG8_WAIT_L(n) asm volatile("s_waitcnt lgkmcnt(" #n ")" ::: "memory")
#define PG8_BAR __builtin_amdgcn_s_barrier()
#define PG8_SCHED __builtin_amdgcn_sched_barrier(0)
    Unit cur, nxt; int ui = 0;
    if (!S.next(0, cur)) return;
    f32x4 acc[2][2][4][2];
#pragma unroll
    for (int a = 0; a < 2; ++a)
#pragma unroll
        for (int b = 0; b < 2; ++b)
#pragma unroll
            for (int m = 0; m < 4; ++m)
#pragma unroll
                for (int n = 0; n < 2; ++n) acc[a][b][m][n] = (f32x4){0.f, 0.f, 0.f, 0.f};
    bf16x8 At[4][2], B0[2][2], B1[2][2];
    const char* cA = (const char*)g.A + (size_t)cur.pm * tstep; const char* cB = (const char*)g.Bt + (size_t)cur.pn * tstep;
    S.a_ready(cur);
    if constexpr (SP2) {
        PG8_STAGE(PG8_SB(0, 0), cB, voffB); PG8_STAGE(PG8_SB(0, 1), cB + hstep, voffB); PG8_STAGE(PG8_SA(0, 0), cA, voffA); PG8_STAGE(PG8_SA(0, 1), cA + hstep, voffA);
        if (wr == 1) PG8_BAR;
        PG8_WAIT_V(2); PG8_BAR;
        PG8_STAGE(PG8_SB(1, 0), cB + kstep, voffB); PG8_STAGE(PG8_SA(1, 0), cA + kstep, voffA); PG8_STAGE(PG8_SB(1, 1), cB + hstep + kstep, voffB);
        PG8_WAIT_V(6); PG8_BAR;
    } else {
        PG8_STAGE(PG8_SB(0, 0), cB, voffB); PG8_STAGE(PG8_SA(0, 0), cA, voffA); PG8_STAGE(PG8_SB(0, 1), cB + hstep, voffB); PG8_STAGE(PG8_SA(0, 1), cA + hstep, voffA);
        if (wr == 1) PG8_BAR;
        PG8_WAIT_V(4); PG8_BAR;
        PG8_STAGE(PG8_SB(1, 0), cB + kstep, voffB); PG8_STAGE(PG8_SA(1, 0), cA + kstep, voffA); PG8_STAGE(PG8_SB(1, 1), cB + hstep + kstep, voffB);
        PG8_WAIT_V(6); PG8_BAR;
    }
    for (;;) {
        const bool has_next = S.next(ui + 1, nxt);
        const char* nA = has_next ? (const char*)g.A + (size_t)nxt.pm * tstep : cA; const char* nB = has_next ? (const char*)g.Bt + (size_t)nxt.pn * tstep : cB;
        for (int t = 0; t < nt; t += 2) {
            const bool last = (t == nt - 2);
            const char* a1 = cA + (size_t)(t + 1) * kstep;
            const char* a2 = last ? nA : cA + (size_t)(t + 2) * kstep; const char* b2 = last ? nB : cB + (size_t)(t + 2) * kstep;
            const char* a3 = a2 + kstep; const char* b3 = b2 + kstep;
            if (last && has_next) S.a_ready(nxt);
            if constexpr (SP2) {
            PG8_LDB(B0, 0, 0); PG8_LDB(B1, 0, 1); PG8_SCHED; PG8_LDA(At, 0, 0); PG8_STAGE(PG8_SA(1, 1), a1 + hstep, voffA);
            PG8_WAIT_V(8); PG8_WAIT_L(0); PG8_BAR; PG8_MMA(0, 0, At, B0); PG8_MMA(0, 1, At, B1); PG8_BAR; PG8_SCHED;
            PG8_LDA(At, 0, 1); PG8_STAGE(PG8_SB(0, 0), b2, voffB); PG8_STAGE(PG8_SB(0, 1), b2 + hstep, voffB); PG8_STAGE(PG8_SA(0, 0), a2, voffA);
            PG8_WAIT_V(8); PG8_WAIT_L(0); PG8_BAR; PG8_MMA(1, 0, At, B0); PG8_MMA(1, 1, At, B1); PG8_BAR; PG8_SCHED;
            PG8_LDB(B0, 1, 0); PG8_LDB(B1, 1, 1); PG8_SCHED; PG8_LDA(At, 1, 0); PG8_STAGE(PG8_SA(0, 1), a2 + hstep, voffA);
            PG8_WAIT_V(8); PG8_WAIT_L(0); PG8_BAR; PG8_MMA(0, 0, At, B0); PG8_MMA(0, 1, At, B1); PG8_BAR; PG8_SCHED;
            PG8_LDA(At, 1, 1); PG8_STAGE(PG8_SB(1, 0), b3, voffB); PG8_STAGE(PG8_SB(1, 1), b3 + hstep, voffB); PG8_STAGE(PG8_SA(1, 0), a3, voffA);
            PG8_WAIT_V(8); PG8_WAIT_L(0); PG8_BAR; PG8_MMA(1, 0, At, B0); PG8_MMA(1, 1, At, B1); PG8_BAR; PG8_SCHED;
            } else {
            PG8_LDB(B0, 0, 0); PG8_SCHED; PG8_LDA(At, 0, 0); PG8_STAGE(PG8_SA(1, 1), a1 + hstep, voffA);
            PG8_WAIT_L(8); PG8_BAR; PG8_WAIT_L(0); PG8_MMA(0, 0, At, B0); PG8_BAR; PG8_SCHED;
            PG8_LDB(B1, 0, 1); PG8_STAGE(PG8_SB(0, 0), b2, voffB);
            PG8_BAR; PG8_WAIT_L(0); PG8_MMA(0, 1, At, B1); PG8_BAR;
            PG8_LDA(At, 0, 1); PG8_STAGE(PG8_SA(0, 0), a2, voffA);
            PG8_BAR; PG8_WAIT_L(0); PG8_MMA(1, 0, At, B0); PG8_BAR; PG8_SCHED;
            PG8_STAGE(PG8_SB(0, 1), b2 + hstep, voffB);
            PG8_WAIT_V(6); PG8_BAR; PG8_MMA(1, 1, At, B1); PG8_BAR;
            PG8_LDB(B0, 1, 0); PG8_SCHED; PG8_LDA(At, 1, 0); PG8_STAGE(PG8_SA(0, 1), a2 + hstep, voffA);
            PG8_WAIT_L(8); PG8_BAR; PG8_WAIT_L(0); PG8_MMA(0, 0, At, B0); PG8_BAR; PG8_SCHED;
            PG8_LDB(B1, 1, 1); PG8_STAGE(PG8_SB(1, 0), b3, voffB);
            PG8_BAR; PG8_WAIT_L(0); PG8_MMA(0, 1, At, B1); PG8_BAR;
            PG8_LDA(At, 1, 1); PG8_STAGE(PG8_SA(1, 0), a3, voffA);
            PG8_BAR; PG8_WAIT_L(0); PG8_MMA(1, 0, At, B0); PG8_BAR; PG8_SCHED;
            PG8_STAGE(PG8_SB(1, 1), b3 + hstep, voffB);
            PG8_WAIT_V(6); PG8_BAR; PG8_MMA(1, 1, At, B1); PG8_BAR;
            }
        }
        if constexpr (ALIGN_EPI) { if (wr == 0) PG8_BAR; }
        if constexpr (!Epi::AFTER_DRAIN) { E(acc, cur, wr, wc, fr, fq); S.done(cur); }
        if (!has_next) break;
#pragma unroll
        for (int a = 0; a < 2; ++a)
#pragma unroll
            for (int b = 0; b < 2; ++b)
#pragma unroll
                for (int m = 0; m < 4; ++m)
#pragma unroll
                    for (int n = 0; n < 2; ++n) acc[a][b][m][n] = (f32x4){0.f, 0.f, 0.f, 0.f};
        cur = nxt; cA = nA; cB = nB; ++ui;
        if constexpr (ALIGN_EPI) { if (wr == 1) PG8_BAR; }
    }
    PG8_WAIT_V(0);
    if constexpr (!ALIGN_EPI) { if (wr == 0) PG8_BAR; }
    PG8_BAR;
    if constexpr (Epi::AFTER_DRAIN) { E.fused(acc, cur, wr, wc, fr, fq, lds, wid, lane); S.done(cur); }
#undef PG8_SA
#undef PG8_SB
#undef PG8_STAGE
#undef PG8_LDA
#undef PG8_LDB
#undef PG8_MMA
#undef PG8_WAIT_V
#undef PG8_WAIT_L
#undef PG8_BAR
#undef PG8_SCHED
}
}

#ifndef HY_P4_ALIGN
#define HY_P4_ALIGN true
#endif
#ifndef HY_N_LAUNCHES
#define HY_N_LAUNCHES 5
#endif

namespace hy {
#define LAS __attribute__((address_space(3)))
typedef unsigned short bf16_t;
typedef short bf16x8 __attribute__((ext_vector_type(8)));
typedef short s16x4 __attribute__((ext_vector_type(4)));
typedef float f32x4 __attribute__((ext_vector_type(4)));
typedef float f32x16 __attribute__((ext_vector_type(16)));
typedef unsigned u32x4 __attribute__((ext_vector_type(4)));
typedef unsigned u32x2 __attribute__((ext_vector_type(2)));
typedef LAS unsigned char* ldsp;

constexpr int BATCH = 32, T = 2048, D = 1024, M = BATCH * T;
constexpr int NIN = 3864, NPAD = 4096, LDP = 3904;
constexpr int C_DQ = 0, C_DK = 512, C_DV = 1024, C_DZ = 1536, C_NQ = 2048, C_NKV = 2560, C_NZ = 3328, C_NG = 3840;
constexpr float EPS = 1e-6f;
constexpr float LOG2E = 1.4426950408889634f;
constexpr float QSCALE = 0.125f * LOG2E;
constexpr float MCOEF = QSCALE * 64.0f;
constexpr float LAM_INIT = 0.2f;

constexpr size_t MiB = 1u << 20;
constexpr size_t WS_CTL = 0, CTL_BYTES = 1 * MiB;
constexpr size_t WS_WIN = 2 * MiB;
constexpr size_t WS_WOUT = 12 * MiB;
constexpr size_t WS_W1T = 14 * MiB;
constexpr size_t WS_W2T = 16 * MiB;
constexpr size_t WS_B1P = 16 * MiB + 256 * 1024;
constexpr size_t WS_KC = 17 * MiB;
constexpr size_t WS_VC = 18 * MiB;
constexpr size_t WS_XN = 32 * MiB;
constexpr size_t WS_AOUT = 160 * MiB;
constexpr size_t WS_PROJ = 288 * MiB;
constexpr size_t WS_END = 776 * MiB;
constexpr int CW_QCTR = 64;

constexpr int LDS_BYTES = 163840;
constexpr int L_IB = 81920, L_LB = L_IB + 33792, L_WSF = L_LB + 1024, L_ZT = L_WSF + 2048, L_MISC = 163328;
static_assert(L_ZT + 32768 + 6144 <= L_MISC && L_MISC + 256 <= LDS_BYTES, "LDS map");

struct Args { const float* in[17]; float* out; unsigned char* ws; int ph_lo, ph_hi; };

#define LOG2E_F 1.4426950408889634f
#define LDS_FENCE() do { asm volatile("s_waitcnt lgkmcnt(0)" ::: "memory"); __builtin_amdgcn_wave_barrier(); } while (0)

__device__ __forceinline__ unsigned cvtpk(float lo, float hi) {
    typedef float f2_t __attribute__((ext_vector_type(2))); typedef __bf16 b2_t __attribute__((ext_vector_type(2)));
    f2_t v = {lo, hi}; b2_t b = __builtin_convertvector(v, b2_t); return __builtin_bit_cast(unsigned, b);
}
__device__ __forceinline__ int hy_tid(int wave) { unsigned z; asm volatile("v_mov_b32 %0, 0" : "=v"(z)); return wave * 64 + (int)__builtin_amdgcn_mbcnt_hi(~0u, __builtin_amdgcn_mbcnt_lo(~0u, z)); }
__device__ __forceinline__ float bf2f(unsigned short u) { return __builtin_bit_cast(float, (unsigned)u << 16); }
template <int K> __device__ __forceinline__ float shx(float v) {
    if constexpr (K == 32) {
        const unsigned u = __builtin_bit_cast(unsigned, v); auto rr = __builtin_amdgcn_permlane32_swap(u, u, false, false);
        return __builtin_bit_cast(float, rr[0] ^ rr[1] ^ u);
    } else return __builtin_bit_cast(float, __builtin_amdgcn_ds_swizzle(__builtin_bit_cast(int, v), (K << 10) | 0x1f));
}
template <int CTRL> __device__ __forceinline__ float dppf(float v) { return __builtin_bit_cast(float, __builtin_amdgcn_update_dpp(0, __builtin_bit_cast(int, v), CTRL, 0xf, 0xf, true)); }
__device__ __forceinline__ float red32(float v) {
    v += dppf<0xB1>(v); v += dppf<0x4E>(v); v += dppf<0x141>(v); v += dppf<0x140>(v); v += shx<16>(v);
    return v;
}
__device__ __forceinline__ float wave_sum(float v) {
    v += shx<1>(v); v += shx<2>(v); v += shx<4>(v); v += shx<8>(v); v += shx<16>(v); v += shx<32>(v);
    return v;
}
__device__ __forceinline__ float wave_max(float v) {
    v = fmaxf(v, shx<1>(v)); v = fmaxf(v, shx<2>(v)); v = fmaxf(v, shx<4>(v)); v = fmaxf(v, shx<8>(v)); v = fmaxf(v, shx<16>(v)); v = fmaxf(v, shx<32>(v));
    return v;
}
__device__ __forceinline__ float sigmf(float v) { return __builtin_amdgcn_rcpf(1.0f + __builtin_amdgcn_exp2f(-LOG2E_F * v)); }
__device__ __forceinline__ float siluf(float v) { return v * sigmf(v); }

__device__ __forceinline__ void transpose_item(const float* W, int ldw, int ncols, int n0, int k0, bf16_t* WT, int K, int p0, LAS float* scr, int lane) {
#pragma unroll 8
    for (int i = 0; i < 32; ++i) {
        const int kk = 2 * i + (lane >> 5), nn = lane & 31, n = n0 + nn;
#ifdef HY_T_NOLOAD
        scr[kk * 33 + nn] = (float)n;
#else
        scr[kk * 33 + nn] = (n < ncols) ? W[(size_t)(k0 + kk) * ldw + n] : 0.f;
#endif
    }
    LDS_FENCE();
    const int c = lane & 7;
#pragma unroll
    for (int j = 0; j < 4; ++j) {
        const int n = (lane >> 3) + 8 * j; const LAS float* s = scr + (8 * c) * 33 + n;
        u32x4 o; o.x = cvtpk(s[0 * 33], s[1 * 33]); o.y = cvtpk(s[2 * 33], s[3 * 33]); o.z = cvtpk(s[4 * 33], s[5 * 33]); o.w = cvtpk(s[6 * 33], s[7 * 33]);
#ifdef HY_T_NOSTORE
        if (o.x == 0x12345678u) *(u32x4*)(WT) = o;
#else
        *(u32x4*)(WT + (size_t)(p0 + n) * K + k0 + 8 * c) = o;
#endif
    }
    LDS_FENCE();
}
__device__ __forceinline__ void rms_rows4(const float* x0, const float* g, bf16_t* o0, int lane) {
    const f32x4* gr = (const f32x4*)g + lane;
    f32x4 v[4][4]; float s[4];
#pragma unroll
    for (int q = 0; q < 4; ++q) { const f32x4* xr = (const f32x4*)(x0 + (size_t)q * D) + lane;
#pragma unroll
        for (int j = 0; j < 4; ++j) v[q][j] = xr[64 * j]; }
#pragma unroll
    for (int q = 0; q < 4; ++q) { float a = 0.f;
#pragma unroll
        for (int j = 0; j < 4; ++j) a += (v[q][j].x * v[q][j].x + v[q][j].y * v[q][j].y) + (v[q][j].z * v[q][j].z + v[q][j].w * v[q][j].w);
        s[q] = a; }
#pragma unroll
    for (int q = 0; q < 4; ++q) s[q] = wave_sum(s[q]);
    f32x4 gj[4];
#pragma unroll
    for (int j = 0; j < 4; ++j) gj[j] = gr[64 * j];
#pragma unroll
    for (int q = 0; q < 4; ++q) { const float r = 1.0f / sqrtf(s[q] * (1.f / D) + EPS); u32x2* o8 = (u32x2*)(o0 + (size_t)q * D) + lane;
#pragma unroll
        for (int j = 0; j < 4; ++j) { const f32x4 y = (v[q][j] * r) * gj[j]; u32x2 w; w.x = cvtpk(y.x, y.y); w.y = cvtpk(y.z, y.w); o8[64 * j] = w; } }
}
__device__ __forceinline__ void p0_prologue(const Args& A, ldsp lds, int vcu, int G, int wave, int lane) {
    LAS float* scr = (LAS float*)(lds + wave * 16384);
    unsigned char* ws = A.ws;
    const int gw = vcu * 8 + wave, NGW = G * 8;
    constexpr int I_WIN = (NPAD / 32) * (D / 64), I_WOUT = (D / 32) * (D / 64), I_W1 = (256 / 32) * (2048 / 64), I_W2 = (64 / 32) * (256 / 64), I_B1 = 2 * 4 * 8;
    constexpr int NITEMS = I_WIN + I_WOUT + 2 * I_W1 + 2 * I_W2 + I_B1;
#ifndef HY_P0_SKIP_T
#ifndef HY_IT_LO
#define HY_IT_LO 0
#define HY_IT_HI NITEMS
#endif
    for (int it = gw; it < NITEMS; it += NGW) {
        int r = it;
        if (it < (HY_IT_LO) || it >= (HY_IT_HI)) continue;
#ifdef HY_WAVE_LT
        if (wave >= (HY_WAVE_LT)) continue;
#endif
        if (r < I_WIN) { const int nb = r / (D / 64), kb = r % (D / 64), p0 = 32 * nb;
            const int n0 = 256 * (p0 >> 8) + 64 * ((p0 >> 5) & 3) + 32 * ((p0 >> 7) & 1);
            transpose_item(A.in[2], NIN, NIN, n0, 64 * kb, (bf16_t*)(ws + WS_WIN), D, p0, scr, lane); continue; }
        r -= I_WIN;
        if (r < I_WOUT) { const int nb = r / (D / 64), kb = r % (D / 64); transpose_item(A.in[16], D, D, 32 * nb, 64 * kb, (bf16_t*)(ws + WS_WOUT), D, 32 * nb, scr, lane); continue; }
        r -= I_WOUT;
        if (r < 2 * I_W1) { const int wh = r / I_W1, q = r % I_W1, nb = q / 32, kb = q % 32;
            transpose_item(A.in[13] + (size_t)wh * 2048 * 256, 256, 256, 32 * nb, 64 * kb, (bf16_t*)(ws + WS_W1T) + (size_t)wh * 256 * 2048, 2048, 32 * nb, scr, lane); continue; }
        r -= 2 * I_W1;
        if (r < 2 * I_W2) { const int wh = r / I_W2, q = r % I_W2, nb = q / 4, kb = q % 4;
            transpose_item(A.in[15] + (size_t)wh * 256 * 64, 64, 64, 32 * nb, 64 * kb, (bf16_t*)(ws + WS_W2T) + (size_t)wh * 64 * 256, 256, 32 * nb, scr, lane); continue; }
        r -= 2 * I_W2;
        {
            const int wh = r >> 5, ng = (r >> 3) & 3, ksl = r & 7;
            const float* pos = A.in[12] + (size_t)wh * 2048 + ksl * 256; const float* w1 = A.in[13] + (size_t)wh * 2048 * 256 + (size_t)(ksl * 256) * 256 + ng * 64 + lane;
            float acc = 0.f;
#pragma unroll 8
            for (int k = 0; k < 256; ++k) acc = fmaf(pos[k], w1[(size_t)k * 256], acc);
            ((float*)(ws + WS_B1P))[(wh * 8 + ksl) * 256 + ng * 64 + lane] = acc;
        }
    }
#endif
#ifndef HY_P0_SKIP_R
    for (int m = 4 * gw; m < M; m += 4 * NGW) rms_rows4(A.in[0] + (size_t)m * D, A.in[1], (bf16_t*)(ws + WS_XN) + (size_t)m * D, lane);
#endif
}

struct EpiIn {
    static constexpr bool PERM = true, AFTER_DRAIN = false;
    bf16_t* P; const float* gq_d; const float* gk_d; const float* gq_n; const float* gk_n3;
    __device__ __forceinline__ void operator()(const f32x4 (&acc)[2][2][4][2], const pg8::Unit& u, int wr, int wc, int fr, int fq) const {
        const int G = u.pn * 4 + wc;
        if (G > 60) return;
        int kind = 0; const float* g = nullptr; float post = 1.f;
        if (G < 8) { kind = 1; g = gq_d; post = QSCALE; }
        else if (G < 16) { kind = 1; g = gk_d; }
        else if (G < 24) { kind = 0; }
        else if (G < 32) { kind = 2; }
        else if (G < 40) { kind = 1; g = gq_n; post = QSCALE; }
        else if (G < 52) { const int wh = (G - 40) >> 1; if (wh == 2) { kind = 1; g = gk_n3 + 64; } else if (wh == 4) { kind = 1; g = gk_n3 + 128; } }
        else if (G < 60) { kind = 2; }
        else { kind = 3; }
        f32x4 gv[2][2];
#pragma unroll
        for (int bj = 0; bj < 2; ++bj)
#pragma unroll
            for (int n = 0; n < 2; ++n) gv[bj][n] = (kind == 1) ? (*(const f32x4*)(g + 32 * bj + 8 * fq + 4 * n)) * post : (f32x4){1.f, 1.f, 1.f, 1.f};
        bf16_t* base = P + (size_t)(u.pm * 256 + wr * 64 + fr) * LDP + G * 64 + 8 * fq;
#pragma unroll
        for (int ai = 0; ai < 2; ++ai)
#pragma unroll
            for (int m = 0; m < 4; ++m) {
                f32x4 v[2][2];
#pragma unroll
                for (int bj = 0; bj < 2; ++bj)
#pragma unroll
                    for (int n = 0; n < 2; ++n) v[bj][n] = acc[ai][bj][m][n];
                if (kind == 1) {
                    float ss = 0.f;
#pragma unroll
                    for (int bj = 0; bj < 2; ++bj)
#pragma unroll
                        for (int n = 0; n < 2; ++n) { const f32x4 x = v[bj][n]; ss += (x[0] * x[0] + x[1] * x[1]) + (x[2] * x[2] + x[3] * x[3]); }
                    ss += shx<16>(ss); ss += shx<32>(ss);
                    const float r = __builtin_amdgcn_rsqf(ss * (1.f / 64.f) + EPS);
#pragma unroll
                    for (int bj = 0; bj < 2; ++bj)
#pragma unroll
                        for (int n = 0; n < 2; ++n) v[bj][n] = (v[bj][n] * r) * gv[bj][n];
                } else if (kind == 2) {
#pragma unroll
                    for (int bj = 0; bj < 2; ++bj)
#pragma unroll
                        for (int n = 0; n < 2; ++n)
#pragma unroll
                            for (int e = 0; e < 4; ++e) v[bj][n][e] = siluf(v[bj][n][e]);
                } else if (kind == 3) {
#pragma unroll
                    for (int bj = 0; bj < 2; ++bj)
#pragma unroll
                        for (int n = 0; n < 2; ++n)
#pragma unroll
                            for (int e = 0; e < 4; ++e) v[bj][n][e] = sigmf(v[bj][n][e]);
                }
                bf16_t* rowp = base + (size_t)(ai * 128 + m * 16) * LDP;
#pragma unroll
                for (int bj = 0; bj < 2; ++bj) {
                    u32x4 w; w.x = cvtpk(v[bj][0][0], v[bj][0][1]); w.y = cvtpk(v[bj][0][2], v[bj][0][3]); w.z = cvtpk(v[bj][1][0], v[bj][1][1]); w.w = cvtpk(v[bj][1][2], v[bj][1][3]);
                    *(u32x4*)(rowp + 32 * bj) = w;
                }
            }
    }
};
struct EpiOut {
    static constexpr bool PERM = false, AFTER_DRAIN = false;
    const float* x; float* out;
    __device__ __forceinline__ void operator()(const f32x4 (&acc)[2][2][4][2], const pg8::Unit& u, int wr, int wc, int fr, int fq) const {
        const int col0 = u.pn * 256 + wc * 32 + 4 * fq;
#pragma unroll
        for (int ai = 0; ai < 2; ++ai) {
            f32x4 xv[4][2][2];
#pragma unroll
            for (int m = 0; m < 4; ++m) {
                const size_t off = (size_t)(u.pm * 256 + ai * 128 + wr * 64 + m * 16 + fr) * D + col0;
#pragma unroll
                for (int bj = 0; bj < 2; ++bj)
#pragma unroll
                    for (int n = 0; n < 2; ++n) xv[m][bj][n] = *(const f32x4*)(x + off + bj * 128 + n * 16);
            }
#pragma unroll
            for (int m = 0; m < 4; ++m) {
                const size_t off = (size_t)(u.pm * 256 + ai * 128 + wr * 64 + m * 16 + fr) * D + col0;
#pragma unroll
                for (int bj = 0; bj < 2; ++bj)
#pragma unroll
                    for (int n = 0; n < 2; ++n) *(f32x4*)(out + off + bj * 128 + n * 16) = xv[m][bj][n] + acc[ai][bj][m][n];
            }
        }
    }
};

__device__ __forceinline__ void compress_phase(const Args& A, ldsp lds, int wave, int lane) {
    unsigned char* ws = A.ws;
    const bf16_t* PROJ = (const bf16_t*)(ws + WS_PROJ);
    const int tid = wave * 64 + lane, fr = lane & 15, kq = lane >> 4, rg4 = wave & 3, ch = wave >> 2;
    constexpr int BROW = 144, BSLOT = 256 * BROW, HB_OFF = 2 * BSLOT;
    LAS bf16_t* hbuf = (LAS bf16_t*)(lds + HB_OFF);
    for (int uidx = blockIdx.x; uidx < 256; uidx += gridDim.x) {
        const int wh = uidx & 1, kvh = (uidx >> 1) & 1, rh = (uidx >> 2) & 1, b = uidx >> 3;
        const bf16_t* src = PROJ + (size_t)(b * T) * LDP + C_NKV + wh * 128 + kvh * 64;
        const bf16_t* w1t = (const bf16_t*)(ws + WS_W1T) + (size_t)wh * 256 * 2048;
        const bf16_t* w2t = (const bf16_t*)(ws + WS_W2T) + (size_t)wh * 64 * 256;
        const float* b1 = A.in[14] + wh * 256; const float* b1p = (const float*)(ws + WS_B1P) + wh * 8 * 256;
        const int i = rh * 64 + rg4 * 16 + fr;
        const bf16_t* bsrc = w1t + (size_t)(tid >> 1) * 2048 + (tid & 1) * 32;
        const int bdst = (tid >> 1) * BROW + (tid & 1) * 64;
        int tok0 = 16 * i; tok0 = tok0 < T - 31 ? tok0 : T - 32;
        const bf16_t* asrc = src + (size_t)tok0 * LDP + 8 * kq;
        f32x4 acc[8];
#pragma unroll
        for (int nt = 0; nt < 8; ++nt) acc[nt] = (f32x4){0.f, 0.f, 0.f, 0.f};
        u32x4 rb[4]; bf16x8 a[2], an[2];
#pragma unroll
        for (int q = 0; q < 4; ++q) rb[q] = *(const u32x4*)(bsrc + q * 8);
        a[0] = *(const bf16x8*)(asrc); a[1] = *(const bf16x8*)(asrc + 32);
#pragma unroll
        for (int q = 0; q < 4; ++q) *(LAS u32x4*)(lds + bdst + q * 16) = rb[q];
        __syncthreads();
#pragma unroll 1
        for (int ks = 0; ks < 32; ++ks) {
            const int cur = (ks & 1) * BSLOT, nxt = BSLOT - cur;
            if (ks + 1 < 32) {
#pragma unroll
                for (int q = 0; q < 4; ++q) rb[q] = *(const u32x4*)(bsrc + (ks + 1) * 64 + q * 8);
                an[0] = *(const bf16x8*)(asrc + (size_t)(ks + 1) * LDP); an[1] = *(const bf16x8*)(asrc + (size_t)(ks + 1) * LDP + 32);
            }
            const LAS unsigned char* bp = lds + cur + (ch * 128 + fr) * BROW + kq * 16;
#pragma unroll
            for (int sb = 0; sb < 2; ++sb)
#pragma unroll
                for (int nt = 0; nt < 8; ++nt) {
                    const bf16x8 bb = *(const LAS bf16x8*)(bp + nt * 16 * BROW + sb * 64);
                    acc[nt] = __builtin_amdgcn_mfma_f32_16x16x32_bf16(a[sb], bb, acc[nt], 0, 0, 0);
                }
            if (ks + 1 < 32) {
#pragma unroll
                for (int q = 0; q < 4; ++q) *(LAS u32x4*)(lds + nxt + bdst + q * 16) = rb[q];
                a[0] = an[0]; a[1] = an[1];
            }
            __syncthreads();
        }
#pragma unroll
        for (int nt = 0; nt < 8; ++nt) {
            const int col = ch * 128 + 16 * nt + fr; float bias = b1[col];
#pragma unroll
            for (int sl = 0; sl < 8; ++sl) bias += b1p[sl * 256 + col];
#pragma unroll
            for (int rg = 0; rg < 4; ++rg) { const float hv = siluf(acc[nt][rg] + bias); hbuf[(rg4 * 16 + 4 * kq + rg) * 264 + col] = (bf16_t)(cvtpk(hv, hv) & 0xffffu); }
        }
        __syncthreads();
        if (ch == 0) {
            f32x4 acc2[4];
#pragma unroll
            for (int nt = 0; nt < 4; ++nt) acc2[nt] = (f32x4){0.f, 0.f, 0.f, 0.f};
#pragma unroll
            for (int ks = 0; ks < 8; ++ks) {
                const bf16x8 av = *(const LAS bf16x8*)(hbuf + (rg4 * 16 + fr) * 264 + 32 * ks + 8 * kq);
#pragma unroll
                for (int nt = 0; nt < 4; ++nt) {
                    const bf16x8 bb = *(const bf16x8*)(w2t + (size_t)(nt * 16 + fr) * 256 + 32 * ks + 8 * kq);
                    acc2[nt] = __builtin_amdgcn_mfma_f32_16x16x32_bf16(av, bb, acc2[nt], 0, 0, 0);
                }
            }
            bf16_t* dst = (bf16_t*)(ws + (wh == 0 ? WS_KC : WS_VC)) + (size_t)((b * 2 + kvh) * 128) * 64;
            const float* gk = A.in[11];
#pragma unroll
            for (int rg = 0; rg < 4; ++rg) {
                const int io = rh * 64 + rg4 * 16 + 4 * kq + rg;
                float v[4];
#pragma unroll
                for (int nt = 0; nt < 4; ++nt) v[nt] = acc2[nt][rg];
                if (wh == 0) {
                    float ss = (v[0] * v[0] + v[1] * v[1]) + (v[2] * v[2] + v[3] * v[3]);
                    ss += shx<1>(ss); ss += shx<2>(ss); ss += shx<4>(ss); ss += shx<8>(ss);
                    const float r = 1.0f / sqrtf(ss * (1.f / 64.f) + EPS);
#pragma unroll
                    for (int nt = 0; nt < 4; ++nt) v[nt] = (v[nt] * r) * gk[16 * nt + fr];
                }
#pragma unroll
                for (int nt = 0; nt < 4; ++nt) { const float ov = (io < 127) ? v[nt] : 0.f; dst[(size_t)io * 64 + 16 * nt + fr] = (bf16_t)(cvtpk(ov, ov) & 0xffffu); }
            }
        }
        __syncthreads();
    }
}

__device__ __forceinline__ int crow(int r, int hi) { return (r & 3) + 8 * (r >> 2) + 4 * hi; }
typedef short v4i16_t __attribute__((ext_vector_type(4)));
typedef LAS const unsigned char* lcp;
__device__ __forceinline__ s16x4 vtr(lcp p) { return __builtin_bit_cast(s16x4, __builtin_amdgcn_ds_read_tr16_b64_v4i16((LAS v4i16_t*)p)); }
#define SBAR() __builtin_amdgcn_sched_barrier(0)
#define WAIT_BAR(N) asm volatile("s_waitcnt vmcnt(" #N ") lgkmcnt(0)\n\ts_barrier" ::: "memory")
__device__ __forceinline__ void glds16(const void* gsrc, unsigned lds_dst) {
    unsigned keep;
    asm volatile("s_mov_b32 %0, m0\n\ts_mov_b32 m0, %2\n\ts_nop 0\n\tglobal_load_lds_dwordx4 %1, off\n\ts_mov_b32 m0, %0" : "=&s"(keep) : "v"(gsrc), "s"(lds_dst) : "memory");
}
__device__ __forceinline__ void glds16s(unsigned voff, const void* sbase, unsigned lds_dst) {
    unsigned keep;
    asm volatile("s_mov_b32 %0, m0\n\ts_mov_b32 m0, %3\n\ts_nop 0\n\tglobal_load_lds_dwordx4 %1, %2\n\ts_mov_b32 m0, %0" : "=&s"(keep) : "v"(voff), "s"(sbase), "s"(lds_dst) : "memory");
}
constexpr int N_VR = 24576;
constexpr int N_CMP = 49152;
constexpr int D_VR = 49152;

__device__ __forceinline__ lcp lxor(lcp p, unsigned x) { return (lcp)(uintptr_t)((unsigned)(uintptr_t)p ^ x); }
template <int KH = 0>
__device__ __forceinline__ void qk_simple(f32x16& p0, f32x16& p1, lcp kp, const bf16x8 (&qr)[4], float c0) {
#pragma unroll
    for (int r = 0; r < 16; ++r) { p0[r] = c0; p1[r] = c0; }
#pragma unroll
    for (int d0 = 0; d0 < 4; ++d0) {
        const bf16x8 b0 = *(const LAS bf16x8*)(KH ? lxor(kp, d0 << 5) : kp + d0 * 2048);
        const bf16x8 b1 = *(const LAS bf16x8*)(KH ? lxor(kp, d0 << 5) + KH : kp + d0 * 2048 + 512);
        p0 = __builtin_amdgcn_mfma_f32_32x32x16_bf16(b0, qr[d0], p0, 0, 0, 0);
        p1 = __builtin_amdgcn_mfma_f32_32x32x16_bf16(b1, qr[d0], p1, 0, 0, 0);
    }
}
__device__ __forceinline__ void mask_neg(f32x16& p0, f32x16& p1, int kbase, int kmin, int kmax) {
#pragma unroll
    for (int r = 0; r < 16; ++r) {
        const int kv = kbase + (r & 3) + 8 * (r >> 2);
        if (kv < kmin || kv > kmax) p0[r] = -INFINITY;
        if (kv + 32 < kmin || kv + 32 > kmax) p1[r] = -INFINITY;
    }
}
__device__ __forceinline__ void mask_hi(f32x16& p0, f32x16& p1, int kbase, int kmax) {
#pragma unroll
    for (int r = 0; r < 16; ++r) {
        const int kv = kbase + (r & 3) + 8 * (r >> 2);
        if (kv > kmax) p0[r] = -INFINITY;
        if (kv + 32 > kmax) p1[r] = -INFINITY;
    }
}
template <bool ALIBI>
__device__ __forceinline__ void exp_all(f32x16& p0, f32x16& p1, float slope2) {
#pragma unroll
    for (int r = 0; r < 16; ++r) {
        const float cr = (float)((r & 3) + 8 * (r >> 2));
        if (ALIBI) { p0[r] = __builtin_amdgcn_exp2f(fmaf(slope2, cr, p0[r])); p1[r] = __builtin_amdgcn_exp2f(fmaf(slope2, cr + 32.f, p1[r])); }
        else { p0[r] = __builtin_amdgcn_exp2f(p0[r]); p1[r] = __builtin_amdgcn_exp2f(p1[r]); }
    }
}
__device__ __forceinline__ float rowsum(const f32x16& p0, const f32x16& p1) {
    float s = 0.f;
#pragma unroll
    for (int r = 0; r < 16; ++r) s += p0[r] + p1[r];
    return s;
}
__device__ __forceinline__ void pack_p(bf16x8 (&pa)[4], const f32x16& p0, const f32x16& p1) {
    u32x4 w;
    w.x = cvtpk(p0[0], p0[1]); w.y = cvtpk(p0[2], p0[3]); w.z = cvtpk(p0[4], p0[5]); w.w = cvtpk(p0[6], p0[7]); pa[0] = __builtin_bit_cast(bf16x8, w);
    w.x = cvtpk(p0[8], p0[9]); w.y = cvtpk(p0[10], p0[11]); w.z = cvtpk(p0[12], p0[13]); w.w = cvtpk(p0[14], p0[15]); pa[1] = __builtin_bit_cast(bf16x8, w);
    w.x = cvtpk(p1[0], p1[1]); w.y = cvtpk(p1[2], p1[3]); w.z = cvtpk(p1[4], p1[5]); w.w = cvtpk(p1[6], p1[7]); pa[2] = __builtin_bit_cast(bf16x8, w);
    w.x = cvtpk(p1[8], p1[9]); w.y = cvtpk(p1[10], p1[11]); w.z = cvtpk(p1[12], p1[13]); w.w = cvtpk(p1[14], p1[15]); pa[3] = __builtin_bit_cast(bf16x8, w);
}
template <int NDV, int VH = 0>
__device__ __forceinline__ void pv_simple(f32x16 (&o)[NDV], const f32x16& p0, const f32x16& p1, lcp vp) {
    bf16x8 pa[4]; pack_p(pa, p0, p1);
#pragma unroll
    for (int d0 = 0; d0 < NDV; ++d0)
#pragma unroll
        for (int ks = 0; ks < 4; ++ks) {
            const lcp a_ = VH ? lxor(vp, d0 << 6) + ks * (2 * VH) : vp + d0 * 4096 + ks * 1024;
            const s16x4 lo = vtr(a_), hh = vtr(a_ + (VH ? VH : 512));
            const bf16x8 vb = (bf16x8){lo[0], lo[1], lo[2], lo[3], hh[0], hh[1], hh[2], hh[3]};
            o[d0] = __builtin_amdgcn_mfma_f32_32x32x16_bf16(pa[ks], vb, o[d0], 0, 0, 0);
        }
}

struct AttnCtx {
    const bf16_t* PROJ; const bf16_t* KC; const bf16_t* VC; bf16_t* AOUT;
    const float* gsub;
    float lam;
    float M2d, M2c, M2s, M2w;
};

#ifdef HY_TSEL
#define TMARK(var) const unsigned var = (unsigned)__builtin_amdgcn_s_memrealtime()
#define TACC(slot, t1, t0) do { if (wid == 0 && (tid & 63) == 0) ((volatile LAS unsigned*)(lds + L_MISC + 128))[slot] += (t1) - (t0); } while (0)
#else
#define TMARK(var) do { } while (0)
#define TACC(slot, t1, t0) do { } while (0)
#endif
#define PKW(P, B) cvtpk(P[B], P[(B) + 1])
#define PAF(k) __builtin_bit_cast(bf16x8, pw##k)
#define PIN(x) asm volatile("" : "+v"(x))
#define MF32(a, b, c) __builtin_amdgcn_mfma_f32_32x32x16_bf16(a, b, c, 0, 0, 0)
#define VJ(buf, dblk, ks) do { const lcp a_ = VADDR(dblk, ks); vl##buf = vtr(a_); vh##buf = vtr(a_ + VHB); } while (0)
#define VADDR(dblk, ks) (lxor(vp_, (dblk) << 6) + (ks) * (2 * VHB))
#define KADDR(j) lxor(kp0 + sl_next, (j) << 5)
#define VF(buf) (bf16x8){vl##buf[0], vl##buf[1], vl##buf[2], vl##buf[3], vh##buf[0], vh##buf[1], vh##buf[2], vh##buf[3]}
#define KRD(j) do { const lcp a_ = KADDR(j); kf[2 * (j)] = *(const LAS bf16x8*)a_; kf[2 * (j) + 1] = *(const LAS bf16x8*)(a_ + KHB); SBAR(); } while (0)
#define GAPA(MF, A0, A1, A2, A3, W0, W1, PW) do { MF; sacc += A0; sacc += A1; sacc += A2; sacc += A3; PIN(sacc); W0; W1; PIN(PW); SBAR(); } while (0)
#define EX1(X, r) X[r] = __builtin_amdgcn_exp2f(X[r])
#define GAPB4(MF, X, B) do { MF; EX1(X, B); EX1(X, (B) + 1); EX1(X, (B) + 2); EX1(X, (B) + 3); PIN(X); SBAR(); } while (0)
#define GAPB2(MF, X, B) do { MF; EX1(X, B); EX1(X, (B) + 1); PIN(X); SBAR(); } while (0)
__device__ __forceinline__ unsigned split2(float x) { const unsigned h = cvtpk(x, 0.f) & 0xffffu; const float hf = __builtin_bit_cast(float, h << 16); return h | (cvtpk(0.f, x - hf) & 0xffff0000u); }
__device__ __forceinline__ unsigned dup_bf16_exact(float x) { const unsigned h = __builtin_bit_cast(unsigned, x) >> 16; return h | (h << 16); }
#define GAPA2(MF, A0, A1, W0, W1, PW) do { MF; sacc += A0; sacc += A1; PIN(sacc); W0; W1; PIN(PW); SBAR(); } while (0)
#define PHASE_A(C0_, C1_, P0_, P1_) do { \
    float sacc = (P0_[0] + P0_[1]); \
    GAPA(C0_ = MF32(__builtin_bit_cast(bf16x8, xa0), __builtin_bit_cast(bf16x8, xb), z16), P0_[2], P0_[3], P0_[4], P0_[5], pw0[0] = PKW(P0_, 0),  pw0[1] = PKW(P0_, 2),  pw0); \
    PA_HOOK0; \
    GAPA(C1_ = MF32(__builtin_bit_cast(bf16x8, xa1), __builtin_bit_cast(bf16x8, xb), z16), P0_[6], P0_[7], P0_[8], P0_[9], pw0[2] = PKW(P0_, 4),  pw0[3] = PKW(P0_, 6),  pw0); \
    GAPA(C0_ = MF32(kf[0], qr[0], C0_), P0_[10], P0_[11], P0_[12], P0_[13], pw1[0] = PKW(P0_, 8),  pw1[1] = PKW(P0_, 10), pw1); \
    PA_HOOK1; \
    GAPA(C1_ = MF32(kf[1], qr[0], C1_), P0_[14], P0_[15], P1_[0], P1_[1],   pw1[2] = PKW(P0_, 12), pw1[3] = PKW(P0_, 14), pw1); \
    GAPA(C0_ = MF32(kf[2], qr[1], C0_), P1_[2], P1_[3], P1_[4], P1_[5],     pw2[0] = PKW(P1_, 0),  pw2[1] = PKW(P1_, 2),  pw2); \
    PA_HOOK2; \
    GAPA(C1_ = MF32(kf[3], qr[1], C1_), P1_[6], P1_[7], P1_[8], P1_[9],     pw2[2] = PKW(P1_, 4),  pw2[3] = PKW(P1_, 6),  pw2); \
    GAPA(C0_ = MF32(kf[4], qr[2], C0_), P1_[10], P1_[11], P1_[12], P1_[13], pw3[0] = PKW(P1_, 8),  pw3[1] = PKW(P1_, 10), pw3); \
    PA_HOOK3; \
    GAPA2(C1_ = MF32(kf[5], qr[2], C1_), P1_[14], P1_[15],                  pw3[2] = PKW(P1_, 12), pw3[3] = PKW(P1_, 14), pw3); \
    C0_ = MF32(kf[6], qr[3], C0_); VJ(0, 0, 0); SBAR(); \
    C1_ = MF32(kf[7], qr[3], C1_); VJ(1, 1, 0); SBAR(); \
    l_reg += sacc; } while (0)

template <int PRB>
__device__ __forceinline__ void diff_unit(const AttnCtx& C0, int b, int h, int qb, ldsp lds, const int wid) {
    constexpr int probe = PRB;
    AttnCtx C = C0; if (probe) C.AOUT = (bf16_t*)((unsigned char*)C.AOUT - (WS_AOUT - WS_XN));
    { volatile LAS float* sc = (volatile LAS float*)(lds + L_MISC); C.lam = sc[4]; C.M2d = sc[5]; }
    int tid = hy_tid(wid); asm volatile("" : "+v"(tid));
    const int lane = tid & 63, r32 = lane & 31, hi = lane >> 5;
    TMARK(tm_a);
    const int cm = wid >> 2, wq = wid & 3;
    const int q0 = qb * 128, qlo = q0 + wq * 32, qpos = qlo + r32;
    const bf16_t* Pb = C.PROJ + (size_t)b * T * LDP;
    const unsigned lds0 = (unsigned)(uintptr_t)lds;
    constexpr int SLOTB = 16384;
    const float slope2 = ldexpf(1.0f, -2 * (h + 1)) * LOG2E;
    int t0 = (int)floorf(((float)(q0 - 63) - 126.0f / slope2) * (1.0f / 64.0f)) + 1; t0 = t0 < 0 ? 0 : (t0 & ~1);
    t0 = __builtin_amdgcn_readfirstlane(t0);
    const int NT = (probe & 32) ? 2 : 2 * (qb + 1) - t0;
    constexpr int KHB = 8192, VHB = 2048;
    const bf16_t* kdma = Pb + (size_t)(4 * wid) * LDP + C_DK + h * 128;
    const bf16_t* vdma = Pb + (size_t)(4 * wid) * LDP + C_DV + h * 128;
    const unsigned kvo = (unsigned)((lane >> 4) * LDP + ((lane & 15) ^ (((lane >> 4) << 2) | (wid & 3))) * 8) * 2u;
    const unsigned vvo = (unsigned)((lane >> 4) * LDP + ((lane & 15) ^ ((lane >> 4) << 2)) * 8) * 2u;
#define DTOFF(i) ((size_t)(t0 + ((i) < NT ? (i) : NT - 1)) * (64 * LDP))
#define DMA_K(i, so) do { if (probe & 1) break; const bf16_t* s_ = kdma + DTOFF(i); const unsigned d_ = (unsigned)__builtin_amdgcn_readfirstlane((int)(lds0 + (so) + wid * 1024)); glds16s(kvo, s_, d_); glds16s(kvo, s_ + 32 * LDP, d_ + 8192u); } while (0)
#define DMA_V(i, so) do { if (probe & 1) break; const bf16_t* s_ = vdma + DTOFF(i); const unsigned d_ = (unsigned)__builtin_amdgcn_readfirstlane((int)(lds0 + D_VR + (so) + wid * 1024)); glds16s(vvo, s_, d_); glds16s(vvo, s_ + 32 * LDP, d_ + 8192u); } while (0)
#define DMA_P(base, vo, i, so, half) do { if (probe & 1) break; const bf16_t* s_ = (base) + DTOFF(i) + (half) * (32 * LDP); const unsigned d_ = (unsigned)__builtin_amdgcn_readfirstlane((int)(lds0 + (so) + wid * 1024 + (half) * 8192)); glds16s(vo, s_, d_); } while (0)
#define DWB(N) do { if (!(probe & 2)) WAIT_BAR(N); } while (0)
    DMA_K(0, 0); DMA_V(0, 0); DMA_K(1, SLOTB); DMA_K(2, 2 * SLOTB);
    if (cm == 0 && !(probe & 1)) {
        const bf16_t* zs = Pb + (size_t)(qlo + (lane >> 4)) * LDP + C_DZ + h * 128 + (lane & 15) * 8;
        const unsigned zd = (unsigned)__builtin_amdgcn_readfirstlane((int)(lds0 + L_ZT + wq * 8192));
#pragma unroll
        for (int i = 0; i < 8; ++i) glds16(zs + (size_t)(4 * i) * LDP, zd + i * 1024u);
    }
    bf16x8 qr[4];
    { const bf16_t* qp = Pb + (size_t)qpos * LDP + C_DQ + h * 128 + cm * 64 + hi * 8;
#pragma unroll
      for (int d0 = 0; d0 < 4; ++d0) qr[d0] = *(const bf16x8*)(qp + d0 * 16); }
    f32x16 o[4];
#pragma unroll
    for (int d0 = 0; d0 < 4; ++d0)
#pragma unroll
        for (int r = 0; r < 16; ++r) o[d0][r] = 0.f;
    float l_reg = 0.f;
    const lcp kp0 = (lcp)lds + r32 * 256 + (((cm << 3) | hi) ^ (((r32 & 3) << 2) | ((r32 >> 2) & 3))) * 16;
    const lcp vp0 = (lcp)lds + D_VR + (4 * hi + ((lane & 15) >> 2)) * 256 + (((lane & 12) | (((lane >> 4) & 1) << 1) | ((lane >> 1) & 1))) * 16 + (lane & 1) * 8;
    int sl_prev = 0, sl_cur = 0, sl_next = SLOTB;
#define ROT() do { sl_prev = sl_cur; sl_cur = sl_next; sl_next = (sl_next == 2 * SLOTB) ? 0 : sl_next + SLOTB; } while (0)
#define DC0(t) fmaf(slope2, (float)(64 * (t0 + (t)) + 4 * hi - qpos), -C.M2d)
#define DMASK(X0, X1, t) do { if (64 * (t0 + (t)) + 63 > qlo) mask_hi(X0, X1, 64 * (t0 + (t)) + 4 * hi, qpos); } while (0)
    f32x16 pA0, pA1, pB0, pB1; bf16x8 kf[8]; s16x4 vl0, vh0, vl1, vh1, vl2, vh2; u32x4 pw0, pw1, pw2, pw3;
    const unsigned himask = hi ? 0u : 0xffffffffu;
    u32x4 xa0, xa1, xb;
    xa0.x = dup_bf16_exact((float)r32) & himask; xa1.x = dup_bf16_exact((float)(32 + r32)) & himask;
    xa0.y = 0u; xa1.y = 0u; xa0.z = 0x3f803f80u & himask; xa1.z = xa0.z; xa0.w = 0x00003f80u & himask; xa1.w = xa0.w;
    xb.x = split2(slope2) & himask; xb.y = xb.x; xb.z = split2(-slope2 * (float)qpos - C.M2d) & himask; xb.w = 0u;
    f32x16 z16;
#pragma unroll
    for (int r = 0; r < 16; ++r) z16[r] = 0.f;
    DWB(0);
    TMARK(tm_b);
    { qk_simple<KHB>(pA0, pA1, kp0, qr, DC0(0)); DMASK(pA0, pA1, 0); exp_all<true>(pA0, pA1, slope2); }
    DWB(0);
    DMA_K(3, 0); DMA_V(1, SLOTB);
    ROT();
#pragma unroll
    for (int j = 0; j < 4; ++j) { const lcp a_ = lxor(kp0 + sl_cur, j << 5); kf[2 * j] = *(const LAS bf16x8*)a_; kf[2 * j + 1] = *(const LAS bf16x8*)(a_ + KHB); }
    DWB(4);
#ifndef HY_DSPREAD
#define HY_DSPREAD 1
#endif
#if HY_DSPREAD == 2
#define DSPREAD(k, t_, X) do { } while (0)
#define PA_HOOK0 do { DMA_P(kdma, kvo, tq_ + 3, sl_cur, 0); SBAR(); } while (0)
#define PA_HOOK1 do { DMA_P(vdma, vvo, tq_ + 1, D_VR + sl_next, 0); SBAR(); } while (0)
#define PA_HOOK2 do { DMA_P(kdma, kvo, tq_ + 3, sl_cur, 1); SBAR(); } while (0)
#define PA_HOOK3 do { DMA_P(vdma, vvo, tq_ + 1, D_VR + sl_next, 1); SBAR(); } while (0)
#elif HY_DSPREAD
#define DSPREAD(k, t_, X) do { X; SBAR(); } while (0)
#else
#define DSPREAD(k, t_, X) do { if ((k) == 0) { DMA_K((t_) + 3, sl_cur); DMA_V((t_) + 1, sl_next); } } while (0)
#endif
#ifndef PA_HOOK0
#define PA_HOOK0 do { } while (0)
#define PA_HOOK1 do { } while (0)
#define PA_HOOK2 do { } while (0)
#define PA_HOOK3 do { } while (0)
#endif
#define DSTEP(C0_, C1_, P0_, P1_, t) do { SBAR(); \
    const int tq_ = (t); \
    const lcp vp_ = vp0 + sl_prev; \
    { const unsigned tb_ = dup_bf16_exact((float)(64 * (t0 + (t)))) & himask; xa0.y = tb_; xa1.y = tb_; } \
    PHASE_A(C0_, C1_, P0_, P1_); \
    DSPREAD(0, t, DMA_P(kdma, kvo, (t) + 3, sl_cur, 0)); \
    DMASK(C0_, C1_, t); \
    SBAR(); \
    GAPB2(o[0] = MF32(PAF(0), VF(0), o[0]); VJ(2, 0, 1), C0_, 0); \
    GAPB2(o[1] = MF32(PAF(0), VF(1), o[1]); VJ(0, 1, 1), C0_, 2); \
    DSPREAD(1, t, DMA_P(vdma, vvo, (t) + 1, D_VR + sl_next, 0)); \
    KRD(0); GAPB2(o[0] = MF32(PAF(1), VF(2), o[0]); VJ(1, 0, 2), C0_, 4); \
    GAPB2(o[1] = MF32(PAF(1), VF(0), o[1]); VJ(2, 1, 2), C0_, 6); \
    DSPREAD(2, t, DMA_P(kdma, kvo, (t) + 3, sl_cur, 1)); \
    KRD(1); GAPB2(o[0] = MF32(PAF(2), VF(1), o[0]); VJ(0, 0, 3), C0_, 8); \
    GAPB2(o[1] = MF32(PAF(2), VF(2), o[1]); VJ(1, 1, 3), C0_, 10); \
    DSPREAD(3, t, DMA_P(vdma, vvo, (t) + 1, D_VR + sl_next, 1)); \
    KRD(2); GAPB2(o[0] = MF32(PAF(3), VF(0), o[0]); VJ(2, 2, 0), C0_, 12); \
    GAPB2(o[1] = MF32(PAF(3), VF(1), o[1]); VJ(0, 3, 0), C0_, 14); \
    KRD(3); GAPB2(o[2] = MF32(PAF(0), VF(2), o[2]); VJ(1, 2, 1), C1_, 0); \
    GAPB2(o[3] = MF32(PAF(0), VF(0), o[3]); VJ(2, 3, 1), C1_, 2); \
    GAPB2(o[2] = MF32(PAF(1), VF(1), o[2]); VJ(0, 2, 2), C1_, 4); \
    GAPB2(o[3] = MF32(PAF(1), VF(2), o[3]); VJ(1, 3, 2), C1_, 6); \
    GAPB2(o[2] = MF32(PAF(2), VF(0), o[2]); VJ(2, 2, 3), C1_, 8); \
    GAPB2(o[3] = MF32(PAF(2), VF(1), o[3]); VJ(0, 3, 3), C1_, 10); \
    GAPB2(o[2] = MF32(PAF(3), VF(2), o[2]), C1_, 12); \
    GAPB2(o[3] = MF32(PAF(3), VF(0), o[3]), C1_, 14); \
    } while (0)
    int t = 1;
    for (; t + 1 < NT; t += 2) {
        DSTEP(pB0, pB1, pA0, pA1, t);     DWB(4); ROT();
        DSTEP(pA0, pA1, pB0, pB1, t + 1); DWB(4); ROT();
    }
    DSTEP(pB0, pB1, pA0, pA1, t); DWB(0); ROT();
    l_reg += rowsum(pB0, pB1);
    pv_simple<4, VHB>(o, pB0, pB1, vp0 + sl_prev);
#undef DSTEP
#undef PA_HOOK0
#undef PA_HOOK1
#undef PA_HOOK2
#undef PA_HOOK3
#undef DSPREAD
#undef DMA_P
#undef DMA_K
#undef DMA_V
#undef DTOFF
#undef DC0
#undef DMASK
    DWB(0);
    TMARK(tm_c);
    l_reg += shx<32>(l_reg);
    LAS float* wsf = (LAS float*)(lds + L_WSF) + wid * 64;
    LAS float* xbuf = (LAS float*)lds + wq * 64 + lane;
    if (cm == 1) {
        if (hi == 0) wsf[r32] = l_reg;
#pragma unroll
        for (int d0 = 0; d0 < 4; ++d0)
#pragma unroll
            for (int r = 0; r < 16; ++r) xbuf[(d0 * 16 + r) * 256] = o[d0][r];
    }
    __syncthreads();
    if (cm == 0) {
        {
            const float l2 = ((const LAS float*)(lds + L_WSF))[(wid + 4) * 64 + r32];
            if (hi == 0) { wsf[r32] = C.lam * l_reg * __builtin_amdgcn_rcpf(l2); wsf[32 + r32] = EPS * l_reg * l_reg; }
            LDS_FENCE();
        }
        float ss[16];
#pragma unroll
        for (int r = 0; r < 16; ++r) ss[r] = 0.f;
#pragma unroll
        for (int r = 0; r < 16; ++r) {
            const float f = wsf[crow(r, hi)];
#pragma unroll
            for (int d0 = 0; d0 < 4; ++d0) { const float v = fmaf(-f, xbuf[(d0 * 16 + r) * 256], o[d0][r]); o[d0][r] = v; ss[r] = fmaf(v, v, ss[r]); }
        }
#pragma unroll
        for (int r = 0; r < 16; ++r) {
            const float s = red32(ss[r]);
            ss[r] = (1.0f - LAM_INIT) * __builtin_amdgcn_rsqf(fmaf(s, 1.f / 128.f, wsf[32 + crow(r, hi)]));
        }
        LAS bf16_t* zt = (LAS bf16_t*)(lds + L_ZT + wq * 8192);
#pragma unroll
        for (int d0 = 0; d0 < 4; ++d0) {
            const float gs = C.gsub[32 * d0 + r32];
#pragma unroll
            for (int r = 0; r < 16; ++r) {
                LAS bf16_t* zp = zt + crow(r, hi) * 128 + 32 * d0 + r32;
                const float v = (o[d0][r] * ss[r]) * gs * bf2f(*zp);
                *zp = (bf16_t)(cvtpk(v, v) & 0xffffu);
            }
        }
        LDS_FENCE();
        {
            bf16_t* orow = C.AOUT + ((size_t)b * T + qlo + (lane >> 4)) * D + h * 128 + (lane & 15) * 8;
#pragma unroll
            for (int j = 0; j < 8; ++j) { const u32x4 w = *(const LAS u32x4*)((lcp)zt + (4 * j + (lane >> 4)) * 256 + (lane & 15) * 16); *(u32x4*)(orow + (size_t)(4 * j) * D) = w; }
        }
    }
    __syncthreads();
    TMARK(tm_d); TACC(0, tm_b, tm_a); TACC(1, tm_c, tm_b); TACC(2, tm_d, tm_c);
#undef DWB
}

__device__ __forceinline__ void nsa_accum(f32x16 (&tot)[2], const f32x16 (&o)[2], float f, LAS float* wsf, int r32, int hi) {
    LDS_FENCE();
    if (hi == 0) wsf[r32] = f;
    LDS_FENCE();
#pragma unroll
    for (int r = 0; r < 16; ++r) { const float fr = wsf[crow(r, hi)]; tot[0][r] += o[0][r] * fr; tot[1][r] += o[1][r] * fr; }
}
__device__ __forceinline__ void nsa_accum_lds(LAS float* tp, const f32x16 (&o)[2], float f, LAS float* wsf, int r32, int hi) {
    LDS_FENCE();
    if (hi == 0) wsf[r32] = f;
    LDS_FENCE();
#pragma unroll
    for (int r = 0; r < 16; ++r) { const float fr = wsf[crow(r, hi)]; tp[r * 512] += o[0][r] * fr; tp[(16 + r) * 512] += o[1][r] * fr; }
}
__device__ __forceinline__ void nsa_unit(const AttnCtx& C0, int b, int kvh, int tb, ldsp lds, const int wid, const int prb = 0) {
    AttnCtx C = C0; if (prb) C.AOUT = (bf16_t*)((unsigned char*)C.AOUT - (WS_AOUT - WS_XN)); { volatile LAS float* sc = (volatile LAS float*)(lds + L_MISC); C.M2c = sc[6]; C.M2s = sc[7]; C.M2w = sc[8]; }
    int tid = hy_tid(wid); asm volatile("" : "+v"(tid));
    const int lane = tid & 63, r32 = lane & 31, hi = lane >> 5;
    TMARK(tm_a);
    const int g = wid >> 1, half = wid & 1, head = kvh * 4 + g;
    const int tokl = 32 * half + r32, qpos = tb * 64 + tokl;
    const bf16_t* Pb = C.PROJ + (size_t)b * T * LDP;
    const unsigned lds0 = (unsigned)(uintptr_t)lds;
    constexpr int SLOTB = 8192;
    const int j0w = tb >= 8 ? tb - 8 : 0;
    const int NT = (prb & 16) ? 2 : (tb + 1) + (tb - j0w + 1);
#ifndef HY_NK_OLD
#define HY_NK_OLD 0
#endif
#ifndef HY_NV_OLD
#define HY_NV_OLD 0
#endif
    constexpr bool NKN = !(HY_NK_OLD), NVN = !(HY_NV_OLD);
    constexpr int KHB = NKN ? 4096 : 512, VHB = NVN ? 1024 : 512;
    const bf16_t* kdma = NKN ? Pb + (size_t)(8 * wid) * LDP + C_NKV + kvh * 64 : Pb + C_NKV + kvh * 64 + wid * 8;
    const bf16_t* vdma = NVN ? Pb + (size_t)(8 * wid) * LDP + C_NKV + kvh * 64 : Pb + (size_t)(16 * (wid & 3)) * LDP + C_NKV + kvh * 64 + (wid >> 2) * 32;
    const unsigned kvo = NKN ? (unsigned)((lane >> 3) * LDP + ((lane & 7) ^ (((lane >> 4) & 3) | (((wid >> 1) & 1) << 2))) * 8) * 2u : (unsigned)lane * (LDP * 2);
    const unsigned vvo = NVN ? (unsigned)((lane >> 3) * LDP + ((lane & 7) ^ (((lane >> 4) & 1) << 2)) * 8) * 2u : (unsigned)((lane >> 2) * LDP + (lane & 3) * 8) * 2u;
#undef VADDR
#undef KADDR
#define VADDR(dblk, ks) (NVN ? lxor(vp_, (dblk) << 6) + (ks) * 2048 : vp_ + ((dblk) * 4096 + (ks) * 1024))
#define KADDR(j) (NKN ? lxor(kp0 + sl_next, (j) << 5) : kp0 + sl_next + (j) * 2048)
#define NTOFF(i) ({ const int i_ = (i) < NT ? (i) : NT - 1; (i_ <= tb) ? (size_t)256 + (size_t)i_ * (64 * LDP) : (size_t)512 + (size_t)(j0w + i_ - tb - 1) * (64 * LDP); })
#define DMA_K(i, so) glds16s(kvo, kdma + NTOFF(i), (unsigned)__builtin_amdgcn_readfirstlane((int)(lds0 + (so) + wid * 1024)))
#define DMA_V(i, so) glds16s(vvo, vdma + NTOFF(i) + 128, (unsigned)__builtin_amdgcn_readfirstlane((int)(lds0 + N_VR + (so) + wid * 1024)))
    DMA_K(0, 0); DMA_V(0, 0); DMA_K(1, SLOTB); DMA_K(2, 2 * SLOTB);
    {
        const bf16_t* kc = C.KC + (size_t)((b * 2 + kvh) * 128) * 64 + (size_t)lane * 64 + wid * 8;
        const bf16_t* vc = C.VC + (size_t)((b * 2 + kvh) * 128) * 64 + (size_t)(16 * (wid & 3) + (lane >> 2)) * 64 + (wid >> 2) * 32 + (lane & 3) * 8;
        const unsigned d_ = (unsigned)__builtin_amdgcn_readfirstlane((int)(lds0 + N_CMP + wid * 1024));
        glds16(kc, d_); glds16(vc, d_ + 8192u); glds16(kc + 64 * 64, d_ + 16384u); glds16(vc + 64 * 64, d_ + 24576u);
    }
    {
        const bf16_t* zs = Pb + (size_t)(tb * 64 + 32 * half + (lane >> 3)) * LDP + C_NZ + head * 64 + (lane & 7) * 8;
        const unsigned zd = (unsigned)__builtin_amdgcn_readfirstlane((int)(lds0 + L_ZT + wid * 4096));
#pragma unroll
        for (int i = 0; i < 4; ++i) glds16(zs + (size_t)(8 * i) * LDP, zd + i * 1024u);
    }
    bf16x8 qr[4];
    { const bf16_t* qp = Pb + (size_t)qpos * LDP + C_NQ + head * 64 + hi * 8;
#pragma unroll
      for (int d0 = 0; d0 < 4; ++d0) qr[d0] = *(const bf16x8*)(qp + d0 * 16); }
    LAS float* wsf = (LAS float*)(lds + L_WSF) + wid * 64;
    const bf16_t* gatep = Pb + (size_t)qpos * LDP + C_NG + head;
    constexpr int GT0 = (L_ZT + 32768 - L_WSF) / 4;
    if (hi == 0) { const float g0_ = bf2f(gatep[0]), g1_ = bf2f(gatep[8]), g2_ = bf2f(gatep[16]); wsf[GT0 + r32] = g0_; wsf[GT0 + 512 + r32] = g1_; wsf[GT0 + 1024 + r32] = g2_; }
    const float slope2 = ldexpf(1.0f, -(head + 1)) * LOG2E;
    const lcp kp0 = NKN ? (lcp)lds + r32 * 128 + (hi ^ (((r32 >> 1) & 3) | (((r32 >> 4) & 1) << 2))) * 16 : (lcp)lds + hi * 1024 + r32 * 16;
    const lcp vp0 = NVN ? (lcp)lds + N_VR + (4 * hi + ((lane & 15) >> 2)) * 128 + ((((lane >> 3) & 1) << 2) | (((lane >> 4) & 1) << 1) | ((lane >> 1) & 1)) * 16 + (lane & 1) * 8
                        : (lcp)lds + N_VR + ((lane >> 4) & 1) * 32 + (lane & 3) * 8 + (4 * hi + ((lane & 15) >> 2)) * 64;
    f32x16 tot[2];
#pragma unroll
    for (int r = 0; r < 16; ++r) { tot[0][r] = 0.f; tot[1][r] = 0.f; }
    unsigned selmask;
    WAIT_BAR(0);
    TMARK(tm_b);
    {
        f32x16 o[2];
#pragma unroll
        for (int r = 0; r < 16; ++r) { o[0][r] = 0.f; o[1][r] = 0.f; }
        const int cmax = (qpos >= 31) ? ((qpos - 31) >> 4) : -1;
        const lcp kpc = (lcp)lds + N_CMP + hi * 1024 + r32 * 16;
        const lcp vpc = (lcp)lds + N_CMP + 8192 + ((lane >> 4) & 1) * 32 + (lane & 3) * 8 + (4 * hi + ((lane & 15) >> 2)) * 64;
        float Gs[16], Ts[16], l = 0.f;
#pragma unroll
        for (int tt = 0; tt < ((prb & 8) ? 0 : 2); ++tt) {
            f32x16 p0, p1;
            qk_simple(p0, p1, kpc + tt * 16384, qr, -C.M2c);
            mask_hi(p0, p1, 64 * tt + 4 * hi, cmax);
            exp_all<false>(p0, p1, 0.f);
            l += rowsum(p0, p1);
#pragma unroll
            for (int i = 0; i < 4; ++i) {
                Gs[tt * 8 + i] = (p0[4 * i] + p0[4 * i + 1]) + (p0[4 * i + 2] + p0[4 * i + 3]); Ts[tt * 8 + i] = p0[4 * i + 3];
                Gs[tt * 8 + 4 + i] = (p1[4 * i] + p1[4 * i + 1]) + (p1[4 * i + 2] + p1[4 * i + 3]); Ts[tt * 8 + 4 + i] = p1[4 * i + 3];
            }
            pv_simple<2>(o, p0, p1, vpc + tt * 16384);
        }
        l += shx<32>(l);
        const float invl = (l > 0.f) ? 1.0f / l : 0.f;
        LAS float* IB = (LAS float*)(lds + L_IB) + (g * 64 + tokl) * 33;
#pragma unroll
        for (int q = 0; q < 16; ++q) {
            const float recv = shx<32>(Ts[q]);
            if (hi == 1) Gs[q] += recv;
            else if (q + 1 < 16) Gs[q + 1] += recv;
        }
#pragma unroll
        for (int q = 0; q < 16; ++q) IB[2 * q + hi] = Gs[q];
        if (hi == 0) ((LAS float*)(lds + L_LB))[g * 64 + tokl] = invl;
        nsa_accum(tot, o, wsf[GT0 + r32] * invl, wsf, r32, hi);
    }
    WAIT_BAR(0);
    if (tb <= 7 || (prb & 4)) selmask = (2u << tb) - 1u;
    else {
        const LAS float* I0 = (const LAS float*)(lds + L_IB) + tokl * 33 + hi;
        float il[4];
#pragma unroll
        for (int gg = 0; gg < 4; ++gg) il[gg] = ((const LAS float*)(lds + L_LB))[gg * 64 + tokl];
        unsigned keys[16];
        const int lim = tb - 2 < 29 ? tb - 2 : 29, klim = (lim - hi) >> 1;
#pragma unroll
        for (int k = 0; k < 16; ++k) {
            float a = 0.f;
#pragma unroll
            for (int gg = 0; gg < 4; ++gg) a = fmaf(I0[gg * 64 * 33 + 2 * k], il[gg], a);
            const unsigned kb = (__builtin_bit_cast(unsigned, a) & ~31u) + (unsigned)(31 - 2 * k - hi);
            keys[k] = (k <= klim && (k > 0 || hi)) ? kb : 0u;
        }
        unsigned sel = 0u;
#pragma unroll 1
        for (int it = 0; it < 5; ++it) {
            unsigned m = keys[0];
#pragma unroll
            for (int k = 1; k < 16; ++k) m = keys[k] > m ? keys[k] : m;
            const unsigned mp = __builtin_bit_cast(unsigned, shx<32>(__builtin_bit_cast(float, m)));
            const unsigned w = mp > m ? mp : m;
            sel |= 1u << (31u - (w & 31u));
#pragma unroll
            for (int k = 0; k < 16; ++k) keys[k] = (keys[k] == w) ? 0u : keys[k];
        }
        selmask = (sel & ~1u) | 1u | (1u << (tb - 1)) | (1u << tb);
    }
    TMARK(tm_c);
    f32x16 o[2];
#pragma unroll
    for (int r = 0; r < 16; ++r) { o[0][r] = 0.f; o[1][r] = 0.f; }
    float l_reg = 0.f;
    int sl_prev = 0, sl_cur = 0, sl_next = SLOTB;
#define NJ(i) (((i) <= tb) ? (i) : j0w + (i) - tb - 1)
#define NC0(i) ({ const int j_ = NJ(i); float c_ = fmaf(slope2, (float)(64 * j_ + 4 * hi - qpos), ((i) <= tb) ? -C.M2s : -C.M2w); if ((i) <= tb && ((selmask >> j_) & 1u) == 0u) c_ = -INFINITY; c_; })
#define NMASK(X0, X1, i) do { const int j_ = NJ(i); if (j_ == tb) mask_hi(X0, X1, 64 * j_ + 4 * hi, qpos); else if ((i) > tb && j_ == tb - 8) mask_neg(X0, X1, 64 * j_ + 4 * hi, qpos - 511, qpos); } while (0)
    const int qw0 = tb * 64 + 32 * half;
    const int dthr = __builtin_amdgcn_readfirstlane((int)(126.0f / slope2) + 1);
#ifndef HY_NSA_LIGHT
#define HY_NSA_LIGHT 0
#endif
#define NDEAD(i) ((i) >= 0 && qw0 - 64 * NJ(i) - 63 > dthr)
#ifndef HY_NPROBE
#define HY_NPROBE 0
#endif
    int jd = qw0 - 63 - dthr; jd = jd > 0 ? (jd + 63) >> 6 : 0; jd = jd < tb ? jd : tb;
    if (((prb & 1) && wid < 4) || (prb & 2)) jd = 1000;
    jd = __builtin_amdgcn_readfirstlane(jd);
    f32x16 pA0, pA1, pB0, pB1; bf16x8 kf[8]; s16x4 vl0, vh0, vl1, vh1, vl2, vh2; u32x4 pw0, pw1, pw2, pw3;
#pragma unroll
    for (int r = 0; r < 16; ++r) { pB0[r] = 0.f; pB1[r] = 0.f; }
    const unsigned himask = hi ? 0u : 0xffffffffu;
    u32x4 xa0, xa1, xb;
    xa0.x = dup_bf16_exact((float)r32) & himask; xa1.x = dup_bf16_exact((float)(32 + r32)) & himask;
    xa0.y = 0u; xa1.y = 0u; xa0.z = 0x3f803f80u & himask; xa1.z = xa0.z; xa0.w = 0x00003f80u & himask; xa1.w = xa0.w;
    xb.x = split2(slope2) & himask; xb.y = xb.x; xb.z = split2(-slope2 * (float)qpos - C.M2s) & himask; xb.w = 0u;
    f32x16 z16;
#pragma unroll
    for (int r = 0; r < 16; ++r) z16[r] = 0.f;
    { qk_simple<NKN ? 4096 : 0>(pA0, pA1, kp0, qr, NC0(0)); NMASK(pA0, pA1, 0); exp_all<true>(pA0, pA1, slope2); }
    WAIT_BAR(0);
    DMA_K(3, 0); DMA_V(1, SLOTB);
    LAS float* tp = (LAS float*)(lds + N_CMP) + tid;
#pragma unroll
    for (int r = 0; r < 16; ++r) { tp[r * 512] = tot[0][r]; tp[(16 + r) * 512] = tot[1][r]; }
    ROT();
#pragma unroll
    for (int j = 0; j < 4; ++j) { const lcp a_ = NKN ? lxor(kp0 + sl_cur, j << 5) : kp0 + sl_cur + j * 2048; kf[2 * j] = *(const LAS bf16x8*)a_; kf[2 * j + 1] = *(const LAS bf16x8*)(a_ + KHB); }
    WAIT_BAR(2);
#define NFLUSH(t) do { if ((t) == tb + 1) { float lt_ = l_reg + shx<32>(l_reg); const float gs_ = wsf[GT0 + 512 + r32]; \
        nsa_accum_lds(tp, o, gs_ / lt_, wsf, r32, hi); _Pragma("unroll") for (int r = 0; r < 16; ++r) { o[0][r] = 0.f; o[1][r] = 0.f; } l_reg = 0.f; } } while (0)
#ifndef HY_NSPREAD
#define HY_NSPREAD 0
#endif
#if HY_NSPREAD == 2
#define NSPREADK(X) do { } while (0)
#define NSPREAD0(X) do { } while (0)
#define NSPREAD1(X) do { } while (0)
#define PA_HOOK0 do { } while (0)
#define PA_HOOK1 do { DMA_K(tq_ + 3, sl_cur); SBAR(); } while (0)
#define PA_HOOK2 do { } while (0)
#define PA_HOOK3 do { DMA_V(tq_ + 1, sl_next); SBAR(); } while (0)
#elif HY_NSPREAD
#define NSPREAD0(X) do { } while (0)
#define NSPREAD1(X) do { X; SBAR(); } while (0)
#else
#define NSPREAD0(X) do { X; } while (0)
#define NSPREAD1(X) do { } while (0)
#endif
#ifndef NSPREADK
#define NSPREADK(X) do { X; } while (0)
#endif
#ifndef PA_HOOK0
#define PA_HOOK0 do { } while (0)
#define PA_HOOK1 do { } while (0)
#define PA_HOOK2 do { } while (0)
#define PA_HOOK3 do { } while (0)
#endif
#define NSTEP(C0_, C1_, P0_, P1_, t) do { SBAR(); \
    const int tq_ = (t); \
    const lcp vp_ = vp0 + sl_prev; \
    { const int j_ = NJ(t); const unsigned tb_ = dup_bf16_exact((float)(64 * j_)) & himask; xa0.y = tb_; xa1.y = tb_; \
      if ((t) <= tb) xb.w = (((selmask >> j_) & 1u) ? 0u : 0x0000c6eau) & himask; \
      else if ((t) == tb + 1) { xb.z = split2(-slope2 * (float)qpos - C.M2w) & himask; xb.w = 0u; } } \
    PHASE_A(C0_, C1_, P0_, P1_); \
    NSPREADK(DMA_K((t) + 3, sl_cur)); NSPREAD0(DMA_V((t) + 1, sl_next)); \
    NMASK(C0_, C1_, t); \
    SBAR(); \
    GAPB4(o[0] = MF32(PAF(0), VF(0), o[0]); VJ(2, 0, 1), C0_, 0); \
    GAPB4(o[1] = MF32(PAF(0), VF(1), o[1]); VJ(0, 1, 1), C0_, 4); \
    KRD(0); GAPB4(o[0] = MF32(PAF(1), VF(2), o[0]); VJ(1, 0, 2), C0_, 8); \
    NSPREAD1(DMA_V((t) + 1, sl_next)); \
    KRD(1); GAPB4(o[1] = MF32(PAF(1), VF(0), o[1]); VJ(2, 1, 2), C0_, 12); \
    KRD(2); GAPB4(o[0] = MF32(PAF(2), VF(1), o[0]); VJ(0, 0, 3), C1_, 0); \
    KRD(3); GAPB4(o[1] = MF32(PAF(2), VF(2), o[1]); VJ(1, 1, 3), C1_, 4); \
    GAPB4(o[0] = MF32(PAF(3), VF(0), o[0]), C1_, 8); \
    GAPB4(o[1] = MF32(PAF(3), VF(1), o[1]), C1_, 12); \
    NFLUSH(t); \
    } while (0)
    int t = 1;
#pragma unroll 1
    for (; t < jd && t < NT; ++t) { SBAR(); DMA_K(t + 3, sl_cur); DMA_V(t + 1, sl_next); KRD(0); KRD(1); KRD(2); KRD(3); WAIT_BAR(2); ROT(); }
    for (; t + 1 < NT; t += 2) {
        NSTEP(pB0, pB1, pA0, pA1, t);     WAIT_BAR(2); ROT();
        NSTEP(pA0, pA1, pB0, pB1, t + 1); WAIT_BAR(2); ROT();
    }
    if (t < NT) {
        NSTEP(pB0, pB1, pA0, pA1, t); WAIT_BAR(2); ROT();
        WAIT_BAR(0);
        l_reg += rowsum(pB0, pB1);
        pv_simple<2, NVN ? 1024 : 0>(o, pB0, pB1, vp0 + sl_prev);
    } else {
        WAIT_BAR(0);
        l_reg += rowsum(pA0, pA1);
        pv_simple<2, NVN ? 1024 : 0>(o, pA0, pA1, vp0 + sl_prev);
    }
#undef NSTEP
#undef PA_HOOK0
#undef PA_HOOK1
#undef PA_HOOK2
#undef PA_HOOK3
#undef NDEAD
#undef NFLUSH
#undef NMASK
#undef NC0
#undef NJ
#undef DMA_K
#undef DMA_V
#undef NTOFF
    TMARK(tm_d);
    {
        const float gw_ = wsf[GT0 + 1024 + r32];
        const float lt_ = l_reg + shx<32>(l_reg);
        nsa_accum_lds(tp, o, gw_ / lt_, wsf, r32, hi);
    }
    {
        LAS bf16_t* zt = (LAS bf16_t*)(lds + L_ZT + wid * 4096);
#pragma unroll
        for (int d0 = 0; d0 < 2; ++d0)
#pragma unroll
            for (int r = 0; r < 16; ++r) {
                LAS bf16_t* zp = zt + crow(r, hi) * 64 + 32 * d0 + r32;
                const float v = tp[(d0 * 16 + r) * 512] * bf2f(*zp);
                *zp = (bf16_t)(cvtpk(v, v) & 0xffffu);
            }
        LDS_FENCE();
        bf16_t* orow = C.AOUT + ((size_t)b * T + tb * 64 + 32 * half + (lane >> 3)) * D + 512 + head * 64 + (lane & 7) * 8;
#pragma unroll
        for (int j = 0; j < 4; ++j) { const u32x4 w = *(const LAS u32x4*)((lcp)zt + (8 * j + (lane >> 3)) * 128 + (lane & 7) * 16); *(u32x4*)(orow + (size_t)(8 * j) * D) = w; }
    }
    asm volatile("s_waitcnt lgkmcnt(0)\n\ts_barrier" ::: "memory");
    TMARK(tm_e); TACC(3, tm_b, tm_a); TACC(4, tm_c, tm_b); TACC(5, tm_d, tm_c); TACC(6, tm_e, tm_d);
}
#undef ROT

__device__ __forceinline__ void attn_phase(const Args& A, ldsp lds, const int wave, int lane, const int qword = CW_QCTR) {
    const bool t0 = (wave == 0 && lane == 0);
    unsigned char* ws = A.ws;
    AttnCtx C;
    C.PROJ = (const bf16_t*)(ws + WS_PROJ); C.KC = (const bf16_t*)(ws + WS_KC); C.VC = (const bf16_t*)(ws + WS_VC); C.AOUT = (bf16_t*)(ws + WS_AOUT);
    C.gsub = A.in[9];
    {
        const float sa = wave_sum(A.in[5][lane] * A.in[6][lane]), sb = wave_sum(A.in[7][lane] * A.in[8][lane]);
        C.lam = expf(sa) - expf(sb) + LAM_INIT;
        const float mqd = wave_max(fabsf(A.in[3][lane])), mkd = wave_max(fabsf(A.in[4][lane])), mqn = wave_max(fabsf(A.in[10][lane]));
        const float mk0 = wave_max(fabsf(A.in[11][lane])), mk1 = wave_max(fabsf(A.in[11][64 + lane])), mk2 = wave_max(fabsf(A.in[11][128 + lane]));
        C.M2d = MCOEF * mqd * mkd; C.M2c = MCOEF * mqn * mk0; C.M2s = MCOEF * mqn * mk1; C.M2w = MCOEF * mqn * mk2;
        if (t0) { LAS float* sc = (LAS float*)(lds + L_MISC); sc[4] = C.lam; sc[5] = C.M2d; sc[6] = C.M2c; sc[7] = C.M2s; sc[8] = C.M2w; }
        C.lam = 0.f; C.M2d = 0.f; C.M2c = 0.f; C.M2s = 0.f; C.M2w = 0.f;
    }
#ifndef HY_QLEN
#define HY_QLEN 512
#define HY_QEXTRA_R 0
#endif
    unsigned* qctr = (unsigned*)(ws + WS_CTL) + qword;
    volatile LAS unsigned* bc = (volatile LAS unsigned*)(lds + L_MISC);
    const unsigned x0 = (unsigned)__builtin_amdgcn_s_getreg((3 << 11) | 20) & 7u;
    unsigned skip = 0u;
    for (;;) {
        if (t0) {
            unsigned found = 0xffffffffu;
            for (unsigned a = skip; a < 8u; ++a) {
                const unsigned x = (x0 + a) & 7u;
                const unsigned idx = atomicAdd(qctr + 64 * x, 1u);
                if (idx < (unsigned)HY_QLEN) { found = x * 1024u + idx; break; }
                skip = a + 1u;
            }
            bc[0] = found;
        }
        __syncthreads();
        const unsigned u = (unsigned)__builtin_amdgcn_readfirstlane((int)bc[0]);
        __syncthreads();
        if (u == 0xffffffffu) break;
        const int x = (int)(u >> 10); int idx = (int)(u & 1023u), b, r;
        if (idx < 256) { b = 4 * x + (idx >> 6); r = idx & 63; }
        else if (idx < 512) { b = 4 * x + ((idx - 256) >> 6); r = 64 + ((idx - 256) & 63); }
        else { idx -= 512; b = 4 * x + (idx >> 6); r = (idx & 63) + HY_QEXTRA_R; }
#ifndef HY_NO_DIFF
#ifndef HY_PROBE
#define HY_PROBE 0
#endif
        if (r < 64) { if ((HY_PROBE) != 0 && (u & 1023u) >= 512u) diff_unit<HY_PROBE>(C, b, r >> 4, 15 - (r & 15), lds, wave); else diff_unit<0>(C, b, r >> 4, 15 - (r & 15), lds, wave); }
#endif
#ifndef HY_NO_NSA
        if (r >= 64) nsa_unit(C, b, (r - 64) >> 5, 31 - ((r - 64) & 31), lds, wave, ((HY_NPROBE) != 0 && (u & 1023u) >= 512u) ? (HY_NPROBE) : 0);
#endif
    }
}

#define XB_TMO      128
#define XB_XCNT(j)  (256  + 64 * (j))
#define XB_XSUB(j)  (1280 + 64 * (j))
#define XB_XGEN(j)  (2304 + 64 * (j))
#define XB_TOP      3328
#define XB_TOPGEN   3392
#define XCD_BAR_WORDS 3456
#define XB_SPIN_CAP (1u << 22)
__device__ __forceinline__ unsigned xb_ld(unsigned* p)              { return __hip_atomic_load(p, __ATOMIC_RELAXED, __HIP_MEMORY_SCOPE_AGENT); }
__device__ __forceinline__ unsigned xb_add(unsigned* p, unsigned v) { return __hip_atomic_fetch_add(p, v, __ATOMIC_RELAXED, __HIP_MEMORY_SCOPE_AGENT); }
__device__ __forceinline__ unsigned xb_xcc_id() { return (unsigned)__builtin_amdgcn_s_getreg((3 << 11) | 20) & 0xFu; }
#define XB_SPIN(cond, bar) do { unsigned _sp = 0; while (cond) { __builtin_amdgcn_s_sleep(1); \
    if ((++_sp & 255u) == 0u) { if (xb_ld(&(bar)[XB_TMO])) break; if (_sp > XB_SPIN_CAP) { atomicAdd(&(bar)[XB_TMO], 1u); break; } } } } while (0)
struct XcdBarrier { unsigned* bar; unsigned x; volatile LAS unsigned* st; };
__device__ __forceinline__ XcdBarrier xcd_barrier_post(unsigned* bar, volatile LAS unsigned* st, bool t0) {
    XcdBarrier b; b.bar = bar; b.x = xb_xcc_id(); b.st = st;
    if (t0) (void)xb_add(&bar[XB_XCNT(b.x)], 1u);
    return b;
}
__device__ __forceinline__ void xcd_barrier_complete(unsigned* bar, unsigned x, unsigned& nloc, unsigned& nx) {
    const unsigned G = gridDim.x * gridDim.y * gridDim.z;
    unsigned sum, cnt, mine, sp = 0u;
    for (;;) {
        sum = 0u; cnt = 0u; mine = 0u;
#pragma unroll
        for (unsigned j = 0; j < 16; ++j) { const unsigned c = xb_ld(&bar[XB_XCNT(j)]); sum += c; cnt += (c > 0u) ? 1u : 0u; mine = (j == x) ? c : mine; }
        if (sum == G) break;
        __builtin_amdgcn_s_sleep(1);
        if ((++sp & 255u) == 0u) { if (xb_ld(&bar[XB_TMO])) break; if (sp > XB_SPIN_CAP) { atomicAdd(&bar[XB_TMO], 1u); break; } }
    }
    nloc = mine > 0u ? mine : 1u; nx = cnt > 0u ? cnt : 1u;
}
__device__ __forceinline__ void xcd_barrier(const XcdBarrier& b, bool t0) {
    asm volatile("s_waitcnt vmcnt(0)" ::: "memory");
    __syncthreads();
    if (t0) {
        unsigned* bar = b.bar;
        __builtin_amdgcn_s_waitcnt(0);
        unsigned nloc = b.st[0], nx = b.st[1];
        if (nloc == 0u) { xcd_barrier_complete(bar, b.x, nloc, nx); b.st[0] = nloc; b.st[1] = nx; }
        const unsigned old = xb_add(&bar[XB_XSUB(b.x)], 1u);
        const unsigned gen = old / nloc;
        if (old + 1u == (gen + 1u) * nloc) {
            __builtin_amdgcn_fence(__ATOMIC_RELEASE, "agent");
            asm volatile("s_waitcnt vmcnt(0)" ::: "memory");
            const unsigned og = xb_add(&bar[XB_TOP], 1u);
            const unsigned tg = og / nx;
            if (og + 1u == (tg + 1u) * nx) xb_add(&bar[XB_TOPGEN], 1u);
            else XB_SPIN(xb_ld(&bar[XB_TOPGEN]) == tg, bar);
            __builtin_amdgcn_fence(__ATOMIC_ACQUIRE, "agent");
            xb_add(&bar[XB_XGEN(b.x)], 1u);
            asm volatile("s_waitcnt vmcnt(0)" ::: "memory");
        } else {
            XB_SPIN(xb_ld(&bar[XB_XGEN(b.x)]) == gen, bar);
            __builtin_amdgcn_fence(__ATOMIC_ACQUIRE, "agent");
            asm volatile("s_waitcnt vmcnt(0)" ::: "memory");
        }
    }
    __syncthreads();
}
constexpr int CW_BAR = 4096;

__global__ void __launch_bounds__(512, 2) hymba_fwd(Args args) {
    extern __shared__ __attribute__((aligned(16))) unsigned char lds_raw[];
    ldsp lds = (ldsp)lds_raw;
    const int wave = __builtin_amdgcn_readfirstlane((int)threadIdx.x >> 6);
    const int G = gridDim.x; const int bx = blockIdx.x; const int vcu = (G % 8 == 0) ? (bx % 8) * (G / 8) + bx / 8 : bx;
    unsigned char* ws = args.ws;
    const int lo = args.ph_lo, hi = args.ph_hi;
#ifndef HY_PHASE_MASK
#define HY_PHASE_MASK 31
#endif
#define IN(k) ((((HY_PHASE_MASK) >> (k)) & 1) && lo <= (k) && (k) < hi)
#if HY_N_LAUNCHES == 1
    const bool t0 = (wave == 0) && ((hy_tid(wave) & 63) == 0);
    { volatile LAS unsigned* st = (volatile LAS unsigned*)(lds + L_MISC + 64); if (t0) { st[0] = 0u; st[1] = 0u; } __syncthreads(); }
    const XcdBarrier bar = xcd_barrier_post((unsigned*)(ws + WS_CTL) + CW_BAR, (volatile LAS unsigned*)(lds + L_MISC + 64), t0);
#define SEAM(k) do { if (IN(k) && IN((k) + 1)) { xcd_barrier(bar, (wave == 0) && ((hy_tid(wave) & 63) == 0)); } } while (0)
#else
#define SEAM(k) do { } while (0)
#endif
#ifdef HY_TSEL
    if (wave == 0 && (hy_tid(wave) & 63) < 16) ((volatile LAS unsigned*)(lds + L_MISC + 128))[hy_tid(wave) & 63] = 0u;
    __syncthreads();
#endif
#ifdef HY_TS_PHASE
    unsigned long long ts_[6]; ts_[0] = __builtin_amdgcn_s_memrealtime();
#define TS(k) do { ts_[k] = __builtin_amdgcn_s_memrealtime(); } while (0)
#else
#define TS(k) do { } while (0)
#endif
#ifndef HY_DUP_PHASE
#define HY_DUP_PHASE -1
#endif
#if HY_DUP_PHASE >= 0
#define DUP(k) for (int rep_ = 0; rep_ < __builtin_amdgcn_readfirstlane((HY_DUP_PHASE) == (k) ? 2 : 1); rep_ = __builtin_amdgcn_readfirstlane(rep_ + 1))
#else
#define DUP(k) for (int rep_ = 0, once_ = 1; once_; once_ = 0)
#endif
    if (IN(0)) DUP(0) { p0_prologue(args, lds, vcu, G, wave, hy_tid(wave) & 63); }
    SEAM(0); TS(1);
    if (IN(1)) DUP(1) {
        pg8::Gemm g{(const bf16_t*)(ws + WS_XN), (const bf16_t*)(ws + WS_WIN), M, NPAD, D}; pg8::StaticOrder S; S.init(M, NPAD, G, bx);
        EpiIn E{(bf16_t*)(ws + WS_PROJ), args.in[3], args.in[4], args.in[10], args.in[11]};
        pg8::gemm_phase<EpiIn, pg8::StaticOrder, true, true>((PG8_LAS unsigned char*)lds, g, S, E, wave);
    }
    SEAM(1); TS(2);
    if (IN(2)) DUP(2) { compress_phase(args, lds, wave, hy_tid(wave) & 63); }
    SEAM(2); TS(3);
#ifdef HY_TSEL
    const unsigned tp3a_ = (unsigned)__builtin_amdgcn_s_memrealtime();
#endif
    if (IN(3)) DUP(3) { attn_phase(args, lds, wave, hy_tid(wave) & 63, CW_QCTR + 512 * rep_); }
#ifdef HY_TSEL
    const unsigned tp3b_ = (unsigned)__builtin_amdgcn_s_memrealtime();
#endif
    SEAM(3); TS(4);
    if (IN(4)) DUP(4) {
        pg8::Gemm g{(const bf16_t*)(ws + WS_AOUT), (const bf16_t*)(ws + WS_WOUT), M, D, D}; pg8::StaticOrder S; S.init(M, D, G, bx);
        EpiOut E{args.in[0], args.out};
        pg8::gemm_phase<EpiOut, pg8::StaticOrder, true, true>((PG8_LAS unsigned char*)lds, g, S, E, wave);
    }
#ifdef HY_TS_PHASE
    xcd_barrier(bar, (wave == 0) && ((hy_tid(wave) & 63) == 0)); TS(5);
    if (bx == 0) { float v = (float)(ts_[HY_TS_PHASE + 1] - ts_[HY_TS_PHASE]) * 0.01f; v = exp2f(floorf(log2f(v) * 12.f + 0.5f) / 12.f);
        const int t = hy_tid(wave);
        for (size_t i = t; i < (size_t)M * D / 4; i += 512) ((f32x4*)args.out)[i] = (f32x4){v, v, v, v}; }
#endif
#ifdef HY_TSEL
    xcd_barrier(bar, (wave == 0) && ((hy_tid(wave) & 63) == 0));
    if (bx == 0) { volatile LAS unsigned* tmv = (volatile LAS unsigned*)(lds + L_MISC + 128);
        const float tot_ = (float)(tp3b_ - tp3a_); const float x_ = (HY_TSEL) == 7 ? tot_ * 0.01f / 50.f   : 20.f * (float)tmv[HY_TSEL] / tot_;
        const float v = 100.f * (10.f + floorf(x_)); const int t = hy_tid(wave);
        for (size_t i = t; i < (size_t)M * D / 4; i += 512) ((f32x4*)args.out)[i] = (f32x4){v, v, v, v}; }
#endif
#undef IN
#undef SEAM
}
}

extern "C" void kernel_launch(void* const* d_in, const int* in_sizes, int n_in, void* d_out, int out_size, void* d_ws, size_t ws_size, hipStream_t stream) {
    using namespace hy;
    static int grid = 0;
    if (grid == 0) {
        if (n_in != 17 || in_sizes[0] != M * D || out_size != M * D || ws_size < WS_END) {
            fprintf(stderr, "kernel_launch: unexpected shapes (n_in %d, in0 %d, out %d, ws %zu)\n", n_in, n_in > 0 ? in_sizes[0] : -1, out_size, ws_size); grid = -1; return; }
        { const int want[17] = {M * D, D, D * NIN, 64, 64, 64, 64, 64, 64, 128, 64, 192, 2 * 32 * 64, 2 * 2048 * 256, 2 * 256, 2 * 256 * 64, D * D};
          for (int i = 0; i < 17; ++i) if (in_sizes[i] != want[i]) { fprintf(stderr, "kernel_launch: input %d has %d elements, expected %d\n", i, in_sizes[i], want[i]); grid = -1; return; } }
        int dev = 0, cus = 0, per_cu = 0;
        if (hipGetDevice(&dev) != hipSuccess || hipDeviceGetAttribute(&cus, hipDeviceAttributeMultiprocessorCount, dev) != hipSuccess) { grid = -1; return; }
        if (hipFuncSetAttribute((const void*)hymba_fwd, hipFuncAttributeMaxDynamicSharedMemorySize, LDS_BYTES) != hipSuccess) { fprintf(stderr, "kernel_launch: hipFuncSetAttribute failed\n"); grid = -1; return; }
        if (hipOccupancyMaxActiveBlocksPerMultiprocessor(&per_cu, (const void*)hymba_fwd, 512, LDS_BYTES) != hipSuccess || per_cu < 1) { fprintf(stderr, "kernel_launch: occupancy query says %d blocks per CU\n", per_cu); grid = -1; return; }
        (void)hipGetLastError();
        grid = cus * 1;
    }
    if (grid < 0) return;
    (void)hipMemsetAsync((char*)d_ws + WS_CTL, 0, CTL_BYTES, stream);
    Args a{};
    for (int i = 0; i < 17; ++i) a.in[i] = (const float*)d_in[i];
    a.out = (float*)d_out; a.ws = (unsigned char*)d_ws;
#if HY_N_LAUNCHES == 1
    a.ph_lo = 0; a.ph_hi = 5;
    void* kargs[] = {&a};
    hipError_t e = hipLaunchCooperativeKernel((const void*)hymba_fwd, dim3(grid), dim3(512), kargs, LDS_BYTES, stream);
    if (e != hipSuccess) fprintf(stderr, "kernel_launch: cooperative launch failed: %s (grid %d)\n", hipGetErrorString(e), grid);
#else
    for (int p = 0; p < 5; ++p) { a.ph_lo = p; a.ph_hi = p + 1; hipLaunchKernelGGL(hymba_fwd, dim3(grid), dim3(512), LDS_BYTES, stream, a); }
#endif
}
```

```cpp
#include <hip/hip_runtime.h>
#include <cstdio>
#include <cstdint>
#include <cmath>
#define HY_N_LAUNCHES 1
namespace pg8 {
#define PG8_LAS __attribute__((address_space(3)))
typedef unsigned short bf16_t;
typedef short bf16x8 __attribute__((ext_vector_type(8)));
typedef float f32x4 __attribute__((ext_vector_type(4)));
typedef unsigned u32x4 __attribute__((ext_vector_type(4)));
constexpr int BM = 256, BK = 64, HALF = 128, HTB = HALF * BK * 2  , STAGE_BYTES = 8 * HTB, NXCD = 8, WGM = 8;

__host__ __device__ __forceinline__ int lds_byte(int r, int c) { const int st = (r >> 4) * 2 + (c >> 5), rr = r & 15, cc = c & 31, ob = rr * 64 + cc * 2; return st * 1024 + (ob ^ (((ob >> 9) & 1) << 5)); }
__host__ __device__ __forceinline__ void stage_rc(int b, int& R, int& C) { const int st = b / 1024, sb = b % 1024, swz = sb ^ (((sb >> 9) & 1) << 5); R = (st >> 1) * 16 + swz / 64; C = (st & 1) * 32 + (swz % 64) / 2; }
__host__ __device__ __forceinline__ int perm32(int rho) { const int n = rho >> 4, i = rho & 15; return 8 * (i >> 2) + 4 * n + (i & 3); }

struct Unit { int pm, pn; };
struct Gemm { const bf16_t* A; const bf16_t* Bt; int M, N, K; };

struct StaticOrder {
    int nM, nN, nwg, G, c;
    __host__ __device__ void init(int M, int N, int G_, int c_) { nM = M / BM; nN = N / BM; nwg = nM * nN; G = G_; c = c_; }
    __host__ __device__ bool next(int i, Unit& u) const {
        const long L = (long)i * G + c; if (L >= nwg) return false;
        int wgid = (int)L; { const int q = nwg / NXCD, r = nwg % NXCD, xcd = wgid % NXCD, off = wgid / NXCD; wgid = (xcd < r ? xcd * (q + 1) : r * (q + 1) + (xcd - r) * q) + off; }
        const int nig = WGM * nN, gid = wgid / nig, fm = gid * WGM, gsz = (nM - fm) < WGM ? (nM - fm) : WGM;
        u.pm = fm + ((wgid % nig) % gsz); u.pn = (wgid % nig) / gsz; return true;
    }
    __device__ __forceinline__ void a_ready(const Unit&) const {}
    __device__ __forceinline__ void done(const Unit&) const {}
};

template <class Epi, class Sched, bool ALIGN_EPI = false, bool SP2 = false>
__device__ __forceinline__ void gemm_phase(PG8_LAS unsigned char* lds, const Gemm g, const Sched& S, const Epi& E, const int wid) {
    unsigned z_; asm volatile("v_mov_b32 %0, 0" : "=v"(z_));
    const int tid = wid * 64 + (int)__builtin_amdgcn_mbcnt_hi(~0u, __builtin_amdgcn_mbcnt_lo(~0u, z_)), lane = tid & 63, wr = wid >> 2, wc = wid & 3, fr = lane & 15, fq = lane >> 4;
    const int K = g.K, nt = K / BK;
    unsigned voffA[2], voffB[2];
#pragma unroll
    for (int i = 0; i < 2; ++i) { int R, C; stage_rc(tid * 16 + i * 8192, R, C); const int Rb = Epi::PERM ? ((R & ~31) + perm32(R & 31)) : R;
        voffA[i] = (unsigned)(R * K + C) * 2u; voffB[i] = (unsigned)(Rb * K + C) * 2u; }
    const size_t kstep = (size_t)(BK * 2);
    const size_t hstep = (size_t)HALF * K * 2;
    const size_t tstep = 2 * hstep;
    const unsigned ldsw = (unsigned)wid * 1024u;
    const int aoff = lds_byte(wr * 64 + fr, fq * 8), boff = lds_byte(wc * 32 + fr, fq * 8);
#define PG8_SA(b, h) (((b) * 2 + (h)) * HTB)
#define PG8_SB(b, h) ((4 + (b) * 2 + (h)) * HTB)
#define PG8_STAGE(bufoff, gbase, voff) do { _Pragma("unroll") for (int _i = 0; _i < 2; ++_i) \
        __builtin_amdgcn_global_load_lds((const unsigned*)((const char*)(gbase) + (voff)[_i]), (PG8_LAS unsigned*)(lds + (bufoff) + ldsw + _i * 8192), 16, 0, 0); } while (0)
#define PG8_LDA(dst, b, h) do { _Pragma("unroll") for (int m = 0; m < 4; ++m) _Pragma("unroll") for (int k = 0; k < 2; ++k) dst[m][k] = *(const PG8_LAS bf16x8*)(lds + PG8_SA(b, h) + aoff + m * 2048 + k * 1024); } while (0)
#define PG8_LDB(dst, b, h) do { _Pragma("unroll") for (int n = 0; n < 2; ++n) _Pragma("unroll") for (int k = 0; k < 2; ++k) dst[n][k] = *(const PG8_LAS bf16x8*)(lds + PG8_SB(b, h) + boff + n * 2048 + k * 1024); } while (0)
#define PG8_MMA(ai, bj, At, Bt) do { __builtin_amdgcn_s_setprio(1); _Pragma("unroll") for (int m = 0; m < 4; ++m) _Pragma("unroll") for (int n = 0; n < 2; ++n) _Pragma("unroll") for (int k = 0; k < 2; ++k) \
        acc[ai][bj][m][n] = __builtin_amdgcn_mfma_f32_16x16x32_bf16(Bt[n][k], At[m][k], acc[ai][bj][m][n], 0, 0, 0); __builtin_amdgcn_s_setprio(0); } while (0)
#define PG8_WAIT_V(n) asm volatile("s_waitcnt vmcnt(" #n ")" ::: "memory")
#define PG8_WAIT_L(n) asm volatile("s_waitcnt lgkmcnt(" #n ")" ::: "memory")
#define PG8_BAR __builtin_amdgcn_s_barrier()
#define PG8_SCHED __builtin_amdgcn_sched_barrier(0)
    Unit cur, nxt; int ui = 0;
    if (!S.next(0, cur)) return;
    f32x4 acc[2][2][4][2];
#pragma unroll
    for (int a = 0; a < 2; ++a)
#pragma unroll
        for (int b = 0; b < 2; ++b)
#pragma unroll
            for (int m = 0; m < 4; ++m)
#pragma unroll
                for (int n = 0; n < 2; ++n) acc[a][b][m][n] = (f32x4){0.f, 0.f, 0.f, 0.f};
    bf16x8 At[4][2], B0[2][2], B1[2][2];
    const char* cA = (const char*)g.A + (size_t)cur.pm * tstep; const char* cB = (const char*)g.Bt + (size_t)cur.pn * tstep;
    S.a_ready(cur);
    if constexpr (SP2) {
        PG8_STAGE(PG8_SB(0, 0), cB, voffB); PG8_STAGE(PG8_SB(0, 1), cB + hstep, voffB); PG8_STAGE(PG8_SA(0, 0), cA, voffA); PG8_STAGE(PG8_SA(0, 1), cA + hstep, voffA);
        if (wr == 1) PG8_BAR;
        PG8_WAIT_V(2); PG8_BAR;
        PG8_STAGE(PG8_SB(1, 0), cB + kstep, voffB); PG8_STAGE(PG8_SA(1, 0), cA + kstep, voffA); PG8_STAGE(PG8_SB(1, 1), cB + hstep + kstep, voffB);
        PG8_WAIT_V(6); PG8_BAR;
    } else {
        PG8_STAGE(PG8_SB(0, 0), cB, voffB); PG8_STAGE(PG8_SA(0, 0), cA, voffA); PG8_STAGE(PG8_SB(0, 1), cB + hstep, voffB); PG8_STAGE(PG8_SA(0, 1), cA + hstep, voffA);
        if (wr == 1) PG8_BAR;
        PG8_WAIT_V(4); PG8_BAR;
        PG8_STAGE(PG8_SB(1, 0), cB + kstep, voffB); PG8_STAGE(PG8_SA(1, 0), cA + kstep, voffA); PG8_STAGE(PG8_SB(1, 1), cB + hstep + kstep, voffB);
        PG8_WAIT_V(6); PG8_BAR;
    }
    for (;;) {
        const bool has_next = S.next(ui + 1, nxt);
        const char* nA = has_next ? (const char*)g.A + (size_t)nxt.pm * tstep : cA; const char* nB = has_next ? (const char*)g.Bt + (size_t)nxt.pn * tstep : cB;
        for (int t = 0; t < nt; t += 2) {
            const bool last = (t == nt - 2);
            const char* a1 = cA + (size_t)(t + 1) * kstep;
            const char* a2 = last ? nA : cA + (size_t)(t + 2) * kstep; const char* b2 = last ? nB : cB + (size_t)(t + 2) * kstep;
            const char* a3 = a2 + kstep; const char* b3 = b2 + kstep;
            if (last && has_next) S.a_ready(nxt);
            if constexpr (SP2) {
            PG8_LDB(B0, 0, 0); PG8_LDB(B1, 0, 1); PG8_SCHED; PG8_LDA(At, 0, 0); PG8_STAGE(PG8_SA(1, 1), a1 + hstep, voffA);
            PG8_WAIT_V(8); PG8_WAIT_L(0); PG8_BAR; PG8_MMA(0, 0, At, B0); PG8_MMA(0, 1, At, B1); PG8_BAR; PG8_SCHED;
            PG8_LDA(At, 0, 1); PG8_STAGE(PG8_SB(0, 0), b2, voffB); PG8_STAGE(PG8_SB(0, 1), b2 + hstep, voffB); PG8_STAGE(PG8_SA(0, 0), a2, voffA);
            PG8_WAIT_V(8); PG8_WAIT_L(0); PG8_BAR; PG8_MMA(1, 0, At, B0); PG8_MMA(1, 1, At, B1); PG8_BAR; PG8_SCHED;
            PG8_LDB(B0, 1, 0); PG8_LDB(B1, 1, 1); PG8_SCHED; PG8_LDA(At, 1, 0); PG8_STAGE(PG8_SA(0, 1), a2 + hstep, voffA);
            PG8_WAIT_V(8); PG8_WAIT_L(0); PG8_BAR; PG8_MMA(0, 0, At, B0); PG8_MMA(0, 1, At, B1); PG8_BAR; PG8_SCHED;
            PG8_LDA(At, 1, 1); PG8_STAGE(PG8_SB(1, 0), b3, voffB); PG8_STAGE(PG8_SB(1, 1), b3 + hstep, voffB); PG8_STAGE(PG8_SA(1, 0), a3, voffA);
            PG8_WAIT_V(8); PG8_WAIT_L(0); PG8_BAR; PG8_MMA(1, 0, At, B0); PG8_MMA(1, 1, At, B1); PG8_BAR; PG8_SCHED;
            } else {
            PG8_LDB(B0, 0, 0); PG8_SCHED; PG8_LDA(At, 0, 0); PG8_STAGE(PG8_SA(1, 1), a1 + hstep, voffA);
            PG8_WAIT_L(8); PG8_BAR; PG8_WAIT_L(0); PG8_MMA(0, 0, At, B0); PG8_BAR; PG8_SCHED;
            PG8_LDB(B1, 0, 1); PG8_STAGE(PG8_SB(0, 0), b2, voffB);
            PG8_BAR; PG8_WAIT_L(0); PG8_MMA(0, 1, At, B1); PG8_BAR;
            PG8_LDA(At, 0, 1); PG8_STAGE(PG8_SA(0, 0), a2, voffA);
            PG8_BAR; PG8_WAIT_L(0); PG8_MMA(1, 0, At, B0); PG8_BAR; PG8_SCHED;
            PG8_STAGE(PG8_SB(0, 1), b2 + hstep, voffB);
            PG8_WAIT_V(6); PG8_BAR; PG8_MMA(1, 1, At, B1); PG8_BAR;
            PG8_LDB(B0, 1, 0); PG8_SCHED; PG8_LDA(At, 1, 0); PG8_STAGE(PG8_SA(0, 1), a2 + hstep, voffA);
            PG8_WAIT_L(8); PG8_BAR; PG8_WAIT_L(0); PG8_MMA(0, 0, At, B0); PG8_BAR; PG8_SCHED;
            PG8_LDB(B1, 1, 1); PG8_STAGE(PG8_SB(1, 0), b3, voffB);
            PG8_BAR; PG8_WAIT_L(0); PG8_MMA(0, 1, At, B1); PG8_BAR;
            PG8_LDA(At, 1, 1); PG8_STAGE(PG8_SA(1, 0), a3, voffA);
            PG8_BAR; PG8_WAIT_L(0); PG8_MMA(1, 0, At, B0); PG8_BAR; PG8_SCHED;
            PG8_STAGE(PG8_SB(1, 1), b3 + hstep, voffB);
            PG8_WAIT_V(6); PG8_BAR; PG8_MMA(1, 1, At, B1); PG8_BAR;
            }
        }
        if constexpr (ALIGN_EPI) { if (wr == 0) PG8_BAR; }
        if constexpr (!Epi::AFTER_DRAIN) { E(acc, cur, wr, wc, fr, fq); S.done(cur); }
        if (!has_next) break;
#pragma unroll
        for (int a = 0; a < 2; ++a)
#pragma unroll
            for (int b = 0; b < 2; ++b)
#pragma unroll
                for (int m = 0; m < 4; ++m)
#pragma unroll
                    for (int n = 0; n < 2; ++n) acc[a][b][m][n] = (f32x4){0.f, 0.f, 0.f, 0.f};
        cur = nxt; cA = nA; cB = nB; ++ui;
        if constexpr (ALIGN_EPI) { if (wr == 1) PG8_BAR; }
    }
    PG8_WAIT_V(0);
    if constexpr (!ALIGN_EPI) { if (wr == 0) PG8_BAR; }
    PG8_BAR;
    if constexpr (Epi::AFTER_DRAIN) { E.fused(acc, cur, wr, wc, fr, fq, lds, wid, lane); S.done(cur); }
#undef PG8_SA
#undef PG8_SB
#undef PG8_STAGE
#undef PG8_LDA
#undef PG8_LDB
#undef PG8_MMA
#undef PG8_WAIT_V
#undef PG8_WAIT_L
#undef PG8_BAR
#undef PG8_SCHED
}
}

#ifndef HY_P4_ALIGN
#define HY_P4_ALIGN true
#endif
#ifndef HY_N_LAUNCHES
#define HY_N_LAUNCHES 5
#endif

namespace hy {
#define LAS __attribute__((address_space(3)))
typedef unsigned short bf16_t;
typedef short bf16x8 __attribute__((ext_vector_type(8)));
typedef short s16x4 __attribute__((ext_vector_type(4)));
typedef float f32x4 __attribute__((ext_vector_type(4)));
typedef float f32x16 __attribute__((ext_vector_type(16)));
typedef unsigned u32x4 __attribute__((ext_vector_type(4)));
typedef unsigned u32x2 __attribute__((ext_vector_type(2)));
typedef LAS unsigned char* ldsp;

constexpr int BATCH = 32, T = 2048, D = 1024, M = BATCH * T;
constexpr int NIN = 3864, NPAD = 4096, LDP = 3904;
constexpr int C_DQ = 0, C_DK = 512, C_DV = 1024, C_DZ = 1536, C_NQ = 2048, C_NKV = 2560, C_NZ = 3328, C_NG = 3840;
constexpr float EPS = 1e-6f;
constexpr float LOG2E = 1.4426950408889634f;
constexpr float QSCALE = 0.125f * LOG2E;
constexpr float MCOEF = QSCALE * 64.0f;
constexpr float LAM_INIT = 0.2f;

constexpr size_t MiB = 1u << 20;
constexpr size_t WS_CTL = 0, CTL_BYTES = 1 * MiB;
constexpr size_t WS_WIN = 2 * MiB;
constexpr size_t WS_WOUT = 12 * MiB;
constexpr size_t WS_W1T = 14 * MiB;
constexpr size_t WS_W2T = 16 * MiB;
constexpr size_t WS_B1P = 16 * MiB + 256 * 1024;
constexpr size_t WS_KC = 17 * MiB;
constexpr size_t WS_VC = 18 * MiB;
constexpr size_t WS_XN = 32 * MiB;
constexpr size_t WS_AOUT = 160 * MiB;
constexpr size_t WS_PROJ = 288 * MiB;
constexpr size_t WS_END = 776 * MiB;
constexpr int CW_QCTR = 64;

constexpr int LDS_BYTES = 163840;
constexpr int L_IB = 81920, L_LB = L_IB + 33792, L_WSF = L_LB + 1024, L_ZT = L_WSF + 2048, L_MISC = 163328;
static_assert(L_ZT + 32768 + 6144 <= L_MISC && L_MISC + 256 <= LDS_BYTES, "LDS map");

struct Args { const float* in[17]; float* out; unsigned char* ws; int ph_lo, ph_hi; };

#define LOG2E_F 1.4426950408889634f
#define LDS_FENCE() do { asm volatile("s_waitcnt lgkmcnt(0)" ::: "memory"); __builtin_amdgcn_wave_barrier(); } while (0)

__device__ __forceinline__ unsigned cvtpk(float lo, float hi) {
    typedef float f2_t __attribute__((ext_vector_type(2))); typedef __bf16 b2_t __attribute__((ext_vector_type(2)));
    f2_t v = {lo, hi}; b2_t b = __builtin_convertvector(v, b2_t); return __builtin_bit_cast(unsigned, b);
}
__device__ __forceinline__ int hy_tid(int wave) { unsigned z; asm volatile("v_mov_b32 %0, 0" : "=v"(z)); return wave * 64 + (int)__builtin_amdgcn_mbcnt_hi(~0u, __builtin_amdgcn_mbcnt_lo(~0u, z)); }
__device__ __forceinline__ float bf2f(unsigned short u) { return __builtin_bit_cast(float, (unsigned)u << 16); }
template <int K> __device__ __forceinline__ float shx(float v) {
    if constexpr (K == 32) {
        const unsigned u = __builtin_bit_cast(unsigned, v); auto rr = __builtin_amdgcn_permlane32_swap(u, u, false, false);
        return __builtin_bit_cast(float, rr[0] ^ rr[1] ^ u);
    } else return __builtin_bit_cast(float, __builtin_amdgcn_ds_swizzle(__builtin_bit_cast(int, v), (K << 10) | 0x1f));
}
template <int CTRL> __device__ __forceinline__ float dppf(float v) { return __builtin_bit_cast(float, __builtin_amdgcn_update_dpp(0, __builtin_bit_cast(int, v), CTRL, 0xf, 0xf, true)); }
__device__ __forceinline__ float red32(float v) {
    v += dppf<0xB1>(v); v += dppf<0x4E>(v); v += dppf<0x141>(v); v += dppf<0x140>(v); v += shx<16>(v);
    return v;
}
__device__ __forceinline__ float wave_sum(float v) {
    v += shx<1>(v); v += shx<2>(v); v += shx<4>(v); v += shx<8>(v); v += shx<16>(v); v += shx<32>(v);
    return v;
}
__device__ __forceinline__ float wave_max(float v) {
    v = fmaxf(v, shx<1>(v)); v = fmaxf(v, shx<2>(v)); v = fmaxf(v, shx<4>(v)); v = fmaxf(v, shx<8>(v)); v = fmaxf(v, shx<16>(v)); v = fmaxf(v, shx<32>(v));
    return v;
}
__device__ __forceinline__ float sigmf(float v) { return __builtin_amdgcn_rcpf(1.0f + __builtin_amdgcn_exp2f(-LOG2E_F * v)); }
__device__ __forceinline__ float siluf(float v) { return v * sigmf(v); }

__device__ __forceinline__ void transpose_item(const float* W, int ldw, int ncols, int n0, int k0, bf16_t* WT, int K, int p0, LAS float* scr, int lane) {
#pragma unroll 8
    for (int i = 0; i < 32; ++i) {
        const int kk = 2 * i + (lane >> 5), nn = lane & 31, n = n0 + nn;
#ifdef HY_T_NOLOAD
        scr[kk * 33 + nn] = (float)n;
#else
        scr[kk * 33 + nn] = (n < ncols) ? W[(size_t)(k0 + kk) * ldw + n] : 0.f;
#endif
    }
    LDS_FENCE();
    const int c = lane & 7;
#pragma unroll
    for (int j = 0; j < 4; ++j) {
        const int n = (lane >> 3) + 8 * j; const LAS float* s = scr + (8 * c) * 33 + n;
        u32x4 o; o.x = cvtpk(s[0 * 33], s[1 * 33]); o.y = cvtpk(s[2 * 33], s[3 * 33]); o.z = cvtpk(s[4 * 33], s[5 * 33]); o.w = cvtpk(s[6 * 33], s[7 * 33]);
#ifdef HY_T_NOSTORE
        if (o.x == 0x12345678u) *(u32x4*)(WT) = o;
#else
        *(u32x4*)(WT + (size_t)(p0 + n) * K + k0 + 8 * c) = o;
#endif
    }
    LDS_FENCE();
}
__device__ __forceinline__ void rms_rows4(const float* x0, const float* g, bf16_t* o0, int lane) {
    const f32x4* gr = (const f32x4*)g + lane;
    f32x4 v[4][4]; float s[4];
#pragma unroll
    for (int q = 0; q < 4; ++q) { const f32x4* xr = (const f32x4*)(x0 + (size_t)q * D) + lane;
#pragma unroll
        for (int j = 0; j < 4; ++j) v[q][j] = xr[64 * j]; }
#pragma unroll
    for (int q = 0; q < 4; ++q) { float a = 0.f;
#pragma unroll
        for (int j = 0; j < 4; ++j) a += (v[q][j].x * v[q][j].x + v[q][j].y * v[q][j].y) + (v[q][j].z * v[q][j].z + v[q][j].w * v[q][j].w);
        s[q] = a; }
#pragma unroll
    for (int q = 0; q < 4; ++q) s[q] = wave_sum(s[q]);
    f32x4 gj[4];
#pragma unroll
    for (int j = 0; j < 4; ++j) gj[j] = gr[64 * j];
#pragma unroll
    for (int q = 0; q < 4; ++q) { const float r = 1.0f / sqrtf(s[q] * (1.f / D) + EPS); u32x2* o8 = (u32x2*)(o0 + (size_t)q * D) + lane;
#pragma unroll
        for (int j = 0; j < 4; ++j) { const f32x4 y = (v[q][j] * r) * gj[j]; u32x2 w; w.x = cvtpk(y.x, y.y); w.y = cvtpk(y.z, y.w); o8[64 * j] = w; } }
}
__device__ __forceinline__ void p0_prologue(const Args& A, ldsp lds, int vcu, int G, int wave, int lane) {
    LAS float* scr = (LAS float*)(lds + wave * 16384);
    unsigned char* ws = A.ws;
    const int gw = vcu * 8 + wave, NGW = G * 8;
    constexpr int I_WIN = (NPAD / 32) * (D / 64), I_WOUT = (D / 32) * (D / 64), I_W1 = (256 / 32) * (2048 / 64), I_W2 = (64 / 32) * (256 / 64), I_B1 = 2 * 4 * 8;
    constexpr int NITEMS = I_WIN + I_WOUT + 2 * I_W1 + 2 * I_W2 + I_B1;
#ifndef HY_P0_SKIP_T
#ifndef HY_IT_LO
#define HY_IT_LO 0
#define HY_IT_HI NITEMS
#endif
    for (int it = gw; it < NITEMS; it += NGW) {
        int r = it;
        if (it < (HY_IT_LO) || it >= (HY_IT_HI)) continue;
#ifdef HY_WAVE_LT
        if (wave >= (HY_WAVE_LT)) continue;
#endif
        if (r < I_WIN) { const int nb = r / (D / 64), kb = r % (D / 64), p0 = 32 * nb;
            const int n0 = 256 * (p0 >> 8) + 64 * ((p0 >> 5) & 3) + 32 * ((p0 >> 7) & 1);
            transpose_item(A.in[2], NIN, NIN, n0, 64 * kb, (bf16_t*)(ws + WS_WIN), D, p0, scr, lane); continue; }
        r -= I_WIN;
        if (r < I_WOUT) { const int nb = r / (D / 64), kb = r % (D / 64); transpose_item(A.in[16], D, D, 32 * nb, 64 * kb, (bf16_t*)(ws + WS_WOUT), D, 32 * nb, scr, lane); continue; }
        r -= I_WOUT;
        if (r < 2 * I_W1) { const int wh = r / I_W1, q = r % I_W1, nb = q / 32, kb = q % 32;
            transpose_item(A.in[13] + (size_t)wh * 2048 * 256, 256, 256, 32 * nb, 64 * kb, (bf16_t*)(ws + WS_W1T) + (size_t)wh * 256 * 2048, 2048, 32 * nb, scr, lane); continue; }
        r -= 2 * I_W1;
        if (r < 2 * I_W2) { const int wh = r / I_W2, q = r % I_W2, nb = q / 4, kb = q % 4;
            transpose_item(A.in[15] + (size_t)wh * 256 * 64, 64, 64, 32 * nb, 64 * kb, (bf16_t*)(ws + WS_W2T) + (size_t)wh * 64 * 256, 256, 32 * nb, scr, lane); continue; }
        r -= 2 * I_W2;
        {
            const int wh = r >> 5, ng = (r >> 3) & 3, ksl = r & 7;
            const float* pos = A.in[12] + (size_t)wh * 2048 + ksl * 256; const float* w1 = A.in[13] + (size_t)wh * 2048 * 256 + (size_t)(ksl * 256) * 256 + ng * 64 + lane;
            float acc = 0.f;
#pragma unroll 8
            for (int k = 0; k < 256; ++k) acc = fmaf(pos[k], w1[(size_t)k * 256], acc);
            ((float*)(ws + WS_B1P))[(wh * 8 + ksl) * 256 + ng * 64 + lane] = acc;
        }
    }
#endif
#ifndef HY_P0_SKIP_R
    for (int m = 4 * gw; m < M; m += 4 * NGW) rms_rows4(A.in[0] + (size_t)m * D, A.in[1], (bf16_t*)(ws + WS_XN) + (size_t)m * D, lane);
#endif
}

struct EpiIn {
    static constexpr bool PERM = true, AFTER_DRAIN = false;
    bf16_t* P; const float* gq_d; const float* gk_d; const float* gq_n; const float* gk_n3;
    __device__ __forceinline__ void operator()(const f32x4 (&acc)[2][2][4][2], const pg8::Unit& u, int wr, int wc, int fr, int fq) const {
        const int G = u.pn * 4 + wc;
        if (G > 60) return;
        int kind = 0; const float* g = nullptr; float post = 1.f;
        if (G < 8) { kind = 1; g = gq_d; post = QSCALE; }
        else if (G < 16) { kind = 1; g = gk_d; }
        else if (G < 24) { kind = 0; }
        else if (G < 32) { kind = 2; }
        else if (G < 40) { kind = 1; g = gq_n; post = QSCALE; }
        else if (G < 52) { const int wh = (G - 40) >> 1; if (wh == 2) { kind = 1; g = gk_n3 + 64; } else if (wh == 4) { kind = 1; g = gk_n3 + 128; } }
        else if (G < 60) { kind = 2; }
        else { kind = 3; }
        f32x4 gv[2][2];
#pragma unroll
        for (int bj = 0; bj < 2; ++bj)
#pragma unroll
            for (int n = 0; n < 2; ++n) gv[bj][n] = (kind == 1) ? (*(const f32x4*)(g + 32 * bj + 8 * fq + 4 * n)) * post : (f32x4){1.f, 1.f, 1.f, 1.f};
        bf16_t* base = P + (size_t)(u.pm * 256 + wr * 64 + fr) * LDP + G * 64 + 8 * fq;
#pragma unroll
        for (int ai = 0; ai < 2; ++ai)
#pragma unroll
            for (int m = 0; m < 4; ++m) {
                f32x4 v[2][2];
#pragma unroll
                for (int bj = 0; bj < 2; ++bj)
#pragma unroll
                    for (int n = 0; n < 2; ++n) v[bj][n] = acc[ai][bj][m][n];
                if (kind == 1) {
                    float ss = 0.f;
#pragma unroll
                    for (int bj = 0; bj < 2; ++bj)
#pragma unroll
                        for (int n = 0; n < 2; ++n) { const f32x4 x = v[bj][n]; ss += (x[0] * x[0] + x[1] * x[1]) + (x[2] * x[2] + x[3] * x[3]); }
                    ss += shx<16>(ss); ss += shx<32>(ss);
                    const float r = __builtin_amdgcn_rsqf(ss * (1.f / 64.f) + EPS);
#pragma unroll
                    for (int bj = 0; bj < 2; ++bj)
#pragma unroll
                        for (int n = 0; n < 2; ++n) v[bj][n] = (v[bj][n] * r) * gv[bj][n];
                } else if (kind == 2) {
#pragma unroll
                    for (int bj = 0; bj < 2; ++bj)
#pragma unroll
                        for (int n = 0; n < 2; ++n)
#pragma unroll
                            for (int e = 0; e < 4; ++e) v[bj][n][e] = siluf(v[bj][n][e]);
                } else if (kind == 3) {
#pragma unroll
                    for (int bj = 0; bj < 2; ++bj)
#pragma unroll
                        for (int n = 0; n < 2; ++n)
#pragma unroll
                            for (int e = 0; e < 4; ++e) v[bj][n][e] = sigmf(v[bj][n][e]);
                }
                bf16_t* rowp = base + (size_t)(ai * 128 + m * 16) * LDP;
#pragma unroll
                for (int bj = 0; bj < 2; ++bj) {
                    u32x4 w; w.x = cvtpk(v[bj][0][0], v[bj][0][1]); w.y = cvtpk(v[bj][0][2], v[bj][0][3]); w.z = cvtpk(v[bj][1][0], v[bj][1][1]); w.w = cvtpk(v[bj][1][2], v[bj][1][3]);
                    *(u32x4*)(rowp + 32 * bj) = w;
                }
            }
    }
};
struct EpiOut {
    static constexpr bool PERM = false, AFTER_DRAIN = false;
    const float* x; float* out;
    __device__ __forceinline__ void operator()(const f32x4 (&acc)[2][2][4][2], const pg8::Unit& u, int wr, int wc, int fr, int fq) const {
        const int col0 = u.pn * 256 + wc * 32 + 4 * fq;
#pragma unroll
        for (int ai = 0; ai < 2; ++ai) {
            f32x4 xv[4][2][2];
#pragma unroll
            for (int m = 0; m < 4; ++m) {
                const size_t off = (size_t)(u.pm * 256 + ai * 128 + wr * 64 + m * 16 + fr) * D + col0;
#pragma unroll
                for (int bj = 0; bj < 2; ++bj)
#pragma unroll
                    for (int n = 0; n < 2; ++n) xv[m][bj][n] = *(const f32x4*)(x + off + bj * 128 + n * 16);
            }
#pragma unroll
            for (int m = 0; m < 4; ++m) {
                const size_t off = (size_t)(u.pm * 256 + ai * 128 + wr * 64 + m * 16 + fr) * D + col0;
#pragma unroll
                for (int bj = 0; bj < 2; ++bj)
#pragma unroll
                    for (int n = 0; n < 2; ++n) *(f32x4*)(out + off + bj * 128 + n * 16) = xv[m][bj][n] + acc[ai][bj][m][n];
            }
        }
    }
};

__device__ __forceinline__ void compress_phase(const Args& A, ldsp lds, int wave, int lane) {
    unsigned char* ws = A.ws;
    const bf16_t* PROJ = (const bf16_t*)(ws + WS_PROJ);
    const int tid = wave * 64 + lane, fr = lane & 15, kq = lane >> 4, rg4 = wave & 3, ch = wave >> 2;
    constexpr int BROW = 144, BSLOT = 256 * BROW, HB_OFF = 2 * BSLOT;
    LAS bf16_t* hbuf = (LAS bf16_t*)(lds + HB_OFF);
    for (int uidx = blockIdx.x; uidx < 256; uidx += gridDim.x) {
        const int wh = uidx & 1, kvh = (uidx >> 1) & 1, rh = (uidx >> 2) & 1, b = uidx >> 3;
        const bf16_t* src = PROJ + (size_t)(b * T) * LDP + C_NKV + wh * 128 + kvh * 64;
        const bf16_t* w1t = (const bf16_t*)(ws + WS_W1T) + (size_t)wh * 256 * 2048;
        const bf16_t* w2t = (const bf16_t*)(ws + WS_W2T) + (size_t)wh * 64 * 256;
        const float* b1 = A.in[14] + wh * 256; const float* b1p = (const float*)(ws + WS_B1P) + wh * 8 * 256;
        const int i = rh * 64 + rg4 * 16 + fr;
        const bf16_t* bsrc = w1t + (size_t)(tid >> 1) * 2048 + (tid & 1) * 32;
        const int bdst = (tid >> 1) * BROW + (tid & 1) * 64;
        int tok0 = 16 * i; tok0 = tok0 < T - 31 ? tok0 : T - 32;
        const bf16_t* asrc = src + (size_t)tok0 * LDP + 8 * kq;
        f32x4 acc[8];
#pragma unroll
        for (int nt = 0; nt < 8; ++nt) acc[nt] = (f32x4){0.f, 0.f, 0.f, 0.f};
        u32x4 rb[4]; bf16x8 a[2], an[2];
#pragma unroll
        for (int q = 0; q < 4; ++q) rb[q] = *(const u32x4*)(bsrc + q * 8);
        a[0] = *(const bf16x8*)(asrc); a[1] = *(const bf16x8*)(asrc + 32);
#pragma unroll
        for (int q = 0; q < 4; ++q) *(LAS u32x4*)(lds + bdst + q * 16) = rb[q];
        __syncthreads();
#pragma unroll 1
        for (int ks = 0; ks < 32; ++ks) {
            const int cur = (ks & 1) * BSLOT, nxt = BSLOT - cur;
            if (ks + 1 < 32) {
#pragma unroll
                for (int q = 0; q < 4; ++q) rb[q] = *(const u32x4*)(bsrc + (ks + 1) * 64 + q * 8);
                an[0] = *(const bf16x8*)(asrc + (size_t)(ks + 1) * LDP); an[1] = *(const bf16x8*)(asrc + (size_t)(ks + 1) * LDP + 32);
            }
            const LAS unsigned char* bp = lds + cur + (ch * 128 + fr) * BROW + kq * 16;
#pragma unroll
            for (int sb = 0; sb < 2; ++sb)
#pragma unroll
                for (int nt = 0; nt < 8; ++nt) {
                    const bf16x8 bb = *(const LAS bf16x8*)(bp + nt * 16 * BROW + sb * 64);
                    acc[nt] = __builtin_amdgcn_mfma_f32_16x16x32_bf16(a[sb], bb, acc[nt], 0, 0, 0);
                }
            if (ks + 1 < 32) {
#pragma unroll
                for (int q = 0; q < 4; ++q) *(LAS u32x4*)(lds + nxt + bdst + q * 16) = rb[q];
                a[0] = an[0]; a[1] = an[1];
            }
            __syncthreads();
        }
#pragma unroll
        for (int nt = 0; nt < 8; ++nt) {
            const int col = ch * 128 + 16 * nt + fr; float bias = b1[col];
#pragma unroll
            for (int sl = 0; sl < 8; ++sl) bias += b1p[sl * 256 + col];
#pragma unroll
            for (int rg = 0; rg < 4; ++rg) { const float hv = siluf(acc[nt][rg] + bias); hbuf[(rg4 * 16 + 4 * kq + rg) * 264 + col] = (bf16_t)(cvtpk(hv, hv) & 0xffffu); }
        }
        __syncthreads();
        if (ch == 0) {
            f32x4 acc2[4];
#pragma unroll
            for (int nt = 0; nt < 4; ++nt) acc2[nt] = (f32x4){0.f, 0.f, 0.f, 0.f};
#pragma unroll
            for (int ks = 0; ks < 8; ++ks) {
                const bf16x8 av = *(const LAS bf16x8*)(hbuf + (rg4 * 16 + fr) * 264 + 32 * ks + 8 * kq);
#pragma unroll
                for (int nt = 0; nt < 4; ++nt) {
                    const bf16x8 bb = *(const bf16x8*)(w2t + (size_t)(nt * 16 + fr) * 256 + 32 * ks + 8 * kq);
                    acc2[nt] = __builtin_amdgcn_mfma_f32_16x16x32_bf16(av, bb, acc2[nt], 0, 0, 0);
                }
            }
            bf16_t* dst = (bf16_t*)(ws + (wh == 0 ? WS_KC : WS_VC)) + (size_t)((b * 2 + kvh) * 128) * 64;
            const float* gk = A.in[11];
#pragma unroll
            for (int rg = 0; rg < 4; ++rg) {
                const int io = rh * 64 + rg4 * 16 + 4 * kq + rg;
                float v[4];
#pragma unroll
                for (int nt = 0; nt < 4; ++nt) v[nt] = acc2[nt][rg];
                if (wh == 0) {
                    float ss = (v[0] * v[0] + v[1] * v[1]) + (v[2] * v[2] + v[3] * v[3]);
                    ss += shx<1>(ss); ss += shx<2>(ss); ss += shx<4>(ss); ss += shx<8>(ss);
                    const float r = 1.0f / sqrtf(ss * (1.f / 64.f) + EPS);
#pragma unroll
                    for (int nt = 0; nt < 4; ++nt) v[nt] = (v[nt] * r) * gk[16 * nt + fr];
                }
#pragma unroll
                for (int nt = 0; nt < 4; ++nt) { const float ov = (io < 127) ? v[nt] : 0.f; dst[(size_t)io * 64 + 16 * nt + fr] = (bf16_t)(cvtpk(ov, ov) & 0xffffu); }
            }
        }
        __syncthreads();
    }
}

__device__ __forceinline__ int crow(int r, int hi) { return (r & 3) + 8 * (r >> 2) + 4 * hi; }
typedef short v4i16_t __attribute__((ext_vector_type(4)));
typedef LAS const unsigned char* lcp;
__device__ __forceinline__ s16x4 vtr(lcp p) { return __builtin_bit_cast(s16x4, __builtin_amdgcn_ds_read_tr16_b64_v4i16((LAS v4i16_t*)p)); }
#define SBAR() __builtin_amdgcn_sched_barrier(0)
#define WAIT_BAR(N) asm volatile("s_waitcnt vmcnt(" #N ") lgkmcnt(0)\n\ts_barrier" ::: "memory")
__device__ __forceinline__ void glds16(const void* gsrc, unsigned lds_dst) {
    unsigned keep;
    asm volatile("s_mov_b32 %0, m0\n\ts_mov_b32 m0, %2\n\ts_nop 0\n\tglobal_load_lds_dwordx4 %1, off\n\ts_mov_b32 m0, %0" : "=&s"(keep) : "v"(gsrc), "s"(lds_dst) : "memory");
}
__device__ __forceinline__ void glds16s(unsigned voff, const void* sbase, unsigned lds_dst) {
    unsigned keep;
    asm volatile("s_mov_b32 %0, m0\n\ts_mov_b32 m0, %3\n\ts_nop 0\n\tglobal_load_lds_dwordx4 %1, %2\n\ts_mov_b32 m0, %0" : "=&s"(keep) : "v"(voff), "s"(sbase), "s"(lds_dst) : "memory");
}
constexpr int N_VR = 24576;
constexpr int N_CMP = 49152;
constexpr int D_VR = 49152;

__device__ __forceinline__ lcp lxor(lcp p, unsigned x) { return (lcp)(uintptr_t)((unsigned)(uintptr_t)p ^ x); }
template <int KH = 0>
__device__ __forceinline__ void qk_simple(f32x16& p0, f32x16& p1, lcp kp, const bf16x8 (&qr)[4], float c0) {
#pragma unroll
    for (int r = 0; r < 16; ++r) { p0[r] = c0; p1[r] = c0; }
#pragma unroll
    for (int d0 = 0; d0 < 4; ++d0) {
        const bf16x8 b0 = *(const LAS bf16x8*)(KH ? lxor(kp, d0 << 5) : kp + d0 * 2048);
        const bf16x8 b1 = *(const LAS bf16x8*)(KH ? lxor(kp, d0 << 5) + KH : kp + d0 * 2048 + 512);
        p0 = __builtin_amdgcn_mfma_f32_32x32x16_bf16(b0, qr[d0], p0, 0, 0, 0);
        p1 = __builtin_amdgcn_mfma_f32_32x32x16_bf16(b1, qr[d0], p1, 0, 0, 0);
    }
}
__device__ __forceinline__ void mask_neg(f32x16& p0, f32x16& p1, int kbase, int kmin, int kmax) {
#pragma unroll
    for (int r = 0; r < 16; ++r) {
        const int kv = kbase + (r & 3) + 8 * (r >> 2);
        if (kv < kmin || kv > kmax) p0[r] = -INFINITY;
        if (kv + 32 < kmin || kv + 32 > kmax) p1[r] = -INFINITY;
    }
}
__device__ __forceinline__ void mask_hi(f32x16& p0, f32x16& p1, int kbase, int kmax) {
#pragma unroll
    for (int r = 0; r < 16; ++r) {
        const int kv = kbase + (r & 3) + 8 * (r >> 2);
        if (kv > kmax) p0[r] = -INFINITY;
        if (kv + 32 > kmax) p1[r] = -INFINITY;
    }
}
template <bool ALIBI>
__device__ __forceinline__ void exp_all(f32x16& p0, f32x16& p1, float slope2) {
#pragma unroll
    for (int r = 0; r < 16; ++r) {
        const float cr = (float)((r & 3) + 8 * (r >> 2));
        if (ALIBI) { p0[r] = __builtin_amdgcn_exp2f(fmaf(slope2, cr, p0[r])); p1[r] = __builtin_amdgcn_exp2f(fmaf(slope2, cr + 32.f, p1[r])); }
        else { p0[r] = __builtin_amdgcn_exp2f(p0[r]); p1[r] = __builtin_amdgcn_exp2f(p1[r]); }
    }
}
__device__ __forceinline__ float rowsum(const f32x16& p0, const f32x16& p1) {
    float s = 0.f;
#pragma unroll
    for (int r = 0; r < 16; ++r) s += p0[r] + p1[r];
    return s;
}
__device__ __forceinline__ void pack_p(bf16x8 (&pa)[4], const f32x16& p0, const f32x16& p1) {
    u32x4 w;
    w.x = cvtpk(p0[0], p0[1]); w.y = cvtpk(p0[2], p0[3]); w.z = cvtpk(p0[4], p0[5]); w.w = cvtpk(p0[6], p0[7]); pa[0] = __builtin_bit_cast(bf16x8, w);
    w.x = cvtpk(p0[8], p0[9]); w.y = cvtpk(p0[10], p0[11]); w.z = cvtpk(p0[12], p0[13]); w.w = cvtpk(p0[14], p0[15]); pa[1] = __builtin_bit_cast(bf16x8, w);
    w.x = cvtpk(p1[0], p1[1]); w.y = cvtpk(p1[2], p1[3]); w.z = cvtpk(p1[4], p1[5]); w.w = cvtpk(p1[6], p1[7]); pa[2] = __builtin_bit_cast(bf16x8, w);
    w.x = cvtpk(p1[8], p1[9]); w.y = cvtpk(p1[10], p1[11]); w.z = cvtpk(p1[12], p1[13]); w.w = cvtpk(p1[14], p1[15]); pa[3] = __builtin_bit_cast(bf16x8, w);
}
template <int NDV, int VH = 0>
__device__ __forceinline__ void pv_simple(f32x16 (&o)[NDV], const f32x16& p0, const f32x16& p1, lcp vp) {
    bf16x8 pa[4]; pack_p(pa, p0, p1);
#pragma unroll
    for (int d0 = 0; d0 < NDV; ++d0)
#pragma unroll
        for (int ks = 0; ks < 4; ++ks) {
            const lcp a_ = VH ? lxor(vp, d0 << 6) + ks * (2 * VH) : vp + d0 * 4096 + ks * 1024;
            const s16x4 lo = vtr(a_), hh = vtr(a_ + (VH ? VH : 512));
            const bf16x8 vb = (bf16x8){lo[0], lo[1], lo[2], lo[3], hh[0], hh[1], hh[2], hh[3]};
            o[d0] = __builtin_amdgcn_mfma_f32_32x32x16_bf16(pa[ks], vb, o[d0], 0, 0, 0);
        }
}

struct AttnCtx {
    const bf16_t* PROJ; const bf16_t* KC; const bf16_t* VC; bf16_t* AOUT;
    const float* gsub;
    float lam;
    float M2d, M2c, M2s, M2w;
};

#ifdef HY_TSEL
#define TMARK(var) const unsigned var = (unsigned)__builtin_amdgcn_s_memrealtime()
#define TACC(slot, t1, t0) do { if (wid == 0 && (tid & 63) == 0) ((volatile LAS unsigned*)(lds + L_MISC + 128))[slot] += (t1) - (t0); } while (0)
#else
#define TMARK(var) do { } while (0)
#define TACC(slot, t1, t0) do { } while (0)
#endif
#define PKW(P, B) cvtpk(P[B], P[(B) + 1])
#define PAF(k) __builtin_bit_cast(bf16x8, pw##k)
#define PIN(x) asm volatile("" : "+v"(x))
#define MF32(a, b, c) __builtin_amdgcn_mfma_f32_32x32x16_bf16(a, b, c, 0, 0, 0)
#define VJ(buf, dblk, ks) do { const lcp a_ = VADDR(dblk, ks); vl##buf = vtr(a_); vh##buf = vtr(a_ + VHB); } while (0)
#define VADDR(dblk, ks) (lxor(vp_, (dblk) << 6) + (ks) * (2 * VHB))
#define KADDR(j) lxor(kp0 + sl_next, (j) << 5)
#define VF(buf) (bf16x8){vl##buf[0], vl##buf[1], vl##buf[2], vl##buf[3], vh##buf[0], vh##buf[1], vh##buf[2], vh##buf[3]}
#define KRD(j) do { const lcp a_ = KADDR(j); kf[2 * (j)] = *(const LAS bf16x8*)a_; kf[2 * (j) + 1] = *(const LAS bf16x8*)(a_ + KHB); SBAR(); } while (0)
#define GAPA(MF, A0, A1, A2, A3, W0, W1, PW) do { MF; sacc += A0; sacc += A1; sacc += A2; sacc += A3; PIN(sacc); W0; W1; PIN(PW); SBAR(); } while (0)
#define EX1(X, r) X[r] = __builtin_amdgcn_exp2f(X[r])
#define GAPB4(MF, X, B) do { MF; EX1(X, B); EX1(X, (B) + 1); EX1(X, (B) + 2); EX1(X, (B) + 3); PIN(X); SBAR(); } while (0)
#define GAPB2(MF, X, B) do { MF; EX1(X, B); EX1(X, (B) + 1); PIN(X); SBAR(); } while (0)
__device__ __forceinline__ unsigned split2(float x) { const unsigned h = cvtpk(x, 0.f) & 0xffffu; const float hf = __builtin_bit_cast(float, h << 16); return h | (cvtpk(0.f, x - hf) & 0xffff0000u); }
__device__ __forceinline__ unsigned dup_bf16_exact(float x) { const unsigned h = __builtin_bit_cast(unsigned, x) >> 16; return h | (h << 16); }
#define GAPA2(MF, A0, A1, W0, W1, PW) do { MF; sacc += A0; sacc += A1; PIN(sacc); W0; W1; PIN(PW); SBAR(); } while (0)
#define PHASE_A(C0_, C1_, P0_, P1_) do { \
    float sacc = (P0_[0] + P0_[1]); \
    GAPA(C0_ = MF32(__builtin_bit_cast(bf16x8, xa0), __builtin_bit_cast(bf16x8, xb), z16), P0_[2], P0_[3], P0_[4], P0_[5], pw0[0] = PKW(P0_, 0),  pw0[1] = PKW(P0_, 2),  pw0); \
    PA_HOOK0; \
    GAPA(C1_ = MF32(__builtin_bit_cast(bf16x8, xa1), __builtin_bit_cast(bf16x8, xb), z16), P0_[6], P0_[7], P0_[8], P0_[9], pw0[2] = PKW(P0_, 4),  pw0[3] = PKW(P0_, 6),  pw0); \
    GAPA(C0_ = MF32(kf[0], qr[0], C0_), P0_[10], P0_[11], P0_[12], P0_[13], pw1[0] = PKW(P0_, 8),  pw1[1] = PKW(P0_, 10), pw1); \
    PA_HOOK1; \
    GAPA(C1_ = MF32(kf[1], qr[0], C1_), P0_[14], P0_[15], P1_[0], P1_[1],   pw1[2] = PKW(P0_, 12), pw1[3] = PKW(P0_, 14), pw1); \
    GAPA(C0_ = MF32(kf[2], qr[1], C0_), P1_[2], P1_[3], P1_[4], P1_[5],     pw2[0] = PKW(P1_, 0),  pw2[1] = PKW(P1_, 2),  pw2); \
    PA_HOOK2; \
    GAPA(C1_ = MF32(kf[3], qr[1], C1_), P1_[6], P1_[7], P1_[8], P1_[9],     pw2[2] = PKW(P1_, 4),  pw2[3] = PKW(P1_, 6),  pw2); \
    GAPA(C0_ = MF32(kf[4], qr[2], C0_), P1_[10], P1_[11], P1_[12], P1_[13], pw3[0] = PKW(P1_, 8),  pw3[1] = PKW(P1_, 10), pw3); \
    PA_HOOK3; \
    GAPA2(C1_ = MF32(kf[5], qr[2], C1_), P1_[14], P1_[15],                  pw3[2] = PKW(P1_, 12), pw3[3] = PKW(P1_, 14), pw3); \
    C0_ = MF32(kf[6], qr[3], C0_); VJ(0, 0, 0); SBAR(); \
    C1_ = MF32(kf[7], qr[3], C1_); VJ(1, 1, 0); SBAR(); \
    l_reg += sacc; } while (0)

template <int PRB>
__device__ __forceinline__ void diff_unit(const AttnCtx& C0, int b, int h, int qb, ldsp lds, const int wid) {
    constexpr int probe = PRB;
    AttnCtx C = C0; if (probe) C.AOUT = (bf16_t*)((unsigned char*)C.AOUT - (WS_AOUT - WS_XN));
    { volatile LAS float* sc = (volatile LAS float*)(lds + L_MISC); C.lam = sc[4]; C.M2d = sc[5]; }
    int tid = hy_tid(wid); asm volatile("" : "+v"(tid));
    const int lane = tid & 63, r32 = lane & 31, hi = lane >> 5;
    TMARK(tm_a);
    const int cm = wid >> 2, wq = wid & 3;
    const int q0 = qb * 128, qlo = q0 + wq * 32, qpos = qlo + r32;
    const bf16_t* Pb = C.PROJ + (size_t)b * T * LDP;
    const unsigned lds0 = (unsigned)(uintptr_t)lds;
    constexpr int SLOTB = 16384;
    const float slope2 = ldexpf(1.0f, -2 * (h + 1)) * LOG2E;
    int t0 = (int)floorf(((float)(q0 - 63) - 126.0f / slope2) * (1.0f / 64.0f)) + 1; t0 = t0 < 0 ? 0 : (t0 & ~1);
    t0 = __builtin_amdgcn_readfirstlane(t0);
    const int NT = (probe & 32) ? 2 : 2 * (qb + 1) - t0;
    constexpr int KHB = 8192, VHB = 2048;
    const bf16_t* kdma = Pb + (size_t)(4 * wid) * LDP + C_DK + h * 128;
    const bf16_t* vdma = Pb + (size_t)(4 * wid) * LDP + C_DV + h * 128;
    const unsigned kvo = (unsigned)((lane >> 4) * LDP + ((lane & 15) ^ (((lane >> 4) << 2) | (wid & 3))) * 8) * 2u;
    const unsigned vvo = (unsigned)((lane >> 4) * LDP + ((lane & 15) ^ ((lane >> 4) << 2)) * 8) * 2u;
#define DTOFF(i) ((size_t)(t0 + ((i) < NT ? (i) : NT - 1)) * (64 * LDP))
#define DMA_K(i, so) do { if (probe & 1) break; const bf16_t* s_ = kdma + DTOFF(i); const unsigned d_ = (unsigned)__builtin_amdgcn_readfirstlane((int)(lds0 + (so) + wid * 1024)); glds16s(kvo, s_, d_); glds16s(kvo, s_ + 32 * LDP, d_ + 8192u); } while (0)
#define DMA_V(i, so) do { if (probe & 1) break; const bf16_t* s_ = vdma + DTOFF(i); const unsigned d_ = (unsigned)__builtin_amdgcn_readfirstlane((int)(lds0 + D_VR + (so) + wid * 1024)); glds16s(vvo, s_, d_); glds16s(vvo, s_ + 32 * LDP, d_ + 8192u); } while (0)
#define DMA_P(base, vo, i, so, half) do { if (probe & 1) break; const bf16_t* s_ = (base) + DTOFF(i) + (half) * (32 * LDP); const unsigned d_ = (unsigned)__builtin_amdgcn_readfirstlane((int)(lds0 + (so) + wid * 1024 + (half) * 8192)); glds16s(vo, s_, d_); } while (0)
#define DWB(N) do { if (!(probe & 2)) WAIT_BAR(N); } while (0)
    DMA_K(0, 0); DMA_V(0, 0); DMA_K(1, SLOTB); DMA_K(2, 2 * SLOTB);
    if (cm == 0 && !(probe & 1)) {
        const bf16_t* zs = Pb + (size_t)(qlo + (lane >> 4)) * LDP + C_DZ + h * 128 + (lane & 15) * 8;
        const unsigned zd = (unsigned)__builtin_amdgcn_readfirstlane((int)(lds0 + L_ZT + wq * 8192));
#pragma unroll
        for (int i = 0; i < 8; ++i) glds16(zs + (size_t)(4 * i) * LDP, zd + i * 1024u);
    }
    bf16x8 qr[4];
    { const bf16_t* qp = Pb + (size_t)qpos * LDP + C_DQ + h * 128 + cm * 64 + hi * 8;
#pragma unroll
      for (int d0 = 0; d0 < 4; ++d0) qr[d0] = *(const bf16x8*)(qp + d0 * 16); }
    f32x16 o[4];
#pragma unroll
    for (int d0 = 0; d0 < 4; ++d0)
#pragma unroll
        for (int r = 0; r < 16; ++r) o[d0][r] = 0.f;
    float l_reg = 0.f;
    const lcp kp0 = (lcp)lds + r32 * 256 + (((cm << 3) | hi) ^ (((r32 & 3) << 2) | ((r32 >> 2) & 3))) * 16;
    const lcp vp0 = (lcp)lds + D_VR + (4 * hi + ((lane & 15) >> 2)) * 256 + (((lane & 12) | (((lane >> 4) & 1) << 1) | ((lane >> 1) & 1))) * 16 + (lane & 1) * 8;
    int sl_prev = 0, sl_cur = 0, sl_next = SLOTB;
#define ROT() do { sl_prev = sl_cur; sl_cur = sl_next; sl_next = (sl_next == 2 * SLOTB) ? 0 : sl_next + SLOTB; } while (0)
#define DC0(t) fmaf(slope2, (float)(64 * (t0 + (t)) + 4 * hi - qpos), -C.M2d)
#define DMASK(X0, X1, t) do { if (64 * (t0 + (t)) + 63 > qlo) mask_hi(X0, X1, 64 * (t0 + (t)) + 4 * hi, qpos); } while (0)
    f32x16 pA0, pA1, pB0, pB1; bf16x8 kf[8]; s16x4 vl0, vh0, vl1, vh1, vl2, vh2; u32x4 pw0, pw1, pw2, pw3;
    const unsigned himask = hi ? 0u : 0xffffffffu;
    u32x4 xa0, xa1, xb;
    xa0.x = dup_bf16_exact((float)r32) & himask; xa1.x = dup_bf16_exact((float)(32 + r32)) & himask;
    xa0.y = 0u; xa1.y = 0u; xa0.z = 0x3f803f80u & himask; xa1.z = xa0.z; xa0.w = 0x00003f80u & himask; xa1.w = xa0.w;
    xb.x = split2(slope2) & himask; xb.y = xb.x; xb.z = split2(-slope2 * (float)qpos - C.M2d) & himask; xb.w = 0u;
    f32x16 z16;
#pragma unroll
    for (int r = 0; r < 16; ++r) z16[r] = 0.f;
    DWB(0);
    TMARK(tm_b);
    { qk_simple<KHB>(pA0, pA1, kp0, qr, DC0(0)); DMASK(pA0, pA1, 0); exp_all<true>(pA0, pA1, slope2); }
    DWB(0);
    DMA_K(3, 0); DMA_V(1, SLOTB);
    ROT();
#pragma unroll
    for (int j = 0; j < 4; ++j) { const lcp a_ = lxor(kp0 + sl_cur, j << 5); kf[2 * j] = *(const LAS bf16x8*)a_; kf[2 * j + 1] = *(const LAS bf16x8*)(a_ + KHB); }
    DWB(4);
#ifndef HY_DSPREAD
#define HY_DSPREAD 1
#endif
#if HY_DSPREAD == 2
#define DSPREAD(k, t_, X) do { } while (0)
#define PA_HOOK0 do { DMA_P(kdma, kvo, tq_ + 3, sl_cur, 0); SBAR(); } while (0)
#define PA_HOOK1 do { DMA_P(vdma, vvo, tq_ + 1, D_VR + sl_next, 0); SBAR(); } while (0)
#define PA_HOOK2 do { DMA_P(kdma, kvo, tq_ + 3, sl_cur, 1); SBAR(); } while (0)
#define PA_HOOK3 do { DMA_P(vdma, vvo, tq_ + 1, D_VR + sl_next, 1); SBAR(); } while (0)
#elif HY_DSPREAD
#define DSPREAD(k, t_, X) do { X; SBAR(); } while (0)
#else
#define DSPREAD(k, t_, X) do { if ((k) == 0) { DMA_K((t_) + 3, sl_cur); DMA_V((t_) + 1, sl_next); } } while (0)
#endif
#ifndef PA_HOOK0
#define PA_HOOK0 do { } while (0)
#define PA_HOOK1 do { } while (0)
#define PA_HOOK2 do { } while (0)
#define PA_HOOK3 do { } while (0)
#endif
#define DSTEP(C0_, C1_, P0_, P1_, t) do { SBAR(); \
    const int tq_ = (t); \
    const lcp vp_ = vp0 + sl_prev; \
    { const unsigned tb_ = dup_bf16_exact((float)(64 * (t0 + (t)))) & himask; xa0.y = tb_; xa1.y = tb_; } \
    PHASE_A(C0_, C1_, P0_, P1_); \
    DSPREAD(0, t, DMA_P(kdma, kvo, (t) + 3, sl_cur, 0)); \
    DMASK(C0_, C1_, t); \
    SBAR(); \
    GAPB2(o[0] = MF32(PAF(0), VF(0), o[0]); VJ(2, 0, 1), C0_, 0); \
    GAPB2(o[1] = MF32(PAF(0), VF(1), o[1]); VJ(0, 1, 1), C0_, 2); \
    DSPREAD(1, t, DMA_P(vdma, vvo, (t) + 1, D_VR + sl_next, 0)); \
    KRD(0); GAPB2(o[0] = MF32(PAF(1), VF(2), o[0]); VJ(1, 0, 2), C0_, 4); \
    GAPB2(o[1] = MF32(PAF(1), VF(0), o[1]); VJ(2, 1, 2), C0_, 6); \
    DSPREAD(2, t, DMA_P(kdma, kvo, (t) + 3, sl_cur, 1)); \
    KRD(1); GAPB2(o[0] = MF32(PAF(2), VF(1), o[0]); VJ(0, 0, 3), C0_, 8); \
    GAPB2(o[1] = MF32(PAF(2), VF(2), o[1]); VJ(1, 1, 3), C0_, 10); \
    DSPREAD(3, t, DMA_P(vdma, vvo, (t) + 1, D_VR + sl_next, 1)); \
    KRD(2); GAPB2(o[0] = MF32(PAF(3), VF(0), o[0]); VJ(2, 2, 0), C0_, 12); \
    GAPB2(o[1] = MF32(PAF(3), VF(1), o[1]); VJ(0, 3, 0), C0_, 14); \
    KRD(3); GAPB2(o[2] = MF32(PAF(0), VF(2), o[2]); VJ(1, 2, 1), C1_, 0); \
    GAPB2(o[3] = MF32(PAF(0), VF(0), o[3]); VJ(2, 3, 1), C1_, 2); \
    GAPB2(o[2] = MF32(PAF(1), VF(1), o[2]); VJ(0, 2, 2), C1_, 4); \
    GAPB2(o[3] = MF32(PAF(1), VF(2), o[3]); VJ(1, 3, 2), C1_, 6); \
    GAPB2(o[2] = MF32(PAF(2), VF(0), o[2]); VJ(2, 2, 3), C1_, 8); \
    GAPB2(o[3] = MF32(PAF(2), VF(1), o[3]); VJ(0, 3, 3), C1_, 10); \
    GAPB2(o[2] = MF32(PAF(3), VF(2), o[2]), C1_, 12); \
    GAPB2(o[3] = MF32(PAF(3), VF(0), o[3]), C1_, 14); \
    } while (0)
    int t = 1;
    for (; t + 1 < NT; t += 2) {
        DSTEP(pB0, pB1, pA0, pA1, t);     DWB(4); ROT();
        DSTEP(pA0, pA1, pB0, pB1, t + 1); DWB(4); ROT();
    }
    DSTEP(pB0, pB1, pA0, pA1, t); DWB(0); ROT();
    l_reg += rowsum(pB0, pB1);
    pv_simple<4, VHB>(o, pB0, pB1, vp0 + sl_prev);
#undef DSTEP
#undef PA_HOOK0
#undef PA_HOOK1
#undef PA_HOOK2
#undef PA_HOOK3
#undef DSPREAD
#undef DMA_P
#undef DMA_K
#undef DMA_V
#undef DTOFF
#undef DC0
#undef DMASK
    DWB(0);
    TMARK(tm_c);
    l_reg += shx<32>(l_reg);
    LAS float* wsf = (LAS float*)(lds + L_WSF) + wid * 64;
    LAS float* xbuf = (LAS float*)lds + wq * 64 + lane;
    if (cm == 1) {
        if (hi == 0) wsf[r32] = l_reg;
#pragma unroll
        for (int d0 = 0; d0 < 4; ++d0)
#pragma unroll
            for (int r = 0; r < 16; ++r) xbuf[(d0 * 16 + r) * 256] = o[d0][r];
    }
    __syncthreads();
    if (cm == 0) {
        {
            const float l2 = ((const LAS float*)(lds + L_WSF))[(wid + 4) * 64 + r32];
            if (hi == 0) { wsf[r32] = C.lam * l_reg * __builtin_amdgcn_rcpf(l2); wsf[32 + r32] = EPS * l_reg * l_reg; }
            LDS_FENCE();
        }
        float ss[16];
#pragma unroll
        for (int r = 0; r < 16; ++r) ss[r] = 0.f;
#pragma unroll
        for (int r = 0; r < 16; ++r) {
            const float f = wsf[crow(r, hi)];
#pragma unroll
            for (int d0 = 0; d0 < 4; ++d0) { const float v = fmaf(-f, xbuf[(d0 * 16 + r) * 256], o[d0][r]); o[d0][r] = v; ss[r] = fmaf(v, v, ss[r]); }
        }
#pragma unroll
        for (int r = 0; r < 16; ++r) {
            const float s = red32(ss[r]);
            ss[r] = (1.0f - LAM_INIT) * __builtin_amdgcn_rsqf(fmaf(s, 1.f / 128.f, wsf[32 + crow(r, hi)]));
        }
        LAS bf16_t* zt = (LAS bf16_t*)(lds + L_ZT + wq * 8192);
#pragma unroll
        for (int d0 = 0; d0 < 4; ++d0) {
            const float gs = C.gsub[32 * d0 + r32];
#pragma unroll
            for (int r = 0; r < 16; ++r) {
                LAS bf16_t* zp = zt + crow(r, hi) * 128 + 32 * d0 + r32;
                const float v = (o[d0][r] * ss[r]) * gs * bf2f(*zp);
                *zp = (bf16_t)(cvtpk(v, v) & 0xffffu);
            }
        }
        LDS_FENCE();
        {
            bf16_t* orow = C.AOUT + ((size_t)b * T + qlo + (lane >> 4)) * D + h * 128 + (lane & 15) * 8;
#pragma unroll
            for (int j = 0; j < 8; ++j) { const u32x4 w = *(const LAS u32x4*)((lcp)zt + (4 * j + (lane >> 4)) * 256 + (lane & 15) * 16); *(u32x4*)(orow + (size_t)(4 * j) * D) = w; }
        }
    }
    __syncthreads();
    TMARK(tm_d); TACC(0, tm_b, tm_a); TACC(1, tm_c, tm_b); TACC(2, tm_d, tm_c);
#undef DWB
}

__device__ __forceinline__ void nsa_accum(f32x16 (&tot)[2], const f32x16 (&o)[2], float f, LAS float* wsf, int r32, int hi) {
    LDS_FENCE();
    if (hi == 0) wsf[r32] = f;
    LDS_FENCE();
#pragma unroll
    for (int r = 0; r < 16; ++r) { const float fr = wsf[crow(r, hi)]; tot[0][r] += o[0][r] * fr; tot[1][r] += o[1][r] * fr; }
}
__device__ __forceinline__ void nsa_accum_lds(LAS float* tp, const f32x16 (&o)[2], float f, LAS float* wsf, int r32, int hi) {
    LDS_FENCE();
    if (hi == 0) wsf[r32] = f;
    LDS_FENCE();
#pragma unroll
    for (int r = 0; r < 16; ++r) { const float fr = wsf[crow(r, hi)]; tp[r * 512] += o[0][r] * fr; tp[(16 + r) * 512] += o[1][r] * fr; }
}
__device__ __forceinline__ void nsa_unit(const AttnCtx& C0, int b, int kvh, int tb, ldsp lds, const int wid, const int prb = 0) {
    AttnCtx C = C0; if (prb) C.AOUT = (bf16_t*)((unsigned char*)C.AOUT - (WS_AOUT - WS_XN)); { volatile LAS float* sc = (volatile LAS float*)(lds + L_MISC); C.M2c = sc[6]; C.M2s = sc[7]; C.M2w = sc[8]; }
    int tid = hy_tid(wid); asm volatile("" : "+v"(tid));
    const int lane = tid & 63, r32 = lane & 31, hi = lane >> 5;
    TMARK(tm_a);
    const int g = wid >> 1, half = wid & 1, head = kvh * 4 + g;
    const int tokl = 32 * half + r32, qpos = tb * 64 + tokl;
    const bf16_t* Pb = C.PROJ + (size_t)b * T * LDP;
    const unsigned lds0 = (unsigned)(uintptr_t)lds;
    constexpr int SLOTB = 8192;
    const int j0w = tb >= 8 ? tb - 8 : 0;
    const int NT = (prb & 16) ? 2 : (tb + 1) + (tb - j0w + 1);
#ifndef HY_NK_OLD
#define HY_NK_OLD 0
#endif
#ifndef HY_NV_OLD
#define HY_NV_OLD 0
#endif
    constexpr bool NKN = !(HY_NK_OLD), NVN = !(HY_NV_OLD);
    constexpr int KHB = NKN ? 4096 : 512, VHB = NVN ? 1024 : 512;
    const bf16_t* kdma = NKN ? Pb + (size_t)(8 * wid) * LDP + C_NKV + kvh * 64 : Pb + C_NKV + kvh * 64 + wid * 8;
    const bf16_t* vdma = NVN ? Pb + (size_t)(8 * wid) * LDP + C_NKV + kvh * 64 : Pb + (size_t)(16 * (wid & 3)) * LDP + C_NKV + kvh * 64 + (wid >> 2) * 32;
    const unsigned kvo = NKN ? (unsigned)((lane >> 3) * LDP + ((lane & 7) ^ (((lane >> 4) & 3) | (((wid >> 1) & 1) << 2))) * 8) * 2u : (unsigned)lane * (LDP * 2);
    const unsigned vvo = NVN ? (unsigned)((lane >> 3) * LDP + ((lane & 7) ^ (((lane >> 4) & 1) << 2)) * 8) * 2u : (unsigned)((lane >> 2) * LDP + (lane & 3) * 8) * 2u;
#undef VADDR
#undef KADDR
#define VADDR(dblk, ks) (NVN ? lxor(vp_, (dblk) << 6) + (ks) * 2048 : vp_ + ((dblk) * 4096 + (ks) * 1024))
#define KADDR(j) (NKN ? lxor(kp0 + sl_next, (j) << 5) : kp0 + sl_next + (j) * 2048)
#define NTOFF(i) ({ const int i_ = (i) < NT ? (i) : NT - 1; (i_ <= tb) ? (size_t)256 + (size_t)i_ * (64 * LDP) : (size_t)512 + (size_t)(j0w + i_ - tb - 1) * (64 * LDP); })
#define DMA_K(i, so) glds16s(kvo, kdma + NTOFF(i), (unsigned)__builtin_amdgcn_readfirstlane((int)(lds0 + (so) + wid * 1024)))
#define DMA_V(i, so) glds16s(vvo, vdma + NTOFF(i) + 128, (unsigned)__builtin_amdgcn_readfirstlane((int)(lds0 + N_VR + (so) + wid * 1024)))
    DMA_K(0, 0); DMA_V(0, 0); DMA_K(1, SLOTB); DMA_K(2, 2 * SLOTB);
    {
        const bf16_t* kc = C.KC + (size_t)((b * 2 + kvh) * 128) * 64 + (size_t)lane * 64 + wid * 8;
        const bf16_t* vc = C.VC + (size_t)((b * 2 + kvh) * 128) * 64 + (size_t)(16 * (wid & 3) + (lane >> 2)) * 64 + (wid >> 2) * 32 + (lane & 3) * 8;
        const unsigned d_ = (unsigned)__builtin_amdgcn_readfirstlane((int)(lds0 + N_CMP + wid * 1024));
        glds16(kc, d_); glds16(vc, d_ + 8192u); glds16(kc + 64 * 64, d_ + 16384u); glds16(vc + 64 * 64, d_ + 24576u);
    }
    {
        const bf16_t* zs = Pb + (size_t)(tb * 64 + 32 * half + (lane >> 3)) * LDP + C_NZ + head * 64 + (lane & 7) * 8;
        const unsigned zd = (unsigned)__builtin_amdgcn_readfirstlane((int)(lds0 + L_ZT + wid * 4096));
#pragma unroll
        for (int i = 0; i < 4; ++i) glds16(zs + (size_t)(8 * i) * LDP, zd + i * 1024u);
    }
    bf16x8 qr[4];
    { const bf16_t* qp = Pb + (size_t)qpos * LDP + C_NQ + head * 64 + hi * 8;
#pragma unroll
      for (int d0 = 0; d0 < 4; ++d0) qr[d0] = *(const bf16x8*)(qp + d0 * 16); }
    LAS float* wsf = (LAS float*)(lds + L_WSF) + wid * 64;
    const bf16_t* gatep = Pb + (size_t)qpos * LDP + C_NG + head;
    constexpr int GT0 = (L_ZT + 32768 - L_WSF) / 4;
    if (hi == 0) { const float g0_ = bf2f(gatep[0]), g1_ = bf2f(gatep[8]), g2_ = bf2f(gatep[16]); wsf[GT0 + r32] = g0_; wsf[GT0 + 512 + r32] = g1_; wsf[GT0 + 1024 + r32] = g2_; }
    const float slope2 = ldexpf(1.0f, -(head + 1)) * LOG2E;
    const lcp kp0 = NKN ? (lcp)lds + r32 * 128 + (hi ^ (((r32 >> 1) & 3) | (((r32 >> 4) & 1) << 2))) * 16 : (lcp)lds + hi * 1024 + r32 * 16;
    const lcp vp0 = NVN ? (lcp)lds + N_VR + (4 * hi + ((lane & 15) >> 2)) * 128 + ((((lane >> 3) & 1) << 2) | (((lane >> 4) & 1) << 1) | ((lane >> 1) & 1)) * 16 + (lane & 1) * 8
                        : (lcp)lds + N_VR + ((lane >> 4) & 1) * 32 + (lane & 3) * 8 + (4 * hi + ((lane & 15) >> 2)) * 64;
    f32x16 tot[2];
#pragma unroll
    for (int r = 0; r < 16; ++r) { tot[0][r] = 0.f; tot[1][r] = 0.f; }
    unsigned selmask;
    WAIT_BAR(0);
    if (prb & 128) { asm volatile("s_waitcnt lgkmcnt(0)\n\ts_barrier" ::: "memory"); return; }
    TMARK(tm_b);
    {
        f32x16 o[2];
#pragma unroll
        for (int r = 0; r < 16; ++r) { o[0][r] = 0.f; o[1][r] = 0.f; }
        const int cmax = (qpos >= 31) ? ((qpos - 31) >> 4) : -1;
        const lcp kpc = (lcp)lds + N_CMP + hi * 1024 + r32 * 16;
        const lcp vpc = (lcp)lds + N_CMP + 8192 + ((lane >> 4) & 1) * 32 + (lane & 3) * 8 + (4 * hi + ((lane & 15) >> 2)) * 64;
        float Gs[16], Ts[16], l = 0.f;
#pragma unroll
        for (int tt = 0; tt < 2; ++tt) {
            if ((tt == 1 && tb < 16) || (prb & 8)) {
#pragma unroll
                for (int i = 0; i < 8; ++i) { Gs[tt * 8 + i] = 0.f; Ts[tt * 8 + i] = 0.f; }
                continue;
            }
            f32x16 p0, p1;
            qk_simple(p0, p1, kpc + tt * 16384, qr, -C.M2c);
            mask_hi(p0, p1, 64 * tt + 4 * hi, cmax);
            exp_all<false>(p0, p1, 0.f);
            l += rowsum(p0, p1);
#pragma unroll
            for (int i = 0; i < 4; ++i) {
                Gs[tt * 8 + i] = (p0[4 * i] + p0[4 * i + 1]) + (p0[4 * i + 2] + p0[4 * i + 3]); Ts[tt * 8 + i] = p0[4 * i + 3];
                Gs[tt * 8 + 4 + i] = (p1[4 * i] + p1[4 * i + 1]) + (p1[4 * i + 2] + p1[4 * i + 3]); Ts[tt * 8 + 4 + i] = p1[4 * i + 3];
            }
            pv_simple<2>(o, p0, p1, vpc + tt * 16384);
        }
        l += shx<32>(l);
        const float invl = (l > 0.f) ? 1.0f / l : 0.f;
        LAS float* IB = (LAS float*)(lds + L_IB) + (g * 64 + tokl) * 33;
#pragma unroll
        for (int q = 0; q < 16; ++q) {
            const float recv = shx<32>(Ts[q]);
            if (hi == 1) Gs[q] += recv;
            else if (q + 1 < 16) Gs[q + 1] += recv;
        }
#pragma unroll
        for (int q = 0; q < 16; ++q) IB[2 * q + hi] = Gs[q];
        if (hi == 0) ((LAS float*)(lds + L_LB))[g * 64 + tokl] = invl;
        nsa_accum(tot, o, wsf[GT0 + r32] * invl, wsf, r32, hi);
    }
    WAIT_BAR(0);
    if (tb <= 7 || (prb & 4)) selmask = (2u << tb) - 1u;
    else {
        const LAS float* I0 = (const LAS float*)(lds + L_IB) + tokl * 33 + hi;
        float il[4];
#pragma unroll
        for (int gg = 0; gg < 4; ++gg) il[gg] = ((const LAS float*)(lds + L_LB))[gg * 64 + tokl];
        unsigned keys[16];
        const int lim = tb - 2 < 29 ? tb - 2 : 29, klim = (lim - hi) >> 1;
#pragma unroll
        for (int k = 0; k < 16; ++k) {
            float a = 0.f;
#pragma unroll
            for (int gg = 0; gg < 4; ++gg) a = fmaf(I0[gg * 64 * 33 + 2 * k], il[gg], a);
            const unsigned kb = (__builtin_bit_cast(unsigned, a) & ~31u) + (unsigned)(31 - 2 * k - hi);
            keys[k] = (k <= klim && (k > 0 || hi)) ? kb : 0u;
        }
        unsigned sel = 0u;
#pragma unroll 1
        for (int it = 0; it < 5; ++it) {
            unsigned m = keys[0];
#pragma unroll
            for (int k = 1; k < 16; ++k) m = keys[k] > m ? keys[k] : m;
            const unsigned mp = __builtin_bit_cast(unsigned, shx<32>(__builtin_bit_cast(float, m)));
            const unsigned w = mp > m ? mp : m;
            sel |= 1u << (31u - (w & 31u));
#pragma unroll
            for (int k = 0; k < 16; ++k) keys[k] = (keys[k] == w) ? 0u : keys[k];
        }
        selmask = (sel & ~1u) | 1u | (1u << (tb - 1)) | (1u << tb);
    }
    TMARK(tm_c);
    f32x16 o[2];
#pragma unroll
    for (int r = 0; r < 16; ++r) { o[0][r] = 0.f; o[1][r] = 0.f; }
    float l_reg = 0.f;
    int sl_prev = 0, sl_cur = 0, sl_next = SLOTB;
#define NJ(i) (((i) <= tb) ? (i) : j0w + (i) - tb - 1)
#define NC0(i) ({ const int j_ = NJ(i); float c_ = fmaf(slope2, (float)(64 * j_ + 4 * hi - qpos), ((i) <= tb) ? -C.M2s : -C.M2w); if ((i) <= tb && ((selmask >> j_) & 1u) == 0u) c_ = -INFINITY; c_; })
#define NMASK(X0, X1, i) do { const int j_ = NJ(i); if (j_ == tb) mask_hi(X0, X1, 64 * j_ + 4 * hi, qpos); else if ((i) > tb && j_ == tb - 8) mask_neg(X0, X1, 64 * j_ + 4 * hi, qpos - 511, qpos); } while (0)
    const int qw0 = tb * 64 + 32 * half;
    const int dthr = __builtin_amdgcn_readfirstlane((int)(126.0f / slope2) + 1);
#ifndef HY_NSA_LIGHT
#define HY_NSA_LIGHT 0
#endif
#define NDEAD(i) ((i) >= 0 && qw0 - 64 * NJ(i) - 63 > dthr)
#ifndef HY_NPROBE
#define HY_NPROBE 0
#endif
    int jd = qw0 - 63 - dthr; jd = jd > 0 ? (jd + 63) >> 6 : 0; jd = jd < tb ? jd : tb;
    if (((prb & 1) && wid < 4) || (prb & 2)) jd = 1000;
    jd = __builtin_amdgcn_readfirstlane(jd);
    f32x16 pA0, pA1, pB0, pB1; bf16x8 kf[8]; s16x4 vl0, vh0, vl1, vh1, vl2, vh2; u32x4 pw0, pw1, pw2, pw3;
#pragma unroll
    for (int r = 0; r < 16; ++r) { pB0[r] = 0.f; pB1[r] = 0.f; }
    const unsigned himask = hi ? 0u : 0xffffffffu;
    u32x4 xa0, xa1, xb;
    xa0.x = dup_bf16_exact((float)r32) & himask; xa1.x = dup_bf16_exact((float)(32 + r32)) & himask;
    xa0.y = 0u; xa1.y = 0u; xa0.z = 0x3f803f80u & himask; xa1.z = xa0.z; xa0.w = 0x00003f80u & himask; xa1.w = xa0.w;
    xb.x = split2(slope2) & himask; xb.y = xb.x; xb.z = split2(-slope2 * (float)qpos - C.M2s) & himask; xb.w = 0u;
    f32x16 z16;
#pragma unroll
    for (int r = 0; r < 16; ++r) z16[r] = 0.f;
    { qk_simple<NKN ? 4096 : 0>(pA0, pA1, kp0, qr, NC0(0)); NMASK(pA0, pA1, 0); exp_all<true>(pA0, pA1, slope2); }
    WAIT_BAR(0);
    DMA_K(3, 0); DMA_V(1, SLOTB);
    LAS float* tp = (LAS float*)(lds + N_CMP) + tid;
#pragma unroll
    for (int r = 0; r < 16; ++r) { tp[r * 512] = tot[0][r]; tp[(16 + r) * 512] = tot[1][r]; }
    ROT();
#pragma unroll
    for (int j = 0; j < 4; ++j) { const lcp a_ = NKN ? lxor(kp0 + sl_cur, j << 5) : kp0 + sl_cur + j * 2048; kf[2 * j] = *(const LAS bf16x8*)a_; kf[2 * j + 1] = *(const LAS bf16x8*)(a_ + KHB); }
    WAIT_BAR(2);
#define NFLUSH(t) do { if ((t) == tb + 1) { float lt_ = l_reg + shx<32>(l_reg); const float gs_ = wsf[GT0 + 512 + r32]; \
        nsa_accum_lds(tp, o, gs_ / lt_, wsf, r32, hi); _Pragma("unroll") for (int r = 0; r < 16; ++r) { o[0][r] = 0.f; o[1][r] = 0.f; } l_reg = 0.f; } } while (0)
#ifndef HY_NSPREAD
#define HY_NSPREAD 0
#endif
#if HY_NSPREAD == 2
#define NSPREADK(X) do { } while (0)
#define NSPREAD0(X) do { } while (0)
#define NSPREAD1(X) do { } while (0)
#define PA_HOOK0 do { } while (0)
#define PA_HOOK1 do { DMA_K(tq_ + 3, sl_cur); SBAR(); } while (0)
#define PA_HOOK2 do { } while (0)
#define PA_HOOK3 do { DMA_V(tq_ + 1, sl_next); SBAR(); } while (0)
#elif HY_NSPREAD
#define NSPREAD0(X) do { } while (0)
#define NSPREAD1(X) do { X; SBAR(); } while (0)
#else
#define NSPREAD0(X) do { X; } while (0)
#define NSPREAD1(X) do { } while (0)
#endif
#ifndef NSPREADK
#define NSPREADK(X) do { X; } while (0)
#endif
#ifndef PA_HOOK0
#define PA_HOOK0 do { } while (0)
#define PA_HOOK1 do { } while (0)
#define PA_HOOK2 do { } while (0)
#define PA_HOOK3 do { } while (0)
#endif
#define NSTEP(C0_, C1_, P0_, P1_, t) do { SBAR(); \
    const int tq_ = (t); \
    const lcp vp_ = vp0 + sl_prev; \
    { const int j_ = NJ(t); const unsigned tb_ = dup_bf16_exact((float)(64 * j_)) & himask; xa0.y = tb_; xa1.y = tb_; \
      if ((t) <= tb) xb.w = (((selmask >> j_) & 1u) ? 0u : 0x0000c6eau) & himask; \
      else if ((t) == tb + 1) { xb.z = split2(-slope2 * (float)qpos - C.M2w) & himask; xb.w = 0u; } } \
    PHASE_A(C0_, C1_, P0_, P1_); \
    NSPREADK(DMA_K((t) + 3, sl_cur)); NSPREAD0(DMA_V((t) + 1, sl_next)); \
    NMASK(C0_, C1_, t); \
    SBAR(); \
    GAPB4(o[0] = MF32(PAF(0), VF(0), o[0]); VJ(2, 0, 1), C0_, 0); \
    GAPB4(o[1] = MF32(PAF(0), VF(1), o[1]); VJ(0, 1, 1), C0_, 4); \
    KRD(0); GAPB4(o[0] = MF32(PAF(1), VF(2), o[0]); VJ(1, 0, 2), C0_, 8); \
    NSPREAD1(DMA_V((t) + 1, sl_next)); \
    KRD(1); GAPB4(o[1] = MF32(PAF(1), VF(0), o[1]); VJ(2, 1, 2), C0_, 12); \
    KRD(2); GAPB4(o[0] = MF32(PAF(2), VF(1), o[0]); VJ(0, 0, 3), C1_, 0); \
    KRD(3); GAPB4(o[1] = MF32(PAF(2), VF(2), o[1]); VJ(1, 1, 3), C1_, 4); \
    GAPB4(o[0] = MF32(PAF(3), VF(0), o[0]), C1_, 8); \
    GAPB4(o[1] = MF32(PAF(3), VF(1), o[1]), C1_, 12); \
    NFLUSH(t); \
    } while (0)
    int t = 1;
#pragma unroll 1
    for (; t < jd && t < NT; ++t) { SBAR(); DMA_K(t + 3, sl_cur); DMA_V(t + 1, sl_next); KRD(0); KRD(1); KRD(2); KRD(3); WAIT_BAR(2); ROT(); }
    for (; t + 1 < NT; t += 2) {
        NSTEP(pB0, pB1, pA0, pA1, t);     WAIT_BAR(2); ROT();
        NSTEP(pA0, pA1, pB0, pB1, t + 1); WAIT_BAR(2); ROT();
    }
    if (t < NT) {
        NSTEP(pB0, pB1, pA0, pA1, t); WAIT_BAR(2); ROT();
        WAIT_BAR(0);
        l_reg += rowsum(pB0, pB1);
        pv_simple<2, NVN ? 1024 : 0>(o, pB0, pB1, vp0 + sl_prev);
    } else {
        WAIT_BAR(0);
        l_reg += rowsum(pA0, pA1);
        pv_simple<2, NVN ? 1024 : 0>(o, pA0, pA1, vp0 + sl_prev);
    }
#undef NSTEP
#undef PA_HOOK0
#undef PA_HOOK1
#undef PA_HOOK2
#undef PA_HOOK3
#undef NDEAD
#undef NFLUSH
#undef NMASK
#undef NC0
#undef NJ
#undef DMA_K
#undef DMA_V
#undef NTOFF
    TMARK(tm_d);
    {
        const float gw_ = wsf[GT0 + 1024 + r32];
        const float lt_ = l_reg + shx<32>(l_reg);
        nsa_accum_lds(tp, o, gw_ / lt_, wsf, r32, hi);
    }
    if (!(prb & 32)) {
        LAS bf16_t* zt = (LAS bf16_t*)(lds + L_ZT + wid * 4096);
#pragma unroll
        for (int d0 = 0; d0 < 2; ++d0)
#pragma unroll
            for (int r = 0; r < 16; ++r) {
                LAS bf16_t* zp = zt + crow(r, hi) * 64 + 32 * d0 + r32;
                const float v = tp[(d0 * 16 + r) * 512] * bf2f(*zp);
                *zp = (bf16_t)(cvtpk(v, v) & 0xffffu);
            }
        LDS_FENCE();
        bf16_t* orow = C.AOUT + ((size_t)b * T + tb * 64 + 32 * half + (lane >> 3)) * D + 512 + head * 64 + (lane & 7) * 8;
#pragma unroll
        for (int j = 0; j < 4; ++j) { const u32x4 w = *(const LAS u32x4*)((lcp)zt + (8 * j + (lane >> 3)) * 128 + (lane & 7) * 16); *(u32x4*)(orow + (size_t)(8 * j) * D) = w; }
    }
    asm volatile("s_waitcnt lgkmcnt(0)\n\ts_barrier" ::: "memory");
    TMARK(tm_e); TACC(3, tm_b, tm_a); TACC(4, tm_c, tm_b); TACC(5, tm_d, tm_c); TACC(6, tm_e, tm_d);
}
#undef ROT

__device__ __forceinline__ void attn_phase(const Args& A, ldsp lds, const int wave, int lane, const int qword = CW_QCTR) {
    const bool t0 = (wave == 0 && lane == 0);
    unsigned char* ws = A.ws;
    AttnCtx C;
    C.PROJ = (const bf16_t*)(ws + WS_PROJ); C.KC = (const bf16_t*)(ws + WS_KC); C.VC = (const bf16_t*)(ws + WS_VC); C.AOUT = (bf16_t*)(ws + WS_AOUT);
    C.gsub = A.in[9];
    {
        const float sa = wave_sum(A.in[5][lane] * A.in[6][lane]), sb = wave_sum(A.in[7][lane] * A.in[8][lane]);
        C.lam = expf(sa) - expf(sb) + LAM_INIT;
        const float mqd = wave_max(fabsf(A.in[3][lane])), mkd = wave_max(fabsf(A.in[4][lane])), mqn = wave_max(fabsf(A.in[10][lane]));
        const float mk0 = wave_max(fabsf(A.in[11][lane])), mk1 = wave_max(fabsf(A.in[11][64 + lane])), mk2 = wave_max(fabsf(A.in[11][128 + lane]));
        C.M2d = MCOEF * mqd * mkd; C.M2c = MCOEF * mqn * mk0; C.M2s = MCOEF * mqn * mk1; C.M2w = MCOEF * mqn * mk2;
        if (t0) { LAS float* sc = (LAS float*)(lds + L_MISC); sc[4] = C.lam; sc[5] = C.M2d; sc[6] = C.M2c; sc[7] = C.M2s; sc[8] = C.M2w; }
        C.lam = 0.f; C.M2d = 0.f; C.M2c = 0.f; C.M2s = 0.f; C.M2w = 0.f;
    }
#ifndef HY_QLEN
#define HY_QLEN 512
#define HY_QEXTRA_R 0
#endif
    unsigned* qctr = (unsigned*)(ws + WS_CTL) + qword;
    volatile LAS unsigned* bc = (volatile LAS unsigned*)(lds + L_MISC);
    const unsigned x0 = (unsigned)__builtin_amdgcn_s_getreg((3 << 11) | 20) & 7u;
    unsigned skip = 0u;
    for (;;) {
        if (t0) {
            unsigned found = 0xffffffffu;
            for (unsigned a = skip; a < 8u; ++a) {
                const unsigned x = (x0 + a) & 7u;
                const unsigned idx = atomicAdd(qctr + 64 * x, 1u);
                if (idx < (unsigned)HY_QLEN) { found = x * 1024u + idx; break; }
                skip = a + 1u;
            }
            bc[0] = found;
        }
        __syncthreads();
        const unsigned u = (unsigned)__builtin_amdgcn_readfirstlane((int)bc[0]);
        __syncthreads();
        if (u == 0xffffffffu) break;
        const int x = (int)(u >> 10); int idx = (int)(u & 1023u), b, r;
        if (idx < 256) { b = 4 * x + (idx >> 6); r = idx & 63; }
        else if (idx < 512) { b = 4 * x + ((idx - 256) >> 6); r = 64 + ((idx - 256) & 63); }
        else { idx -= 512; b = 4 * x + (idx >> 6); r = (idx & 63) + HY_QEXTRA_R; }
#ifndef HY_NO_DIFF
#ifndef HY_PROBE
#define HY_PROBE 0
#endif
        if (r < 64) { if ((HY_PROBE) != 0 && (u & 1023u) >= 512u) diff_unit<HY_PROBE>(C, b, r >> 4, 15 - (r & 15), lds, wave); else diff_unit<0>(C, b, r >> 4, 15 - (r & 15), lds, wave); }
#endif
#ifndef HY_NO_NSA
        if (r >= 64) nsa_unit(C, b, (r - 64) >> 5, 31 - ((r - 64) & 31), lds, wave, ((HY_NPROBE) != 0 && (u & 1023u) >= 512u) ? (HY_NPROBE) : 0);
#endif
    }
}

#define XB_TMO      128
#define XB_XCNT(j)  (256  + 64 * (j))
#define XB_XSUB(j)  (1280 + 64 * (j))
#define XB_XGEN(j)  (2304 + 64 * (j))
#define XB_TOP      3328
#define XB_TOPGEN   3392
#define XCD_BAR_WORDS 3456
#define XB_SPIN_CAP (1u << 22)
__device__ __forceinline__ unsigned xb_ld(unsigned* p)              { return __hip_atomic_load(p, __ATOMIC_RELAXED, __HIP_MEMORY_SCOPE_AGENT); }
__device__ __forceinline__ unsigned xb_add(unsigned* p, unsigned v) { return __hip_atomic_fetch_add(p, v, __ATOMIC_RELAXED, __HIP_MEMORY_SCOPE_AGENT); }
__device__ __forceinline__ unsigned xb_xcc_id() { return (unsigned)__builtin_amdgcn_s_getreg((3 << 11) | 20) & 0xFu; }
#define XB_SPIN(cond, bar) do { unsigned _sp = 0; while (cond) { __builtin_amdgcn_s_sleep(1); \
    if ((++_sp & 255u) == 0u) { if (xb_ld(&(bar)[XB_TMO])) break; if (_sp > XB_SPIN_CAP) { atomicAdd(&(bar)[XB_TMO], 1u); break; } } } } while (0)
struct XcdBarrier { unsigned* bar; unsigned x; volatile LAS unsigned* st; };
__device__ __forceinline__ XcdBarrier xcd_barrier_post(unsigned* bar, volatile LAS unsigned* st, bool t0) {
    XcdBarrier b; b.bar = bar; b.x = xb_xcc_id(); b.st = st;
    if (t0) (void)xb_add(&bar[XB_XCNT(b.x)], 1u);
    return b;
}
__device__ __forceinline__ void xcd_barrier_complete(unsigned* bar, unsigned x, unsigned& nloc, unsigned& nx) {
    const unsigned G = gridDim.x * gridDim.y * gridDim.z;
    unsigned sum, cnt, mine, sp = 0u;
    for (;;) {
        sum = 0u; cnt = 0u; mine = 0u;
#pragma unroll
        for (unsigned j = 0; j < 16; ++j) { const unsigned c = xb_ld(&bar[XB_XCNT(j)]); sum += c; cnt += (c > 0u) ? 1u : 0u; mine = (j == x) ? c : mine; }
        if (sum == G) break;
        __builtin_amdgcn_s_sleep(1);
        if ((++sp & 255u) == 0u) { if (xb_ld(&bar[XB_TMO])) break; if (sp > XB_SPIN_CAP) { atomicAdd(&bar[XB_TMO], 1u); break; } }
    }
    nloc = mine > 0u ? mine : 1u; nx = cnt > 0u ? cnt : 1u;
}
__device__ __forceinline__ void xcd_barrier(const XcdBarrier& b, bool t0) {
    asm volatile("s_waitcnt vmcnt(0)" ::: "memory");
    __syncthreads();
    if (t0) {
        unsigned* bar = b.bar;
        __builtin_amdgcn_s_waitcnt(0);
        unsigned nloc = b.st[0], nx = b.st[1];
        if (nloc == 0u) { xcd_barrier_complete(bar, b.x, nloc, nx); b.st[0] = nloc; b.st[1] = nx; }
        const unsigned old = xb_add(&bar[XB_XSUB(b.x)], 1u);
        const unsigned gen = old / nloc;
        if (old + 1u == (gen + 1u) * nloc) {
            __builtin_amdgcn_fence(__ATOMIC_RELEASE, "agent");
            asm volatile("s_waitcnt vmcnt(0)" ::: "memory");
            const unsigned og = xb_add(&bar[XB_TOP], 1u);
            const unsigned tg = og / nx;
            if (og + 1u == (tg + 1u) * nx) xb_add(&bar[XB_TOPGEN], 1u);
            else XB_SPIN(xb_ld(&bar[XB_TOPGEN]) == tg, bar);
            __builtin_amdgcn_fence(__ATOMIC_ACQUIRE, "agent");
            xb_add(&bar[XB_XGEN(b.x)], 1u);
            asm volatile("s_waitcnt vmcnt(0)" ::: "memory");
        } else {
            XB_SPIN(xb_ld(&bar[XB_XGEN(b.x)]) == gen, bar);
            __builtin_amdgcn_fence(__ATOMIC_ACQUIRE, "agent");
            asm volatile("s_waitcnt vmcnt(0)" ::: "memory");
        }
    }
    __syncthreads();
}
constexpr int CW_BAR = 4096;

__global__ void __launch_bounds__(512, 2) hymba_fwd(Args args) {
    extern __shared__ __attribute__((aligned(16))) unsigned char lds_raw[];
    ldsp lds = (ldsp)lds_raw;
    const int wave = __builtin_amdgcn_readfirstlane((int)threadIdx.x >> 6);
    const int G = gridDim.x; const int bx = blockIdx.x; const int vcu = (G % 8 == 0) ? (bx % 8) * (G / 8) + bx / 8 : bx;
    unsigned char* ws = args.ws;
    const int lo = args.ph_lo, hi = args.ph_hi;
#ifndef HY_PHASE_MASK
#define HY_PHASE_MASK 31
#endif
#define IN(k) ((((HY_PHASE_MASK) >> (k)) & 1) && lo <= (k) && (k) < hi)
#if HY_N_LAUNCHES == 1
    const bool t0 = (wave == 0) && ((hy_tid(wave) & 63) == 0);
    { volatile LAS unsigned* st = (volatile LAS unsigned*)(lds + L_MISC + 64); if (t0) { st[0] = 0u; st[1] = 0u; } __syncthreads(); }
    const XcdBarrier bar = xcd_barrier_post((unsigned*)(ws + WS_CTL) + CW_BAR, (volatile LAS unsigned*)(lds + L_MISC + 64), t0);
#define SEAM(k) do { if (IN(k) && IN((k) + 1)) { xcd_barrier(bar, (wave == 0) && ((hy_tid(wave) & 63) == 0)); } } while (0)
#else
#define SEAM(k) do { } while (0)
#endif
#ifdef HY_TSEL
    if (wave == 0 && (hy_tid(wave) & 63) < 16) ((volatile LAS unsigned*)(lds + L_MISC + 128))[hy_tid(wave) & 63] = 0u;
    __syncthreads();
#endif
#ifdef HY_TS_PHASE
    unsigned long long ts_[6]; ts_[0] = __builtin_amdgcn_s_memrealtime();
#define TS(k) do { ts_[k] = __builtin_amdgcn_s_memrealtime(); } while (0)
#else
#define TS(k) do { } while (0)
#endif
#ifndef HY_DUP_PHASE
#define HY_DUP_PHASE -1
#endif
#if HY_DUP_PHASE >= 0
#define DUP(k) for (int rep_ = 0; rep_ < __builtin_amdgcn_readfirstlane((HY_DUP_PHASE) == (k) ? 2 : 1); rep_ = __builtin_amdgcn_readfirstlane(rep_ + 1))
#else
#define DUP(k) for (int rep_ = 0, once_ = 1; once_; once_ = 0)
#endif
    if (IN(0)) DUP(0) { p0_prologue(args, lds, vcu, G, wave, hy_tid(wave) & 63); }
    SEAM(0); TS(1);
    if (IN(1)) DUP(1) {
        pg8::Gemm g{(const bf16_t*)(ws + WS_XN), (const bf16_t*)(ws + WS_WIN), M, NPAD, D}; pg8::StaticOrder S; S.init(M, NPAD, G, bx);
        EpiIn E{(bf16_t*)(ws + WS_PROJ), args.in[3], args.in[4], args.in[10], args.in[11]};
        pg8::gemm_phase<EpiIn, pg8::StaticOrder, true, true>((PG8_LAS unsigned char*)lds, g, S, E, wave);
    }
    SEAM(1); TS(2);
    if (IN(2)) DUP(2) { compress_phase(args, lds, wave, hy_tid(wave) & 63); }
    SEAM(2); TS(3);
#ifdef HY_TSEL
    const unsigned tp3a_ = (unsigned)__builtin_amdgcn_s_memrealtime();
#endif
    if (IN(3)) DUP(3) { attn_phase(args, lds, wave, hy_tid(wave) & 63, CW_QCTR + 512 * rep_); }
#ifdef HY_TSEL
    const unsigned tp3b_ = (unsigned)__builtin_amdgcn_s_memrealtime();
#endif
    SEAM(3); TS(4);
    if (IN(4)) DUP(4) {
        pg8::Gemm g{(const bf16_t*)(ws + WS_AOUT), (const bf16_t*)(ws + WS_WOUT), M, D, D}; pg8::StaticOrder S; S.init(M, D, G, bx);
        EpiOut E{args.in[0], args.out};
        pg8::gemm_phase<EpiOut, pg8::StaticOrder, true, true>((PG8_LAS unsigned char*)lds, g, S, E, wave);
    }
#ifdef HY_TS_PHASE
    xcd_barrier(bar, (wave == 0) && ((hy_tid(wave) & 63) == 0)); TS(5);
    if (bx == 0) { float v = (float)(ts_[HY_TS_PHASE + 1] - ts_[HY_TS_PHASE]) * 0.01f; v = exp2f(floorf(log2f(v) * 12.f + 0.5f) / 12.f);
        const int t = hy_tid(wave);
        for (size_t i = t; i < (size_t)M * D / 4; i += 512) ((f32x4*)args.out)[i] = (f32x4){v, v, v, v}; }
#endif
#ifdef HY_TSEL
    xcd_barrier(bar, (wave == 0) && ((hy_tid(wave) & 63) == 0));
    if (bx == 0) { volatile LAS unsigned* tmv = (volatile LAS unsigned*)(lds + L_MISC + 128);
        const float tot_ = (float)(tp3b_ - tp3a_); const float x_ = (HY_TSEL) == 7 ? tot_ * 0.01f / 50.f   : 20.f * (float)tmv[HY_TSEL] / tot_;
        const float v = 100.f * (10.f + floorf(x_)); const int t = hy_tid(wave);
        for (size_t i = t; i < (size_t)M * D / 4; i += 512) ((f32x4*)args.out)[i] = (f32x4){v, v, v, v}; }
#endif
#undef IN
#undef SEAM
}
}

extern "C" void kernel_launch(void* const* d_in, const int* in_sizes, int n_in, void* d_out, int out_size, void* d_ws, size_t ws_size, hipStream_t stream) {
    using namespace hy;
    static int grid = 0;
    if (grid == 0) {
        if (n_in != 17 || in_sizes[0] != M * D || out_size != M * D || ws_size < WS_END) {
            fprintf(stderr, "kernel_launch: unexpected shapes (n_in %d, in0 %d, out %d, ws %zu)\n", n_in, n_in > 0 ? in_sizes[0] : -1, out_size, ws_size); grid = -1; return; }
        { const int want[17] = {M * D, D, D * NIN, 64, 64, 64, 64, 64, 64, 128, 64, 192, 2 * 32 * 64, 2 * 2048 * 256, 2 * 256, 2 * 256 * 64, D * D};
          for (int i = 0; i < 17; ++i) if (in_sizes[i] != want[i]) { fprintf(stderr, "kernel_launch: input %d has %d elements, expected %d\n", i, in_sizes[i], want[i]); grid = -1; return; } }
        int dev = 0, cus = 0, per_cu = 0;
        if (hipGetDevice(&dev) != hipSuccess || hipDeviceGetAttribute(&cus, hipDeviceAttributeMultiprocessorCount, dev) != hipSuccess) { grid = -1; return; }
        if (hipFuncSetAttribute((const void*)hymba_fwd, hipFuncAttributeMaxDynamicSharedMemorySize, LDS_BYTES) != hipSuccess) { fprintf(stderr, "kernel_launch: hipFuncSetAttribute failed\n"); grid = -1; return; }
        if (hipOccupancyMaxActiveBlocksPerMultiprocessor(&per_cu, (const void*)hymba_fwd, 512, LDS_BYTES) != hipSuccess || per_cu < 1) { fprintf(stderr, "kernel_launch: occupancy query says %d blocks per CU\n", per_cu); grid = -1; return; }
        (void)hipGetLastError();
        grid = cus * 1;
    }
    if (grid < 0) return;
    (void)hipMemsetAsync((char*)d_ws + WS_CTL, 0, CTL_BYTES, stream);
    Args a{};
    for (int i = 0; i < 17; ++i) a.in[i] = (const float*)d_in[i];
    a.out = (float*)d_out; a.ws = (unsigned char*)d_ws;
#if HY_N_LAUNCHES == 1
    a.ph_lo = 0; a.ph_hi = 5;
    void* kargs[] = {&a};
    hipError_t e = hipLaunchCooperativeKernel((const void*)hymba_fwd, dim3(grid), dim3(512), kargs, LDS_BYTES, stream);
    if (e != hipSuccess) fprintf(stderr, "kernel_launch: cooperative launch failed: %s (grid %d)\n", hipGetErrorString(e), grid);
#else
    for (int p = 0; p < 5; ++p) { a.ph_lo = p; a.ph_hi = p + 1; hipLaunchKernelGGL(hymba_fwd, dim3(grid), dim3(512), LDS_BYTES, stream, a); }
#endif
}
```
